# Optimizing an MI355X kernel written in HIP

```python
import math
import jax, jax.numpy as jnp
from jax import lax
import numpy as np

D_MODEL = 1024
BATCH = 2
SEQ = 8192
DEPTH = 1

PLE_DIM = 256
D_FF = 2816
MLA_HEADS = 8
MLA_NOPE = 64
MLA_ROPE = 32
MLA_QK = MLA_NOPE + MLA_ROPE
MLA_V = 64
MLA_Q_RANK = 256
MLA_KV_RANK = 128
ROPE_THETA = 10000.0
DIFF_HEADS = 4
DIFF_QK = 64
DIFF_V = 2 * DIFF_QK
MIX_WIDTH = MLA_HEADS * MLA_V + DIFF_HEADS * DIFF_V
IN_SIZES = (MLA_Q_RANK, MLA_KV_RANK, MLA_ROPE,
            DIFF_HEADS * 2 * DIFF_QK, DIFF_HEADS * 2 * DIFF_QK, DIFF_HEADS * DIFF_V)
N_IN = sum(IN_SIZES)
IN_OFFSETS = [int(v) for v in np.cumsum(IN_SIZES)[:-1]]
Q_BLOCK = 128
EPS = 1e-6

kernel_name = "hybrid_mla_diffattn_macaron_encoder"


def rms_norm(x, g):
    xf = x.astype(jnp.float32)
    y = xf * lax.rsqrt(jnp.mean(xf * xf, axis=-1, keepdims=True) + EPS)
    return (y * g.astype(jnp.float32)).astype(x.dtype)


def swiglu(u, w_gate, w_up, w_down):
    return (jax.nn.silu(u @ w_gate) * (u @ w_up)) @ w_down


def rope_tables(S, dtype):
    pos = jnp.arange(S, dtype=jnp.float32)
    inv = ROPE_THETA ** (-jnp.arange(0, MLA_ROPE, 2, dtype=jnp.float32) / MLA_ROPE)
    ang = pos[:, None] * inv[None, :]
    ang = jnp.concatenate([ang, ang], axis=-1)
    return jnp.cos(ang).astype(dtype), jnp.sin(ang).astype(dtype)


def apply_rope(x, cos, sin):
    half = x.shape[-1] // 2
    rot = jnp.concatenate([-x[..., half:], x[..., :half]], axis=-1)
    return x * cos + rot * sin


def sweep_query_blocks(block_fn, qs):
    B, H, S, _ = qs[0].shape
    nb = S // Q_BLOCK
    blocks = tuple(q.reshape(B, H, nb, Q_BLOCK, q.shape[-1]).transpose(2, 0, 1, 3, 4) for q in qs)
    starts = jnp.arange(nb, dtype=jnp.int32) * Q_BLOCK
    out = lax.map(lambda a: block_fn(a[0], *a[1]), (starts, blocks))
    dv = out.shape[-1]
    return out.transpose(1, 0, 3, 2, 4).reshape(B, S, H * dv)


def mla_mixer(q_lat, kv_lat, k_rope, g_q_lat, w_q_up, g_kv_lat, w_kv_up, g_q, g_k, cos, sin):
    B, S, _ = q_lat.shape
    q = (rms_norm(q_lat, g_q_lat) @ w_q_up).reshape(B, S, MLA_HEADS, MLA_QK)
    kv = (rms_norm(kv_lat, g_kv_lat) @ w_kv_up).reshape(B, S, MLA_HEADS, MLA_NOPE + MLA_V)
    k_nope, v = kv[..., :MLA_NOPE], kv[..., MLA_NOPE:]
    q_nope = rms_norm(q[..., :MLA_NOPE], g_q[:MLA_NOPE])
    q_rot = apply_rope(rms_norm(q[..., MLA_NOPE:], g_q[MLA_NOPE:]), cos[:, None, :], sin[:, None, :])
    k_nope = rms_norm(k_nope, g_k[:MLA_NOPE])
    k_rot = apply_rope(rms_norm(k_rope, g_k[MLA_NOPE:]), cos, sin)
    q = jnp.concatenate([q_nope, q_rot], axis=-1).transpose(0, 2, 1, 3)
    k = jnp.concatenate([k_nope, jnp.broadcast_to(k_rot[:, :, None, :], (B, S, MLA_HEADS, MLA_ROPE))],
                        axis=-1).transpose(0, 2, 1, 3)
    v = v.transpose(0, 2, 1, 3)
    scale = MLA_QK ** -0.5

    def block(start, qb):
        s = jnp.einsum('bhqd,bhkd->bhqk', qb, k).astype(jnp.float32) * scale
        a = jax.nn.softmax(s, axis=-1)
        return jnp.einsum('bhqk,bhkd->bhqd', a.astype(v.dtype), v)

    return sweep_query_blocks(block, (q,))


def diff_mixer(qd, kd, vd, g_q, g_k, lq1, lk1, lq2, lk2, g_sub, slopes, lambda_init):
    B, S, _ = qd.shape
    q = rms_norm(qd.reshape(B, S, DIFF_HEADS, 2, DIFF_QK), g_q)
    k = rms_norm(kd.reshape(B, S, DIFF_HEADS, 2, DIFF_QK), g_k)
    q1 = q[:, :, :, 0].transpose(0, 2, 1, 3)
    q2 = q[:, :, :, 1].transpose(0, 2, 1, 3)
    k1 = k[:, :, :, 0].transpose(0, 2, 1, 3)
    k2 = k[:, :, :, 1].transpose(0, 2, 1, 3)
    v = vd.reshape(B, S, DIFF_HEADS, DIFF_V).transpose(0, 2, 1, 3)
    lam = (jnp.exp(jnp.sum(lq1.astype(jnp.float32) * lk1.astype(jnp.float32)))
           - jnp.exp(jnp.sum(lq2.astype(jnp.float32) * lk2.astype(jnp.float32))) + lambda_init)
    scale = DIFF_QK ** -0.5
    pos_k = jnp.arange(S, dtype=jnp.int32)

    def block(start, q1b, q2b):
        pos_q = start + jnp.arange(Q_BLOCK, dtype=jnp.int32)
        dist = jnp.abs(pos_q[:, None] - pos_k[None, :]).astype(jnp.float32)
        bias = -slopes[:, None, None] * dist
        a1 = jax.nn.softmax(jnp.einsum('bhqd,bhkd->bhqk', q1b, k1).astype(jnp.float32) * scale + bias, axis=-1)
        a2 = jax.nn.softmax(jnp.einsum('bhqd,bhkd->bhqk', q2b, k2).astype(jnp.float32) * scale + bias, axis=-1)
        a = a1 - lam * a2
        return jnp.einsum('bhqk,bhkd->bhqd', a.astype(v.dtype), v)

    o = sweep_query_blocks(block, (q1, q2)).reshape(B, S, DIFF_HEADS, DIFF_V)
    o = rms_norm(o, g_sub) * (1.0 - lambda_init)
    return o.reshape(B, S, DIFF_HEADS * DIFF_V)


def setup_inputs(seed: int = 0) -> dict:
    key = jax.random.key(seed)
    ks = jax.random.split(key, 32)
    f32 = jnp.float32

    def w(k, shape, fan_in):
        return jax.random.normal(k, shape, f32) * (fan_in ** -0.5)

    def gain(k, n):
        return 1.0 + 0.02 * jax.random.normal(k, (DEPTH, n), f32)

    return {
        "x": jax.random.normal(ks[0], (BATCH, SEQ, D_MODEL), f32),
        "p": jax.random.normal(ks[1], (DEPTH, BATCH, SEQ, PLE_DIM), f32),
        "g_ffn1": gain(ks[2], D_MODEL),
        "w_ffn1_gate": w(ks[3], (DEPTH, D_MODEL, D_FF), D_MODEL),
        "w_ffn1_up": w(ks[4], (DEPTH, D_MODEL, D_FF), D_MODEL),
        "w_ffn1_down": w(ks[5], (DEPTH, D_FF, D_MODEL), D_FF),
        "g_mix": gain(ks[6], D_MODEL),
        "w_in": w(ks[7], (DEPTH, D_MODEL, N_IN), D_MODEL),
        "g_q_lat": gain(ks[8], MLA_Q_RANK),
        "w_q_up": w(ks[9], (DEPTH, MLA_Q_RANK, MLA_HEADS * MLA_QK), MLA_Q_RANK),
        "g_kv_lat": gain(ks[10], MLA_KV_RANK),
        "w_kv_up": w(ks[11], (DEPTH, MLA_KV_RANK, MLA_HEADS * (MLA_NOPE + MLA_V)), MLA_KV_RANK),
        "g_mla_q": gain(ks[12], MLA_QK),
        "g_mla_k": gain(ks[13], MLA_QK),
        "g_diff_q": gain(ks[14], DIFF_QK),
        "g_diff_k": gain(ks[15], DIFF_QK),
        "lambda_q1": 0.1 * jax.random.normal(ks[16], (DEPTH, DIFF_QK), f32),
        "lambda_k1": 0.1 * jax.random.normal(ks[17], (DEPTH, DIFF_QK), f32),
        "lambda_q2": 0.1 * jax.random.normal(ks[18], (DEPTH, DIFF_QK), f32),
        "lambda_k2": 0.1 * jax.random.normal(ks[19], (DEPTH, DIFF_QK), f32),
        "g_diff_sub": gain(ks[20], DIFF_V),
        "w_out": w(ks[21], (DEPTH, MIX_WIDTH, D_MODEL), MIX_WIDTH),
        "g_ffn2": gain(ks[22], D_MODEL),
        "w_ffn2_gate": w(ks[23], (DEPTH, D_MODEL, D_FF), D_MODEL),
        "w_ffn2_up": w(ks[24], (DEPTH, D_MODEL, D_FF), D_MODEL),
        "w_ffn2_down": w(ks[25], (DEPTH, D_FF, D_MODEL), D_FF),
        "g_ple_in": gain(ks[26], D_MODEL),
        "w_ple_gate": w(ks[27], (DEPTH, D_MODEL, D_MODEL), D_MODEL),
        "b_ple_gate": 0.02 * jax.random.normal(ks[28], (DEPTH, D_MODEL), f32),
        "w_ple_proj": w(ks[29], (DEPTH, PLE_DIM, D_MODEL), PLE_DIM),
        "g_ple_out": gain(ks[30], D_MODEL),
    }


def reference(x, p, g_ffn1, w_ffn1_gate, w_ffn1_up, w_ffn1_down, g_mix, w_in, g_q_lat, w_q_up,
              g_kv_lat, w_kv_up, g_mla_q, g_mla_k, g_diff_q, g_diff_k, lambda_q1, lambda_k1,
              lambda_q2, lambda_k2, g_diff_sub, w_out, g_ffn2, w_ffn2_gate, w_ffn2_up, w_ffn2_down,
              g_ple_in, w_ple_gate, b_ple_gate, w_ple_proj, g_ple_out):
    S = x.shape[1]
    cos, sin = rope_tables(S, x.dtype)
    slopes = 2.0 ** (-8.0 * jnp.arange(1, DIFF_HEADS + 1, dtype=jnp.float32) / DIFF_HEADS)
    h = x
    for i in range(DEPTH):
        lambda_init = 0.8 - 0.6 * math.exp(-0.3 * i)
        h = h + 0.5 * swiglu(rms_norm(h, g_ffn1[i]), w_ffn1_gate[i], w_ffn1_up[i], w_ffn1_down[i])
        u = rms_norm(h, g_mix[i]) @ w_in[i]
        q_lat, kv_lat, k_rope, qd, kd, vd = jnp.split(u, IN_OFFSETS, axis=-1)
        o_mla = mla_mixer(q_lat, kv_lat, k_rope, g_q_lat[i], w_q_up[i], g_kv_lat[i], w_kv_up[i],
                          g_mla_q[i], g_mla_k[i], cos, sin)
        o_diff = diff_mixer(qd, kd, vd, g_diff_q[i], g_diff_k[i], lambda_q1[i], lambda_k1[i],
                            lambda_q2[i], lambda_k2[i], g_diff_sub[i], slopes, lambda_init)
        h = h + jnp.concatenate([o_mla, o_diff], axis=-1) @ w_out[i]
        h = h + 0.5 * swiglu(rms_norm(h, g_ffn2[i]), w_ffn2_gate[i], w_ffn2_up[i], w_ffn2_down[i])
        gate = jax.nn.sigmoid(rms_norm(h, g_ple_in[i]) @ w_ple_gate[i] + b_ple_gate[i])
        h = h + gate * rms_norm(p[i] @ w_ple_proj[i], g_ple_out[i])
    return h
```

```cpp
#define MK_HAVE_MIX
#define MK_HAVE_TAIL
#include <hip/hip_runtime.h>
#include <hip/hip_bf16.h>
#include <cstdio>
#include <cstdint>
#include <cstring>

namespace mk {
constexpr int BATCH = 2, SEQ = 8192, DM = 1024, M = BATCH * SEQ, DFF = 2816, PLE = 256, NIN = 1952;
constexpr float EPS = 1e-6f;
constexpr float LOG2E = 1.4426950408889634f;
constexpr float QSC_MLA = 0.10206207261596577f * LOG2E;
constexpr float QSC_DIFF = 0.125f * LOG2E;
constexpr int NWAVES = 8;

constexpr size_t MiB = 1u << 20;
constexpr size_t WS_CTL = 0, CTL_ZERO_BYTES = 128 * 1024;
constexpr size_t WS_TAB = 1 * MiB;
constexpr size_t WS_S0 = 2 * MiB;
constexpr size_t WS_S1 = WS_S0 + 256 * 1024, WS_S2 = WS_S1 + 256 * 1024, WS_S3 = WS_S2 + 256 * 1024;
constexpr size_t WS_QSS = WS_S3 + 256 * 1024, WS_KSS = WS_QSS + 256 * 1024;
constexpr size_t WS_SPP = WS_KSS + 256 * 1024;
constexpr size_t WS_WGU1 = 5 * MiB;
constexpr size_t WS_WD1 = 16 * MiB;
constexpr size_t WS_WGU2 = 22 * MiB;
constexpr size_t WS_WD2 = 33 * MiB;
constexpr size_t WS_WIN = 39 * MiB;
constexpr size_t WS_WUP = 43 * MiB;
constexpr size_t WS_WOUT = 45 * MiB;
constexpr size_t WS_WPG = 47 * MiB;
constexpr size_t WS_RA = 49 * MiB;
constexpr size_t WS_ACT = WS_RA;
constexpr size_t WS_KROT = WS_RA;
constexpr size_t WS_QD = WS_RA + 1 * MiB, WS_KD = WS_QD + 16 * MiB, WS_VD = WS_KD + 16 * MiB;
constexpr size_t WS_QM = WS_VD + 16 * MiB;
constexpr size_t WS_KVM = WS_QM + 24 * MiB;
constexpr size_t WS_LATP = WS_KVM + 32 * MiB;
constexpr size_t WS_OCAT = WS_LATP;
constexpr size_t WS_HB = WS_OCAT + 32 * MiB;
constexpr size_t WS_PP = WS_HB + 32 * MiB;
constexpr size_t WS_END = WS_PP + 32 * MiB;
constexpr size_t WS_PB0 = WS_END;
__host__ __device__ __forceinline__ size_t pb_panel_off(int pm) {
    if (pm < 48) return WS_PB0 + (size_t)pm * 131072;
    const int h = (pm - 48) >> 2; const size_t hb = h == 0 ? WS_SPP + 1 * MiB : (h == 1 ? WS_WD1 + 5632 * 1024 : (h == 2 ? WS_WD2 + 5632 * 1024 : WS_WUP + 1408 * 1024));
    return hb + (size_t)((pm - 48) & 3) * 131072;
}
static_assert(WS_PB0 + 48 * 131072 <= 256 * MiB && WS_SPP + 1 * MiB + 4 * 131072 <= WS_WGU1 && WS_WD1 + 5632 * 1024 + 4 * 131072 <= WS_WGU2 && WS_WD2 + 5632 * 1024 + 4 * 131072 <= WS_WIN && WS_WUP + 1408 * 1024 + 4 * 131072 <= WS_WOUT, "p-bf16 panels");
static_assert(WS_LATP >= WS_RA + 88 * MiB, "LATP must be clear of ACT");
static_assert(WS_END <= 256 * MiB, "d_ws map");
constexpr int CW_TMO = 0, CW_CODE = 1;
constexpr int CW_BAR = 4096;

constexpr int RING_OFF = 0, RING_BYTES = 131072;
constexpr int LDSCTL_OFF = RING_BYTES, MISC_OFF = LDSCTL_OFF + 320;
constexpr int LDS_BYTES = 147456;
constexpr int ROWSC_OFF = RING_BYTES + 4096;

#define GAS __attribute__((address_space(1)))
#define LAS __attribute__((address_space(3)))
typedef unsigned short bf16;
typedef unsigned v4u __attribute__((ext_vector_type(4)));
typedef unsigned v2u __attribute__((ext_vector_type(2)));
typedef float f32x4 __attribute__((ext_vector_type(4)));
typedef float f32x2 __attribute__((ext_vector_type(2)));
typedef short bf16x8 __attribute__((ext_vector_type(8)));
typedef GAS unsigned gu32;
#define RLX_AGENT __ATOMIC_RELAXED, __HIP_MEMORY_SCOPE_AGENT
#define LDS_WAIT() asm volatile("s_waitcnt lgkmcnt(0)" ::: "memory")
#define VM_WAIT() asm volatile("s_waitcnt vmcnt(0)" ::: "memory")
__device__ __forceinline__ unsigned cvt_pk_bf16(float lo, float hi) { unsigned r; asm volatile("v_cvt_pk_bf16_f32 %0, %1, %2" : "=v"(r) : "v"(lo), "v"(hi)); return r; }
__device__ __forceinline__ void st16_wt(void* p, v4u v) { asm volatile("global_store_dwordx4 %0, %1, off sc1\n\ts_nop 1" :: "v"(p), "v"(v) : "memory"); }
__device__ __forceinline__ void st8_wt(void* p, v2u v) { asm volatile("global_store_dwordx2 %0, %1, off sc1\n\ts_nop 1" :: "v"(p), "v"(v) : "memory"); }
__device__ __forceinline__ float bf_lo(unsigned w) { return __uint_as_float(w << 16); }
__device__ __forceinline__ float bf_hi(unsigned w) { return __uint_as_float(w & 0xffff0000u); }
__device__ __forceinline__ float wave_sum(float v) {
#pragma unroll
    for (int o = 1; o < 64; o <<= 1) v += __shfl_xor(v, o);
    return v;
}
__device__ __forceinline__ float fast_sigmoid(float x) { return __builtin_amdgcn_rcpf(1.f + __builtin_amdgcn_exp2f(-x * LOG2E)); }

#define XB_TMO      128
#define XB_XCNT(j)  (256  + 64 * (j))
#define XB_XSUB(j)  (1280 + 64 * (j))
#define XB_XGEN(j)  (2304 + 64 * (j))
#define XB_TOP      3328
#define XB_TOPGEN   3392
#define XCD_BAR_WORDS 3456
#define XB_SPIN_CAP (1u << 18)
__device__ __forceinline__ unsigned xb_ld(unsigned* p)              { return __hip_atomic_load(p, __ATOMIC_RELAXED, __HIP_MEMORY_SCOPE_AGENT); }
__device__ __forceinline__ unsigned xb_add(unsigned* p, unsigned v) { return __hip_atomic_fetch_add(p, v, __ATOMIC_RELAXED, __HIP_MEMORY_SCOPE_AGENT); }
__device__ __forceinline__ unsigned xb_xcc_id() { return (unsigned)__builtin_amdgcn_s_getreg((3 << 11) | 20) & 0xFu; }
#define XB_SPIN(cond, bar) do { unsigned _sp = 0; while (cond) { __builtin_amdgcn_s_sleep(1); \
    if ((++_sp & 255u) == 0u) { if (xb_ld(&(bar)[XB_TMO])) break; if (_sp > XB_SPIN_CAP) { atomicAdd(&(bar)[XB_TMO], 1u); break; } } } } while (0)
struct XcdBarrier { unsigned* bar; unsigned x; volatile LAS unsigned* st; };
__device__ __forceinline__ XcdBarrier xcd_barrier_post(unsigned* bar, volatile LAS unsigned* st) {
    XcdBarrier b; b.bar = bar; b.x = xb_xcc_id(); b.st = st;
    if (threadIdx.x == 0) (void)xb_add(&bar[XB_XCNT(b.x)], 1u);
    return b;
}
__device__ __forceinline__ void xcd_barrier_complete(unsigned* bar, unsigned x, unsigned& nloc, unsigned& nx) {
    const unsigned G = gridDim.x * gridDim.y * gridDim.z;
    unsigned sum, cnt, mine, sp = 0u;
    for (;;) {
        sum = 0u; cnt = 0u; mine = 0u;
#pragma unroll
        for (unsigned j = 0; j < 16; ++j) { const unsigned c = xb_ld(&bar[XB_XCNT(j)]); sum += c; cnt += (c > 0u) ? 1u : 0u; mine = (j == x) ? c : mine; }
        if (sum == G) break;
        __builtin_amdgcn_s_sleep(1);
        if ((++sp & 255u) == 0u) { if (xb_ld(&bar[XB_TMO])) break; if (sp > XB_SPIN_CAP) { atomicAdd(&bar[XB_TMO], 1u); break; } }
    }
    nloc = mine > 0u ? mine : 1u; nx = cnt > 0u ? cnt : 1u;
}
__device__ __forceinline__ void xcd_barrier(const XcdBarrier& b) {
    asm volatile("s_waitcnt vmcnt(0)" ::: "memory");
    __syncthreads();
    if (threadIdx.x == 0) {
        unsigned* bar = b.bar;
        __builtin_amdgcn_s_waitcnt(0);
        unsigned nloc = b.st[0], nx = b.st[1];
        if (nloc == 0u) { xcd_barrier_complete(bar, b.x, nloc, nx); b.st[0] = nloc; b.st[1] = nx; }
        const unsigned old = xb_add(&bar[XB_XSUB(b.x)], 1u);
        const unsigned gen = old / nloc;
        if (old + 1u == (gen + 1u) * nloc) {
            __builtin_amdgcn_fence(__ATOMIC_RELEASE, "agent");
            asm volatile("s_waitcnt vmcnt(0)" ::: "memory");
            const unsigned og = xb_add(&bar[XB_TOP], 1u);
            const unsigned tg = og / nx;
            if (og + 1u == (tg + 1u) * nx) xb_add(&bar[XB_TOPGEN], 1u);
            else XB_SPIN(xb_ld(&bar[XB_TOPGEN]) == tg, bar);
            __builtin_amdgcn_fence(__ATOMIC_ACQUIRE, "agent");
            xb_add(&bar[XB_XGEN(b.x)], 1u);
            asm volatile("s_waitcnt vmcnt(0)" ::: "memory");
        } else {
            XB_SPIN(xb_ld(&bar[XB_XGEN(b.x)]) == gen, bar);
            __builtin_amdgcn_fence(__ATOMIC_ACQUIRE, "agent");
            asm volatile("s_waitcnt vmcnt(0)" ::: "memory");
        }
    }
    __syncthreads();
}

#define GB_X(g)   (4096 + 16 * (g))
#define GB_CNT(g) (4352 + 64 * (g))
#define GB_GEN(g) (4864 + 64 * (g))
#define XCD_BAR_STRIDE 8192
struct GrpBarrier { unsigned* ctl; unsigned* tmo; unsigned g, x; volatile LAS unsigned* st; };
__device__ __forceinline__ GrpBarrier grp_barrier_post(unsigned* ctl, unsigned* tmo, unsigned x, volatile LAS unsigned* st) {
    GrpBarrier b; b.ctl = ctl; b.tmo = tmo; b.g = blockIdx.x & 7u; b.x = x; b.st = st;
    if (threadIdx.x == 0) (void)xb_add(&ctl[GB_X(b.g) + x], 1u);
    return b;
}
__device__ __forceinline__ void grp_barrier(const GrpBarrier& b) {
    asm volatile("s_waitcnt vmcnt(0)" ::: "memory");
    __syncthreads();
    if (threadIdx.x == 0) {
        unsigned* ctl = b.ctl;
        __builtin_amdgcn_s_waitcnt(0);
        unsigned mode = b.st[0];
        if (mode == 0u) {
            unsigned sp = 0u, sum, mine;
            for (;;) {
                sum = 0u; mine = 0u;
#pragma unroll
                for (unsigned j = 0; j < 16; ++j) { const unsigned c_ = xb_ld(&ctl[GB_X(b.g) + j]); sum += c_; mine = (j == b.x) ? c_ : mine; }
                if (sum == 32u) break;
                __builtin_amdgcn_s_sleep(1);
                if ((++sp & 255u) == 0u) { if (xb_ld(&b.tmo[XB_TMO])) break; if (sp > XB_SPIN_CAP) { atomicAdd(&b.tmo[XB_TMO], 1u); break; } }
            }
            mode = (sum == 32u && mine == 32u) ? 1u : 2u; b.st[0] = mode;
        }
        if (mode != 1u) __builtin_amdgcn_fence(__ATOMIC_RELEASE, "agent");
        asm volatile("s_waitcnt vmcnt(0)" ::: "memory");
        const unsigned old = xb_add(&ctl[GB_CNT(b.g)], 1u), gen = old / 32u;
        if (old + 1u == (gen + 1u) * 32u) xb_add(&ctl[GB_GEN(b.g)], 1u);
        else XB_SPIN(xb_ld(&ctl[GB_GEN(b.g)]) == gen, b.tmo);
        __builtin_amdgcn_fence(__ATOMIC_ACQUIRE, "agent");
        asm volatile("s_waitcnt vmcnt(0)" ::: "memory");
    }
    __syncthreads();
}

namespace pg8 {
constexpr int BM = 256, BK = 64, HALF = 128, HTB = HALF * BK * 2, STAGE_BYTES = 8 * HTB, NXCD = 8, WGM = 8;
__host__ __device__ __forceinline__ int lds_byte(int r, int c) { const int st = (r >> 4) * 2 + (c >> 5), rr = r & 15, cc = c & 31, ob = rr * 64 + cc * 2; return st * 1024 + (ob ^ (((ob >> 9) & 1) << 5)); }
__host__ __device__ __forceinline__ void stage_rc(int b, int& R, int& C) { const int st = b / 1024, sb = b % 1024, swz = sb ^ (((sb >> 9) & 1) << 5); R = (st >> 1) * 16 + swz / 64; C = (st & 1) * 32 + (swz % 64) / 2; }
__host__ __device__ __forceinline__ int perm32(int rho) { const int n = rho >> 4, i = rho & 15; return 8 * (i >> 2) + 4 * n + (i & 3); }
struct Unit { int pm, pn; };
struct Gemm { const bf16* A; const bf16* Bt; int M, N, K, lda; int pnA, acolA, pnB, acolB; int pmap;
    __device__ __forceinline__ int acol(int pn) const { return pn < pnA ? 0 : (pn < pnB ? acolA : acolB); }
    __device__ __forceinline__ const char* apanel(int pm, size_t tstepA) const { return pmap ? (const char*)A + pb_panel_off(pm) : (const char*)A + (size_t)pm * tstepA; } };
struct StaticOrder {
    int nM, nN, nwg, G, c;
    __host__ __device__ void init(int M, int N, int G_, int c_) { nM = M / BM; nN = N / BM; nwg = nM * nN; G = G_; c = c_; }
    __host__ __device__ bool next(int i, Unit& u) const {
        const long L = (long)i * G + c; if (L >= nwg) return false;
        int wgid = (int)L; { const int q = nwg / NXCD, r = nwg % NXCD, xcd = wgid % NXCD, off = wgid / NXCD; wgid = (xcd < r ? xcd * (q + 1) : r * (q + 1) + (xcd - r) * q) + off; }
        const int nig = WGM * nN, gid = wgid / nig, fm = gid * WGM, gsz = (nM - fm) < WGM ? (nM - fm) : WGM;
        u.pm = fm + ((wgid % nig) % gsz); u.pn = (wgid % nig) / gsz; return true;
    }
};
typedef f32x4 Acc[2][2][4][2];

template <class Epi, bool ALIGN_EPI>
__device__ __forceinline__ void gemm_phase(LAS unsigned char* lds, const Gemm g, const StaticOrder& S, const Epi& E) {
    const int tid = threadIdx.x, wid = __builtin_amdgcn_readfirstlane(tid >> 6), lane = tid & 63, wr = wid >> 2, wc = wid & 3, fr = lane & 15, fq = lane >> 4;
    const int K = g.K, nt = K / BK, lda = g.lda;
    unsigned voffA[2], voffB[2];
#pragma unroll
    for (int i = 0; i < 2; ++i) { int R, C; stage_rc(tid * 16 + i * 8192, R, C); const int Rb = Epi::PERM ? ((R & ~31) + perm32(R & 31)) : R;
        voffA[i] = (unsigned)(R * lda + C) * 2u; voffB[i] = (unsigned)(Rb * K + C) * 2u; }
    const size_t kstep = (size_t)(BK * 2);
    const size_t hstepA = (size_t)HALF * lda * 2, hstepB = (size_t)HALF * K * 2;
    const size_t tstepA = 2 * hstepA, tstepB = 2 * hstepB;
    const unsigned ldsw = (unsigned)wid * 1024u;
    const int aoff = lds_byte(wr * 64 + fr, fq * 8), boff = lds_byte(wc * 32 + fr, fq * 8);
#define PG8_SA(b, h) (((b) * 2 + (h)) * HTB)
#define PG8_SB(b, h) ((4 + (b) * 2 + (h)) * HTB)
#define PG8_STAGE(bufoff, gbase, voff) do { _Pragma("unroll") for (int _i = 0; _i < 2; ++_i) \
        __builtin_amdgcn_global_load_lds((const unsigned*)((const char*)(gbase) + (voff)[_i]), (LAS unsigned*)(lds + (bufoff) + ldsw + _i * 8192), 16, 0, 0); } while (0)
#define PG8_LDA(dst, b, h) do { _Pragma("unroll") for (int m = 0; m < 4; ++m) _Pragma("unroll") for (int k = 0; k < 2; ++k) dst[m][k] = *(const LAS bf16x8*)(lds + PG8_SA(b, h) + aoff + m * 2048 + k * 1024); } while (0)
#define PG8_LDB(dst, b, h) do { _Pragma("unroll") for (int n = 0; n < 2; ++n) _Pragma("unroll") for (int k = 0; k < 2; ++k) dst[n][k] = *(const LAS bf16x8*)(lds + PG8_SB(b, h) + boff + n * 2048 + k * 1024); } while (0)
#define PG8_MMA(ai, bj, At, Bt) do { __builtin_amdgcn_s_setprio(1); _Pragma("unroll") for (int m = 0; m < 4; ++m) _Pragma("unroll") for (int n = 0; n < 2; ++n) _Pragma("unroll") for (int k = 0; k < 2; ++k) \
        acc[ai][bj][m][n] = __builtin_amdgcn_mfma_f32_16x16x32_bf16(Bt[n][k], At[m][k], acc[ai][bj][m][n], 0, 0, 0); __builtin_amdgcn_s_setprio(0); } while (0)
#define PG8_WAIT_V(n) asm volatile("s_waitcnt vmcnt(" #n ")" ::: "memory")
#define PG8_WAIT_L(n) asm volatile("s_waitcnt lgkmcnt(" #n ")" ::: "memory")
#define PG8_BAR __builtin_amdgcn_s_barrier()
#define PG8_SCHED __builtin_amdgcn_sched_barrier(0)
    Unit cur, nxt; int ui = 0;
    if (!S.next(0, cur)) return;
    f32x4 acc[2][2][4][2];
#pragma unroll
    for (int a = 0; a < 2; ++a)
#pragma unroll
        for (int b = 0; b < 2; ++b)
#pragma unroll
            for (int m = 0; m < 4; ++m)
#pragma unroll
                for (int n = 0; n < 2; ++n) acc[a][b][m][n] = (f32x4){0.f, 0.f, 0.f, 0.f};
    bf16x8 At[4][2], B0[2][2], B1[2][2];
    const char* cA = g.apanel(cur.pm, tstepA) + (size_t)g.acol(cur.pn) * 2; const char* cB = (const char*)g.Bt + (size_t)cur.pn * tstepB;
    PG8_STAGE(PG8_SB(0, 0), cB, voffB); PG8_STAGE(PG8_SB(0, 1), cB + hstepB, voffB); PG8_STAGE(PG8_SA(0, 0), cA, voffA); PG8_STAGE(PG8_SA(0, 1), cA + hstepA, voffA);
    if (wr == 1) PG8_BAR;
    PG8_WAIT_V(2); PG8_BAR;
    PG8_STAGE(PG8_SB(1, 0), cB + kstep, voffB); PG8_STAGE(PG8_SA(1, 0), cA + kstep, voffA); PG8_STAGE(PG8_SB(1, 1), cB + hstepB + kstep, voffB);
    PG8_WAIT_V(6); PG8_BAR;
    for (;;) {
        const bool has_next = S.next(ui + 1, nxt);
        const char* nA = has_next ? g.apanel(nxt.pm, tstepA) + (size_t)g.acol(nxt.pn) * 2 : cA; const char* nB = has_next ? (const char*)g.Bt + (size_t)nxt.pn * tstepB : cB;
        for (int t = 0; t < nt; t += 2) {
            const bool last = (t == nt - 2);
            const char* a1 = cA + (size_t)(t + 1) * kstep;
            const char* a2 = last ? nA : cA + (size_t)(t + 2) * kstep; const char* b2 = last ? nB : cB + (size_t)(t + 2) * kstep;
            const char* a3 = a2 + kstep; const char* b3 = b2 + kstep;
            f32x4 praw;
            if constexpr (Epi::PRE) { if (last) { const float* pp_ = E.pre_addr(cur, wid, lane); asm volatile("global_load_dwordx4 %0, %1, off" : "=v"(praw) : "v"(pp_) : "memory"); } }
            PG8_LDB(B0, 0, 0); PG8_LDB(B1, 0, 1); PG8_SCHED; PG8_LDA(At, 0, 0); PG8_STAGE(PG8_SA(1, 1), a1 + hstepA, voffA);
            PG8_WAIT_V(8); PG8_WAIT_L(0); PG8_BAR; PG8_MMA(0, 0, At, B0); PG8_MMA(0, 1, At, B1); PG8_BAR; PG8_SCHED;
            PG8_LDA(At, 0, 1); PG8_STAGE(PG8_SB(0, 0), b2, voffB); PG8_STAGE(PG8_SB(0, 1), b2 + hstepB, voffB); PG8_STAGE(PG8_SA(0, 0), a2, voffA);
            PG8_WAIT_V(8); PG8_WAIT_L(0); PG8_BAR; PG8_MMA(1, 0, At, B0); PG8_MMA(1, 1, At, B1); PG8_BAR; PG8_SCHED;
            PG8_LDB(B0, 1, 0); PG8_LDB(B1, 1, 1); PG8_SCHED; PG8_LDA(At, 1, 0); PG8_STAGE(PG8_SA(0, 1), a2 + hstepA, voffA);
            PG8_WAIT_V(8); PG8_WAIT_L(0); PG8_BAR; PG8_MMA(0, 0, At, B0); PG8_MMA(0, 1, At, B1); PG8_BAR; PG8_SCHED;
            PG8_LDA(At, 1, 1); PG8_STAGE(PG8_SB(1, 0), b3, voffB); PG8_STAGE(PG8_SB(1, 1), b3 + hstepB, voffB); PG8_STAGE(PG8_SA(1, 0), a3, voffA);
            PG8_WAIT_V(8);
            if constexpr (Epi::PRE) { if (last) { asm volatile("" : "+v"(praw)); E.pre_store(praw, (LAS float*)(lds + ROWSC_OFF), wid, lane); } }
            PG8_WAIT_L(0); PG8_BAR; PG8_MMA(1, 0, At, B0); PG8_MMA(1, 1, At, B1); PG8_BAR; PG8_SCHED;
        }
        if constexpr (ALIGN_EPI) { if (wr == 0) PG8_BAR; }
        if constexpr (Epi::PRE) { static_assert(ALIGN_EPI, "PRE needs the aligned epilogue"); E(acc, cur, wr, wc, fr, fq, (const LAS float*)(lds + ROWSC_OFF)); }
        else if constexpr (!Epi::AFTER_DRAIN) { E(acc, cur, wr, wc, fr, fq); }
        if (!has_next) break;
#pragma unroll
        for (int a = 0; a < 2; ++a)
#pragma unroll
            for (int b = 0; b < 2; ++b)
#pragma unroll
                for (int m = 0; m < 4; ++m)
#pragma unroll
                    for (int n = 0; n < 2; ++n) acc[a][b][m][n] = (f32x4){0.f, 0.f, 0.f, 0.f};
        cur = nxt; cA = nA; cB = nB; ++ui;
        if constexpr (ALIGN_EPI) { if (wr == 1) PG8_BAR; }
    }
    PG8_WAIT_V(0);
    if constexpr (!ALIGN_EPI) { if (wr == 0) PG8_BAR; }
    PG8_BAR;
    if constexpr (Epi::AFTER_DRAIN) { E.fused(acc, cur, wr, wc, fr, fq, lds, wid, lane); }
#undef PG8_SA
#undef PG8_SB
#undef PG8_STAGE
#undef PG8_LDA
#undef PG8_LDB
#undef PG8_MMA
#undef PG8_WAIT_V
#undef PG8_WAIT_L
#undef PG8_BAR
#undef PG8_SCHED
}
}
}
namespace mk {
namespace pg8 {
__device__ __forceinline__ float rstd4(const float* ssq, int row, float inv_n) { const f32x4 s = *(const f32x4*)(ssq + (size_t)row * 4); return __builtin_amdgcn_rsqf(((s.x + s.y) + (s.z + s.w)) * inv_n + EPS); }

struct EpiSwiglu {
    static constexpr bool PERM = true, AFTER_DRAIN = false, PRE = true;
    bf16* O; const float* ssq;
    __device__ __forceinline__ const float* pre_addr(const Unit& u, int wid, int lane) const { return ssq + (size_t)(u.pm * BM + wid * 32 + (lane & 31)) * 4; }
    __device__ __forceinline__ void pre_store(const f32x4 s, LAS float* rowsc, int wid, int lane) const { if (lane < 32) rowsc[wid * 32 + lane] = ((s.x + s.y) + (s.z + s.w)) * (1.f / DM) + EPS; }
    __device__ __forceinline__ void operator()(const Acc& acc, const Unit& u, int wr, int wc, int fr, int fq, const LAS float* rowsc) const {
        asm volatile("" : "+v"(fr), "+v"(fq));
        const int row0 = u.pm * BM + wr * 64 + fr, col0 = u.pn * HALF + wc * 32 + 8 * fq;
        const LAS float* rsc = rowsc + wr * 64 + fr;
        float ms[2][4];
#pragma unroll
        for (int ai = 0; ai < 2; ++ai)
#pragma unroll
            for (int m = 0; m < 4; ++m) ms[ai][m] = rsc[ai * HALF + m * 16];
#pragma unroll
        for (int ai = 0; ai < 2; ++ai)
#pragma unroll
            for (int m = 0; m < 4; ++m) { const int row = row0 + ai * HALF + m * 16; const float msq = ms[ai][m], nr = __builtin_amdgcn_rsqf(msq) * -LOG2E;
                const f32x2 ms2 = {msq, msq}, nr2 = {nr, nr};
                unsigned w[4];
#pragma unroll
                for (int n = 0; n < 2; ++n)
#pragma unroll
                    for (int h = 0; h < 2; ++h) { const f32x4 ga = acc[ai][0][m][n], ua = acc[ai][1][m][n];
                        const f32x2 gt = h ? (f32x2){ga.z, ga.w} : (f32x2){ga.x, ga.y}, up = h ? (f32x2){ua.z, ua.w} : (f32x2){ua.x, ua.y};
                        const f32x2 t = gt * nr2;
                        const f32x2 ex = {__builtin_amdgcn_exp2f(t.x), __builtin_amdgcn_exp2f(t.y)};
                        const f32x2 d = __builtin_elementwise_fma(ex, ms2, ms2);
                        const f32x2 rc = {__builtin_amdgcn_rcpf(d.x), __builtin_amdgcn_rcpf(d.y)};
                        const f32x2 o = (gt * up) * rc;
                        w[n * 2 + h] = cvt_pk_bf16(o.x, o.y); }
                v4u wv; wv.x = w[0]; wv.y = w[1]; wv.z = w[2]; wv.w = w[3];
                *(v4u*)(O + (size_t)row * DFF + col0) = wv; }
    }
};

template <bool BASE_BF16> struct EpiResid {
    static constexpr bool PERM = false, AFTER_DRAIN = true, PRE = false;
    const void* base; bf16* hb; float* ssq_out; float sc; int pad;
    __device__ __forceinline__ void fused(const Acc& acc, const Unit& u, int wr, int wc, int fr, int fq, LAS unsigned char* lds, int wid, int lane) const {
        LAS float* P = (LAS float*)lds;
        const int col0 = u.pn * BM + wc * 32 + 4 * fq;
#pragma unroll
        for (int ai = 0; ai < 2; ++ai)
#pragma unroll
            for (int m = 0; m < 4; ++m) { const int rl = ai * HALF + wr * 64 + m * 16 + fr; const size_t off = (size_t)(u.pm * BM + rl) * DM + col0; float s = 0.f;
#pragma unroll
                for (int bj = 0; bj < 2; ++bj)
#pragma unroll
                    for (int n = 0; n < 2; ++n) { const size_t o2 = off + bj * HALF + n * 16; f32x4 b;
                        if (BASE_BF16) { const v2u pw = *(const v2u*)((const bf16*)base + o2); b = (f32x4){bf_lo(pw.x), bf_hi(pw.x), bf_lo(pw.y), bf_hi(pw.y)}; } else b = *(const f32x4*)((const float*)base + o2);
                        const f32x4 o = b + acc[ai][bj][m][n] * sc;
                        v2u w; w.x = cvt_pk_bf16(o[0], o[1]); w.y = cvt_pk_bf16(o[2], o[3]); *(v2u*)(hb + o2) = w;
                        s += (o[0] * o[0] + o[1] * o[1]) + (o[2] * o[2] + o[3] * o[3]); }
                s += __shfl_xor(s, 16); s += __shfl_xor(s, 32);
                if (fq == 0) P[rl * 4 + wc] = s;
                if (m == 3) asm volatile("" ::: "memory"); }
        asm volatile("s_waitcnt lgkmcnt(0)" ::: "memory"); __builtin_amdgcn_s_barrier(); asm volatile("" ::: "memory");
        const int t = wid * 64 + lane;
        if (t < 256) { const f32x4 p = *(const LAS f32x4*)(P + t * 4); ssq_out[(size_t)(u.pm * BM + t) * 4 + u.pn] = (p.x + p.y) + (p.z + p.w); }
    }
};

struct EpiPle {
    static constexpr bool PERM = false, AFTER_DRAIN = false, PRE = false;
    const bf16* base; float* out; const float* ssq3; const float* spp; const bf16* pp; const float* bias; const float* gout;
    __device__ __forceinline__ void operator()(const Acc& acc, const Unit& u, int wr, int wc, int fr, int fq) const {
        asm volatile("" : "+v"(fr), "+v"(fq));
        const int col0 = u.pn * BM + wc * 32 + 4 * fq;
        f32x4 nb[2][2], gv[2][2];
#pragma unroll
        for (int bj = 0; bj < 2; ++bj)
#pragma unroll
            for (int n = 0; n < 2; ++n) { nb[bj][n] = *(const f32x4*)(bias + col0 + bj * HALF + n * 16) * -LOG2E; gv[bj][n] = *(const f32x4*)(gout + col0 + bj * HALF + n * 16); }
        float nr3s[2][4], rpps[2][4];
#pragma unroll
        for (int ai = 0; ai < 2; ++ai)
#pragma unroll
            for (int m = 0; m < 4; ++m) { const int row = u.pm * BM + ai * HALF + wr * 64 + m * 16 + fr;
                nr3s[ai][m] = rstd4(ssq3, row, 1.f / DM) * -LOG2E;
                const f32x4 a = *(const f32x4*)(spp + (size_t)row * 16), b = *(const f32x4*)(spp + (size_t)row * 16 + 4), c = *(const f32x4*)(spp + (size_t)row * 16 + 8), d = *(const f32x4*)(spp + (size_t)row * 16 + 12);
                const float sp = (((a.x + a.y) + (a.z + a.w)) + ((b.x + b.y) + (b.z + b.w))) + (((c.x + c.y) + (c.z + c.w)) + ((d.x + d.y) + (d.z + d.w)));
                rpps[ai][m] = __builtin_amdgcn_rsqf(sp * (1.f / DM) + EPS); }
#pragma unroll
        for (int ai = 0; ai < 2; ++ai)
#pragma unroll
            for (int m = 0; m < 4; ++m) { const int row = u.pm * BM + ai * HALF + wr * 64 + m * 16 + fr; const size_t off = (size_t)row * DM + col0;
                const f32x2 nr3 = {nr3s[ai][m], nr3s[ai][m]}, rpp = {rpps[ai][m], rpps[ai][m]}, one = {1.f, 1.f};
#pragma unroll
                for (int bj = 0; bj < 2; ++bj)
#pragma unroll
                    for (int n = 0; n < 2; ++n) { const size_t o2 = off + bj * HALF + n * 16; const v2u hw = *(const v2u*)(base + o2); const v2u pw = *(const v2u*)(pp + o2);
                        const f32x4 a4 = acc[ai][bj][m][n], b4 = nb[bj][n], g4 = gv[bj][n]; f32x4 o;
#pragma unroll
                        for (int h = 0; h < 2; ++h) {
                            const f32x2 a = h ? (f32x2){a4.z, a4.w} : (f32x2){a4.x, a4.y}, b = h ? (f32x2){b4.z, b4.w} : (f32x2){b4.x, b4.y}, g = h ? (f32x2){g4.z, g4.w} : (f32x2){g4.x, g4.y};
                            const unsigned hx = h ? hw.y : hw.x, px = h ? pw.y : pw.x;
                            const f32x2 hv = {bf_lo(hx), bf_hi(hx)}, pv = {bf_lo(px), bf_hi(px)};
                            const f32x2 t = __builtin_elementwise_fma(a, nr3, b);
                            const f32x2 d = (f32x2){__builtin_amdgcn_exp2f(t.x), __builtin_amdgcn_exp2f(t.y)} + one;
                            const f32x2 rc = {__builtin_amdgcn_rcpf(d.x), __builtin_amdgcn_rcpf(d.y)};
                            const f32x2 r = __builtin_elementwise_fma(rc, (pv * rpp) * g, hv);
                            if (h) { o.z = r.x; o.w = r.y; } else { o.x = r.x; o.y = r.y; } }
                        __builtin_nontemporal_store(o, (f32x4*)(out + o2)); }
                if (m == 3) asm volatile("" ::: "memory"); }
    }
};
}
}
namespace mk {
struct Frame {
    LAS unsigned char* lds;
    volatile LAS unsigned* MISC;
    gu32* ctl;
    int tid, lane, wave;
    int vcu, G;
    float* out; unsigned char* ws;
};
#define PANEL_BAR() do { if (F.G == 256) { GrpBarrier gb_; gb_.ctl = bar.bar; gb_.tmo = bar.bar; gb_.g = blockIdx.x & 7u; gb_.x = bar.x; gb_.st = F.MISC + 12; grp_barrier(gb_); } else xcd_barrier(bar); } while (0)
__device__ __forceinline__ const float* kin(int i) { return ((const float* const __attribute__((address_space(4)))*)__builtin_amdgcn_kernarg_segment_ptr())[i]; }
enum { I_X = 0, I_P, I_GFFN1, I_W1G, I_W1U, I_W1D, I_GMIX, I_WIN, I_GQLAT, I_WQUP, I_GKVLAT, I_WKVUP, I_GMLAQ, I_GMLAK, I_GDQ, I_GDK, I_LQ1, I_LK1, I_LQ2, I_LK2, I_GSUB, I_WOUT,
       I_GFFN2, I_W2G, I_W2U, I_W2D, I_GPLEIN, I_WPG, I_BPG, I_WPP, I_GPLEOUT };

struct ColSrc { const float* p; int ld; int krows; const float* gain; };
__device__ __forceinline__ int erope(int j) { return 4 * (j >> 3) + (j & 3) + 16 * ((j >> 2) & 1); }
__device__ __forceinline__ ColSrc colsrc(const Frame& F, int id, int np) {
    ColSrc c; c.p = nullptr; c.ld = 0; c.krows = 0; c.gain = nullptr;
    const int t = np >> 8, tc = np & 255, bj = tc >> 7, wc = (tc >> 5) & 3, j = tc & 31, e = 32 * bj + j;
    if (id == 0 || id == 2) { const float* wg = kin(id == 0 ? I_W1G : I_W2G); const float* wu = kin(id == 0 ? I_W1U : I_W2U);
        c.p = (bj ? wu : wg) + 128 * t + (tc & 127); c.ld = DFF; c.krows = DM; c.gain = kin(id == 0 ? I_GFFN1 : I_GFFN2); }
    else if (id == 1 || id == 3) { c.p = kin(id == 1 ? I_W1D : I_W2D) + np; c.ld = DM; c.krows = DFF; }
    else if (id == 4) { int lg = -1;
        if (t == 0) lg = tc;
        else if (t == 1) { if (bj == 0) lg = 256 + tc; else if (wc == 0) lg = 384 + erope(j); }
        else if (t < 4) lg = 416 + 64 * (4 * (t - 2) + wc) + e;
        else if (t < 6) lg = 928 + 64 * (4 * (t - 4) + wc) + e;
        else lg = 1440 + 256 * (t - 6) + tc;
        if (lg >= 0) { c.p = kin(I_WIN) + lg; c.ld = NIN; c.krows = DM; c.gain = kin(I_GMIX); } }
    else if (id == 5) {
        if (t < 2) { c.p = kin(I_WQUP) + 96 * (4 * t + wc) + e; c.ld = 768; c.krows = 256; c.gain = kin(I_GQLAT); }
        else if (t == 2) { c.p = kin(I_WQUP) + 96 * (2 * wc + bj) + 64 + erope(j); c.ld = 768; c.krows = 256; c.gain = kin(I_GQLAT); }
        else if (t < 7) { const int cid = 4 * (t - 3) + wc; c.p = kin(I_WKVUP) + 128 * (cid >> 1) + 64 * (cid & 1) + e; c.ld = 1024; c.krows = 128; c.gain = kin(I_GKVLAT); }
        else { c.p = kin(I_WPP) + 256 * (t - 7) + tc; c.ld = DM; c.krows = 256; } }
    else if (id == 6) { c.p = kin(I_WOUT) + np; c.ld = DM; c.krows = DM; }
    else { c.p = kin(I_WPG) + np; c.ld = DM; c.krows = DM; c.gain = kin(I_GPLEIN); }
    return c;
}
__device__ __forceinline__ void p0_transpose_item(const Frame& F, int id, int K, bf16* WT, LAS float* scr, int kb, int nb, int lane) {
    const int k0 = 64 * kb, n0 = 32 * nb;
    const int cg = lane & 7, kr = lane >> 3;
    const ColSrc cs = colsrc(F, id, n0 + 4 * cg);
#pragma unroll
    for (int i = 0; i < 8; ++i) { const int kk = 8 * i + kr; const int k = k0 + kk; f32x4 v = {0.f, 0.f, 0.f, 0.f};
        if (cs.p != nullptr && k < cs.krows) { v = __builtin_nontemporal_load((const f32x4*)(cs.p + (size_t)k * cs.ld)); if (cs.gain != nullptr) v = v * cs.gain[k]; }
        *(LAS f32x4*)(scr + kk * 36 + 4 * cg) = v; }
    LDS_WAIT(); asm volatile("" ::: "memory");
    const int c = lane & 7;
#pragma unroll
    for (int jj = 0; jj < 4; ++jj) { const int n = (lane >> 3) + 8 * jj; const LAS float* s = scr + (8 * c) * 36 + n;
        v4u o; o.x = cvt_pk_bf16(s[0 * 36], s[1 * 36]); o.y = cvt_pk_bf16(s[2 * 36], s[3 * 36]); o.z = cvt_pk_bf16(s[4 * 36], s[5 * 36]); o.w = cvt_pk_bf16(s[6 * 36], s[7 * 36]);
        *(GAS v4u*)(WT + (size_t)(n0 + n) * K + k0 + 8 * c) = o; }
    LDS_WAIT(); asm volatile("" ::: "memory");
}
__device__ __forceinline__ void sincos_acc(float ang, float& s, float& c) {
    const double a = (double)ang;
    const double k = rint(a * 0.15915494309189535);
    const double r = a - k * 6.283185307179586;
    const double r2 = r * r;
    double ps = 1.0, pc = 1.0;
#pragma unroll
    for (int i = 12; i >= 1; --i) {
        ps = 1.0 - ps * r2 * (1.0 / (double)((2 * i) * (2 * i + 1)));
        pc = 1.0 - pc * r2 * (1.0 / (double)((2 * i - 1) * (2 * i)));
    }
    s = (float)(r * ps); c = (float)pc;
}
__device__ __forceinline__ void p0_convert(Frame& F, int id_lo, int id_hi, int gw, int NGW) {
    LAS float* scr = (LAS float*)(F.lds + RING_OFF + F.wave * 16384);
    constexpr int NMAT = 8;
    const int Ks[NMAT] = {DM, DFF, DM, DFF, DM, 256, DM, DM};
    const int Ns[NMAT] = {2 * DFF, DM, 2 * DFF, DM, 2048, 2816, DM, DM};
    const size_t Ds[NMAT] = {WS_WGU1, WS_WD1, WS_WGU2, WS_WD2, WS_WIN, WS_WUP, WS_WOUT, WS_WPG};
    int base = 0;
#pragma unroll
    for (int id = 0; id < NMAT; ++id) {
        if (id < id_lo || id >= id_hi) continue;
        const int nkb = Ks[id] / 64, nnb = Ns[id] / 32, nit = nkb * nnb;
        int first = base + ((gw - base % NGW) + NGW) % NGW;
        for (int it = first; it < base + nit; it += NGW) { const int r = it - base; p0_transpose_item(F, id, Ks[id], (bf16*)(F.ws + Ds[id]), scr, r / nnb, r % nnb, F.lane); }
        base += nit;
    }
}
__device__ __forceinline__ void p0_prologue(Frame& F) {
    const int gw = F.vcu * NWAVES + F.wave, NGW = F.G * NWAVES;
    p0_convert(F, 0, 2, gw, NGW);
    if (F.G != 256) { p0_convert(F, 2, 8, gw, NGW); }
    const float* x = kin(I_X); const float* p = kin(I_P);
    bf16* HB = (bf16*)(F.ws + WS_HB); float* S0 = (float*)(F.ws + WS_S0);
    for (int m = gw; m < M; m += 2 * NGW) {
        const int m2 = m + NGW;
        const GAS f32x4* xr = (const GAS f32x4*)(x + (size_t)m * DM) + F.lane; const GAS f32x4* xr2 = (const GAS f32x4*)(x + (size_t)m2 * DM) + F.lane;
        f32x4 v[4], w2[4];
#pragma unroll
        for (int j = 0; j < 4; ++j) { v[j] = __builtin_nontemporal_load(xr + 64 * j); w2[j] = __builtin_nontemporal_load(xr2 + 64 * j); }
        const f32x4 pv = __builtin_nontemporal_load((const GAS f32x4*)(p + (size_t)m * PLE) + F.lane), pv2 = __builtin_nontemporal_load((const GAS f32x4*)(p + (size_t)m2 * PLE) + F.lane);
        GAS v2u* o8 = (GAS v2u*)(HB + (size_t)m * DM) + F.lane; GAS v2u* o82 = (GAS v2u*)(HB + (size_t)m2 * DM) + F.lane; float s = 0.f, s2 = 0.f;
#pragma unroll
        for (int j = 0; j < 4; ++j) { s += (v[j].x * v[j].x + v[j].y * v[j].y) + (v[j].z * v[j].z + v[j].w * v[j].w); v2u w; w.x = cvt_pk_bf16(v[j].x, v[j].y); w.y = cvt_pk_bf16(v[j].z, v[j].w); o8[64 * j] = w;
            s2 += (w2[j].x * w2[j].x + w2[j].y * w2[j].y) + (w2[j].z * w2[j].z + w2[j].w * w2[j].w); v2u u; u.x = cvt_pk_bf16(w2[j].x, w2[j].y); u.y = cvt_pk_bf16(w2[j].z, w2[j].w); o82[64 * j] = u; }
        s = wave_sum(s); s2 = wave_sum(s2);
        if (F.lane == 0) { *(GAS f32x4*)(S0 + (size_t)m * 4) = (f32x4){s, 0.f, 0.f, 0.f}; *(GAS f32x4*)(S0 + (size_t)m2 * 4) = (f32x4){s2, 0.f, 0.f, 0.f}; }
        v2u w; w.x = cvt_pk_bf16(pv.x, pv.y); w.y = cvt_pk_bf16(pv.z, pv.w); *((GAS v2u*)(F.ws + pb_panel_off(m >> 8) + (size_t)(m & 255) * 512) + F.lane) = w;
        v2u u; u.x = cvt_pk_bf16(pv2.x, pv2.y); u.y = cvt_pk_bf16(pv2.z, pv2.w); *((GAS v2u*)(F.ws + pb_panel_off(m2 >> 8) + (size_t)(m2 & 255) * 512) + F.lane) = u;
    }
    float2* tab = (float2*)(F.ws + WS_TAB);
    for (int idx = gw * 64 + F.lane; idx < SEQ * 16; idx += NGW * 64) {
        const int s = idx >> 4, i = idx & 15;
        const float inv = (float)exp2(-(double)(2 * i) / 32.0 * 13.287712379549449);
        const float ang = (float)s * inv; float sn, cs; sincos_acc(ang, sn, cs);
        tab[idx] = make_float2(cs, sn);
    }
}
}
namespace mk {
namespace att {
using s16x4 = __attribute__((ext_vector_type(4))) short;
using f32x16 = __attribute__((ext_vector_type(16))) float;
typedef LAS const char* lds_cptr;
typedef short v4i16_t __attribute__((ext_vector_type(4)));
typedef __bf16 bf16x2_t __attribute__((ext_vector_type(2)));
constexpr float THRL = 8.f;
__device__ __forceinline__ int crow(int r, int hi) { return (r & 3) + 8 * (r >> 2) + 4 * hi; }
__device__ __forceinline__ void glds16(const void* gsrc, unsigned lds_dst) { unsigned keep;
    asm volatile("s_mov_b32 %0, m0\n\ts_mov_b32 m0, %2\n\ts_nop 0\n\tglobal_load_lds_dwordx4 %1, off\n\ts_mov_b32 m0, %0" : "=&s"(keep) : "v"(gsrc), "s"(lds_dst) : "memory"); }
__device__ __forceinline__ void glds16s(const void* sbase, unsigned voff, unsigned lds_dst) { unsigned keep;
    asm volatile("s_nop 4\n\ts_mov_b32 %0, m0\n\ts_mov_b32 m0, %3\n\ts_nop 0\n\tglobal_load_lds_dwordx4 %1, %2\n\ts_mov_b32 m0, %0" : "=&s"(keep) : "v"(voff), "s"(sbase), "s"(lds_dst) : "memory"); }
__device__ __forceinline__ const char* uptr(const void* p) { const unsigned long long v = (unsigned long long)p; const unsigned lo = __builtin_amdgcn_readfirstlane((unsigned)v), hi = __builtin_amdgcn_readfirstlane((unsigned)(v >> 32)); return (const char*)(((unsigned long long)hi << 32) | lo); }
__device__ __forceinline__ unsigned cvtpk_s(float lo, float hi) { f32x2 v = {lo, hi}; bf16x2_t b = __builtin_convertvector(v, bf16x2_t); return __builtin_bit_cast(unsigned, b); }
#define ATT_WAIT_BAR0() asm volatile("s_waitcnt vmcnt(0) lgkmcnt(0)\n\ts_barrier" ::: "memory")
#define ATT_LBAR() asm volatile("s_waitcnt lgkmcnt(0)\n\ts_barrier" ::: "memory")
#define ATT_WAIT_BARN(N) asm volatile("s_waitcnt vmcnt(" #N ") lgkmcnt(0)\n\ts_barrier" ::: "memory")
constexpr int ATT_WS_OFF = 131072 + 1024;
__device__ __forceinline__ s16x4 vtr(lds_cptr p) { return __builtin_bit_cast(s16x4, __builtin_amdgcn_ds_read_tr16_b64_v4i16((LAS v4i16_t*)p)); }

template <int ND0> __device__ __forceinline__ void qkt(f32x16& p0, f32x16& p1, lds_cptr kslot, const bf16x8* qr, int r32, int hi) {
    const lds_cptr kb = kslot + hi * 1024 + r32 * 16;
    p0 = f32x16{}; p1 = f32x16{};
#pragma unroll
    for (int d0 = 0; d0 < ND0; ++d0) {
        const bf16x8 b0 = *(const LAS bf16x8*)(kb + d0 * 2048);
        const bf16x8 b1 = *(const LAS bf16x8*)(kb + d0 * 2048 + 512);
        p0 = __builtin_amdgcn_mfma_f32_32x32x16_bf16(b0, qr[d0], p0, 0, 0, 0);
        p1 = __builtin_amdgcn_mfma_f32_32x32x16_bf16(b1, qr[d0], p1, 0, 0, 0);
    }
}
template <int NVB> __device__ __forceinline__ void pv(f32x16* o, lds_cptr vp, bf16x8 pa0, bf16x8 pa1, bf16x8 pa2, bf16x8 pa3) {
#pragma unroll
    for (int d0 = 0; d0 < NVB; ++d0) { s16x4 lo[4], hh[4];
#pragma unroll
        for (int ks = 0; ks < 4; ++ks) { lo[ks] = vtr(vp + d0 * 4096 + ks * 1024); hh[ks] = vtr(vp + d0 * 4096 + ks * 1024 + 512); }
#define ATT_PK(k) (bf16x8){lo[k][0], lo[k][1], lo[k][2], lo[k][3], hh[k][0], hh[k][1], hh[k][2], hh[k][3]}
        o[d0] = __builtin_amdgcn_mfma_f32_32x32x16_bf16(pa0, ATT_PK(0), o[d0], 0, 0, 0);
        o[d0] = __builtin_amdgcn_mfma_f32_32x32x16_bf16(pa1, ATT_PK(1), o[d0], 0, 0, 0);
        o[d0] = __builtin_amdgcn_mfma_f32_32x32x16_bf16(pa2, ATT_PK(2), o[d0], 0, 0, 0);
        o[d0] = __builtin_amdgcn_mfma_f32_32x32x16_bf16(pa3, ATT_PK(3), o[d0], 0, 0, 0);
#undef ATT_PK
    }
}
__device__ __forceinline__ float rowmax(const f32x16& p0, const f32x16& p1) {
    float a = fmaxf(p0[0], p1[0]);
#pragma unroll
    for (int r = 1; r < 16; ++r) a = fmaxf(a, fmaxf(p0[r], p1[r]));
    auto rr = __builtin_amdgcn_permlane32_swap(__float_as_uint(a), __float_as_uint(a), false, false);
    return fmaxf(__uint_as_float(rr[0]), __uint_as_float(rr[1]));
}
template <int NVB> __device__ __forceinline__ void softmax_step(f32x16& p0, f32x16& p1, float& m_reg, float& l_reg, f32x16* o, LAS float* wsf, int r32, int hi,
                                                                 bf16x8& pa0, bf16x8& pa1, bf16x8& pa2, bf16x8& pa3) {
    const float rm = rowmax(p0, p1);
    if (!__all(rm - m_reg <= THRL)) {
        const float mn = fmaxf(m_reg, rm), f = __builtin_amdgcn_exp2f(m_reg - mn);
        m_reg = mn; l_reg *= f;
        if (hi == 0) wsf[r32] = f;
        asm volatile("s_waitcnt lgkmcnt(0)" ::: "memory");
#pragma unroll
        for (int d = 0; d < NVB; ++d)
#pragma unroll
            for (int r = 0; r < 16; ++r) o[d][r] *= wsf[crow(r, hi)];
    }
    float s = 0.f;
#pragma unroll
    for (int r = 0; r < 16; ++r) { p0[r] = __builtin_amdgcn_exp2f(p0[r] - m_reg); p1[r] = __builtin_amdgcn_exp2f(p1[r] - m_reg); s += p0[r] + p1[r]; }
    l_reg += s;
    v4u w0 = {cvtpk_s(p0[0], p0[1]), cvtpk_s(p0[2], p0[3]), cvtpk_s(p0[4], p0[5]), cvtpk_s(p0[6], p0[7])};
    v4u w1 = {cvtpk_s(p0[8], p0[9]), cvtpk_s(p0[10], p0[11]), cvtpk_s(p0[12], p0[13]), cvtpk_s(p0[14], p0[15])};
    v4u w2 = {cvtpk_s(p1[0], p1[1]), cvtpk_s(p1[2], p1[3]), cvtpk_s(p1[4], p1[5]), cvtpk_s(p1[6], p1[7])};
    v4u w3 = {cvtpk_s(p1[8], p1[9]), cvtpk_s(p1[10], p1[11]), cvtpk_s(p1[12], p1[13]), cvtpk_s(p1[14], p1[15])};
    pa0 = __builtin_bit_cast(bf16x8, w0); pa1 = __builtin_bit_cast(bf16x8, w1); pa2 = __builtin_bit_cast(bf16x8, w2); pa3 = __builtin_bit_cast(bf16x8, w3);
}

template <int NVB> __device__ __forceinline__ void softmax_rel(f32x16& p0, f32x16& p1, float& mhat, float& l_reg, f32x16* o, LAS float* wsf, int r32, int hi,
                                                                bf16x8& pa0, bf16x8& pa1, bf16x8& pa2, bf16x8& pa3) {
    float a = fmaxf(fmaxf(p0[0], p0[1]), p1[0]), b = fmaxf(fmaxf(p0[2], p0[3]), p1[1]); a = fmaxf(fmaxf(a, p1[2]), p1[3]);
#pragma unroll
    for (int r = 4; r < 16; r += 4) { a = fmaxf(fmaxf(a, p0[r]), p0[r + 1]); b = fmaxf(fmaxf(b, p0[r + 2]), p0[r + 3]); a = fmaxf(fmaxf(a, p1[r]), p1[r + 1]); b = fmaxf(fmaxf(b, p1[r + 2]), p1[r + 3]); }
    float rm = fmaxf(a, b);
    { auto rr = __builtin_amdgcn_permlane32_swap(__float_as_uint(rm), __float_as_uint(rm), false, false); rm = fmaxf(__uint_as_float(rr[0]), __uint_as_float(rr[1])); }
    if (__builtin_expect(__any(rm > THRL), 0)) {
        const float dl = fmaxf(rm, 0.f), f = __builtin_amdgcn_exp2f(-dl);
        mhat += dl; l_reg *= f;
#pragma unroll
        for (int r = 0; r < 16; ++r) { p0[r] -= dl; p1[r] -= dl; }
        if (hi == 0) wsf[r32] = f;
        asm volatile("s_waitcnt lgkmcnt(0)" ::: "memory");
#pragma unroll
        for (int d = 0; d < NVB; ++d)
#pragma unroll
            for (int r = 0; r < 16; ++r) o[d][r] *= (wsf + 4 * hi)[(r & 3) + 8 * (r >> 2)];
    }
    float s = 0.f;
#pragma unroll
    for (int r = 0; r < 16; ++r) { p0[r] = __builtin_amdgcn_exp2f(p0[r]); p1[r] = __builtin_amdgcn_exp2f(p1[r]); s += p0[r] + p1[r]; }
    l_reg += s;
    v4u w0 = {cvtpk_s(p0[0], p0[1]), cvtpk_s(p0[2], p0[3]), cvtpk_s(p0[4], p0[5]), cvtpk_s(p0[6], p0[7])};
    v4u w1 = {cvtpk_s(p0[8], p0[9]), cvtpk_s(p0[10], p0[11]), cvtpk_s(p0[12], p0[13]), cvtpk_s(p0[14], p0[15])};
    v4u w2 = {cvtpk_s(p1[0], p1[1]), cvtpk_s(p1[2], p1[3]), cvtpk_s(p1[4], p1[5]), cvtpk_s(p1[6], p1[7])};
    v4u w3 = {cvtpk_s(p1[8], p1[9]), cvtpk_s(p1[10], p1[11]), cvtpk_s(p1[12], p1[13]), cvtpk_s(p1[14], p1[15])};
    pa0 = __builtin_bit_cast(bf16x8, w0); pa1 = __builtin_bit_cast(bf16x8, w1); pa2 = __builtin_bit_cast(bf16x8, w2); pa3 = __builtin_bit_cast(bf16x8, w3);
}
template <int ND0> __device__ __forceinline__ void qkt_c(f32x16& p0, f32x16& p1, lds_cptr kslot, const bf16x8* qr, const f32x16& c0, const f32x16& c1, int r32, int hi) {
    const lds_cptr kb = kslot + hi * 1024 + r32 * 16;
#pragma unroll
    for (int d0 = 0; d0 < ND0; ++d0) {
        const bf16x8 b0 = *(const LAS bf16x8*)(kb + d0 * 2048);
        const bf16x8 b1 = *(const LAS bf16x8*)(kb + d0 * 2048 + 512);
        if (d0 == 0) { p0 = __builtin_amdgcn_mfma_f32_32x32x16_bf16(b0, qr[0], c0, 0, 0, 0); p1 = __builtin_amdgcn_mfma_f32_32x32x16_bf16(b1, qr[0], c1, 0, 0, 0); }
        else { p0 = __builtin_amdgcn_mfma_f32_32x32x16_bf16(b0, qr[d0], p0, 0, 0, 0); p1 = __builtin_amdgcn_mfma_f32_32x32x16_bf16(b1, qr[d0], p1, 0, 0, 0); }
    }
}
#define ATT_NEXT(x) (((x) == (NSLOT - 1) * BUF) ? 0 : (x) + BUF)
#define ATT_SBAR() __builtin_amdgcn_sched_barrier(0)
#define ATT_PK2(L, H) (bf16x8){L[0], L[1], L[2], L[3], H[0], H[1], H[2], H[3]}


constexpr int MLA_KB = 12 * 1024, MLA_VB = 8 * 1024, MLA_BUF = MLA_KB + MLA_VB, MLA_NSLOT = 5, MLA_D = 3, MLA_WS = ATT_WS_OFF, MLA_OST = 0;
__device__ __forceinline__ void mla_unit(int b, int h, int qb, const bf16* QM, const bf16* KVM, const bf16* KROT, bf16* OCAT, LAS char* shm) {
    constexpr int BUF = MLA_BUF, NSLOT = MLA_NSLOT, D = MLA_D;
    const int tid = threadIdx.x, lane = tid & 63, r32 = lane & 31, hi = lane >> 5; const int wid = __builtin_amdgcn_readfirstlane(tid >> 6);
    const bool lead = wid < 4;
    const long rowbase = (long)b * SEQ; const int q0 = qb * 256;
    const unsigned lds0 = (unsigned)(uintptr_t)shm;
    LAS float* wsf = (LAS float*)(shm + MLA_WS) + wid * 64;
    bf16x8 qr[6];
    { const bf16* Qw = QM + (rowbase + q0 + wid * 32 + r32) * 768 + h * 96 + hi * 8;
#pragma unroll
      for (int d0 = 0; d0 < 6; ++d0) qr[d0] = *(const bf16x8*)(Qw + d0 * 16); }
    const char* kvbase = (const char*)(KVM + rowbase * 1024 + h * 128); const char* krbase = (const char*)(KROT + rowbase * 32);
    const unsigned koffA = (unsigned)(lane * 1024 + wid * 8) * 2u;
    const unsigned koffB = (unsigned)(lane * 32 + (wid & 3) * 8) * 2u;
    const unsigned voffs = (unsigned)((16 * (wid & 3) + (lane >> 2)) * 1024 + 64 + (wid >> 2) * 32 + (lane & 3) * 8) * 2u;
#define MLA_DMA(t, sl) do { const unsigned base_ = lds0 + (sl); const char* kvt_ = uptr(kvbase + (size_t)(t) * (64 * 1024 * 2)); \
        glds16s(kvt_, koffA, (unsigned)__builtin_amdgcn_readfirstlane(base_ + wid * 1024)); \
        if (wid < 4) glds16s(uptr(krbase + (size_t)(t) * (64 * 32 * 2)), koffB, (unsigned)__builtin_amdgcn_readfirstlane(base_ + (8 + wid) * 1024)); \
        glds16s(kvt_, voffs, (unsigned)__builtin_amdgcn_readfirstlane(base_ + MLA_KB + wid * 1024)); } while (0)
    const int vofs = ((lane >> 4) & 1) * 32 + (lane & 3) * 8 + (4 * hi + ((lane & 15) >> 2)) * 64;
    const int kofs = hi * 1024 + r32 * 16;
    float mhat = 0.f, l_reg = 0.f; f32x16 o[2]; o[0] = f32x16{}; o[1] = f32x16{};
    f32x16 p0, p1; bf16x8 pa0, pa1, pa2, pa3; bf16x8 kf[12]; s16x4 vlo[8], vhh[8];
    constexpr int NT = SEQ / 64;
#define MLA_KLOAD(sl) do { const lds_cptr kb_ = (lds_cptr)shm + (sl) + kofs; _Pragma("unroll") for (int d0 = 0; d0 < 6; ++d0) { \
        kf[2 * d0] = *(const LAS bf16x8*)(kb_ + d0 * 2048); kf[2 * d0 + 1] = *(const LAS bf16x8*)(kb_ + d0 * 2048 + 512); } } while (0)
#define MLA_QK() do { f32x16 c_; _Pragma("unroll") for (int r = 0; r < 16; ++r) c_[r] = -mhat; \
        p0 = __builtin_amdgcn_mfma_f32_32x32x16_bf16(kf[0], qr[0], c_, 0, 0, 0); p1 = __builtin_amdgcn_mfma_f32_32x32x16_bf16(kf[1], qr[0], c_, 0, 0, 0); \
        _Pragma("unroll") for (int d0 = 1; d0 < 6; ++d0) { p0 = __builtin_amdgcn_mfma_f32_32x32x16_bf16(kf[2 * d0], qr[d0], p0, 0, 0, 0); p1 = __builtin_amdgcn_mfma_f32_32x32x16_bf16(kf[2 * d0 + 1], qr[d0], p1, 0, 0, 0); } } while (0)
#define MLA_VLOAD(sl) do { const lds_cptr vp_ = (lds_cptr)shm + (sl) + MLA_KB + vofs; _Pragma("unroll") for (int i = 0; i < 8; ++i) { \
        vlo[i] = vtr(vp_ + (i >> 2) * 4096 + (i & 3) * 1024); vhh[i] = vtr(vp_ + (i >> 2) * 4096 + (i & 3) * 1024 + 512); } } while (0)
#define MLA_PV() do { _Pragma("unroll") for (int d0 = 0; d0 < 2; ++d0) { \
        o[d0] = __builtin_amdgcn_mfma_f32_32x32x16_bf16(pa0, ATT_PK2(vlo[d0 * 4 + 0], vhh[d0 * 4 + 0]), o[d0], 0, 0, 0); o[d0] = __builtin_amdgcn_mfma_f32_32x32x16_bf16(pa1, ATT_PK2(vlo[d0 * 4 + 1], vhh[d0 * 4 + 1]), o[d0], 0, 0, 0); \
        o[d0] = __builtin_amdgcn_mfma_f32_32x32x16_bf16(pa2, ATT_PK2(vlo[d0 * 4 + 2], vhh[d0 * 4 + 2]), o[d0], 0, 0, 0); o[d0] = __builtin_amdgcn_mfma_f32_32x32x16_bf16(pa3, ATT_PK2(vlo[d0 * 4 + 3], vhh[d0 * 4 + 3]), o[d0], 0, 0, 0); } } while (0)
#define MLA_BAR(t) do { if ((t) + D < NT) { if (lead) ATT_WAIT_BARN(6); else ATT_WAIT_BARN(4); } else ATT_WAIT_BAR0(); } while (0)
    MLA_DMA(0, 0); MLA_DMA(1, BUF); MLA_DMA(2, 2 * BUF); MLA_DMA(3, 3 * BUF);
    if (lead) { ATT_WAIT_BARN(9); } else { ATT_WAIT_BARN(6); ATT_WAIT_BARN(6); }
    int s_v = 0, s_k = BUF, s_d = 4 * BUF;
    MLA_KLOAD(0); MLA_QK();
    for (int t = 0; t < NT; ++t) {
        MLA_BAR(t);
        if (t + 1 + D < NT) MLA_DMA(t + 1 + D, s_d);
        MLA_VLOAD(s_v); ATT_SBAR();
        softmax_rel<2>(p0, p1, mhat, l_reg, o, wsf, r32, hi, pa0, pa1, pa2, pa3);
        MLA_BAR(t);
        __builtin_amdgcn_s_setprio(2);
        if (t + 1 < NT) { MLA_KLOAD(s_k); } ATT_SBAR();
        MLA_PV();
        if (t + 1 < NT) { MLA_QK(); }
        __builtin_amdgcn_s_setprio(0);
        s_v = s_k; s_k = ATT_NEXT(s_k); s_d = ATT_NEXT(s_d);
    }
    if (lead) ATT_LBAR();
    ATT_LBAR();
#undef MLA_DMA
#undef MLA_KLOAD
#undef MLA_QK
#undef MLA_VLOAD
#undef MLA_PV
#undef MLA_BAR
    int lane_e = lane; asm volatile("" : "+v"(lane_e)); const int r32e = lane_e & 31, hie = lane_e >> 5;
    { auto rr = __builtin_amdgcn_permlane32_swap(__float_as_uint(l_reg), __float_as_uint(l_reg), false, false); l_reg = __uint_as_float(rr[0]) + __uint_as_float(rr[1]); }
    if (hie == 0) wsf[32 + r32e] = l_reg;
    asm volatile("s_waitcnt lgkmcnt(0)" ::: "memory");
    float rli[16];
#pragma unroll
    for (int r = 0; r < 16; ++r) rli[r] = __builtin_amdgcn_rcpf((wsf + 32 + 4 * hie)[(r & 3) + 8 * (r >> 2)]);
    bf16* Ow = OCAT + (rowbase + q0 + wid * 32) * 1024 + h * 64;
    { LAS bf16* stg = (LAS bf16*)(shm + MLA_OST) + wid * 2048;
#pragma unroll
      for (int r = 0; r < 16; ++r) { const int orow = crow(r, hie);
#pragma unroll
          for (int d0 = 0; d0 < 2; ++d0) stg[orow * 64 + d0 * 32 + r32e] = (bf16)(cvtpk_s(o[d0][r] * rli[r], 0.f) & 0xffffu); }
      asm volatile("s_waitcnt lgkmcnt(0)" ::: "memory");
#pragma unroll
      for (int i = 0; i < 4; ++i) { const int row = i * 8 + (lane_e >> 3), ch = lane_e & 7; const v4u v = *(const LAS v4u*)(stg + row * 64 + ch * 8); *(v4u*)(Ow + (long)row * 1024 + ch * 8) = v; } }
    ATT_LBAR();
}

constexpr int DF_KB = 16 * 1024, DF_VB = 16 * 1024, DF_BUF = DF_KB + DF_VB, DF_NSLOT = 4, DF_D = 2, DF_WS = ATT_WS_OFF, DF_X = 0, DF_OST = 65536;
__device__ __forceinline__ void diff_unit(int b, int h, int qb, int t_lo, int NT, const bf16* QD, const bf16* KD, const bf16* VD, bf16* OCAT, float lam, const float* gsub, LAS char* shm) {
    constexpr int BUF = DF_BUF, NSLOT = DF_NSLOT, D = DF_D;
    const int tid = threadIdx.x, lane = tid & 63, r32 = lane & 31, hi = lane >> 5; const int wid = __builtin_amdgcn_readfirstlane(tid >> 6);
    const int w4 = wid & 3, mp = wid >> 2; const bool lead = mp == 0;
    const long rowbase = (long)b * SEQ; const int q0 = qb * 128;
    const unsigned lds0 = (unsigned)(uintptr_t)shm;
    LAS float* wsf = (LAS float*)(shm + DF_WS) + wid * 64;
    bf16x8 qr[4];
    { const bf16* Qw = QD + (rowbase + q0 + w4 * 32 + r32) * 512 + h * 128 + mp * 64 + hi * 8;
#pragma unroll
      for (int d0 = 0; d0 < 4; ++d0) qr[d0] = *(const bf16x8*)(Qw + d0 * 16); }
    const char* kbase = (const char*)(KD + rowbase * 512 + h * 128); const char* vbase = (const char*)(VD + rowbase * 512 + h * 128);
    const unsigned koffs = (unsigned)(lane * 512 + wid * 8) * 2u;
    const unsigned voffs = (unsigned)((16 * (wid & 3) + (lane >> 2)) * 512 + (wid >> 2) * 32 + (lane & 3) * 8) * 2u;
#define DF_DMA(t, sl) do { const unsigned base_ = lds0 + (sl); const char* kt_ = uptr(kbase + (size_t)(t) * (64 * 512 * 2)); const char* vt_ = uptr(vbase + (size_t)(t) * (64 * 512 * 2)); \
        glds16s(kt_, koffs, (unsigned)__builtin_amdgcn_readfirstlane(base_ + wid * 1024)); \
        glds16s(kt_ + 128, koffs, (unsigned)__builtin_amdgcn_readfirstlane(base_ + (8 + wid) * 1024)); \
        glds16s(vt_, voffs, (unsigned)__builtin_amdgcn_readfirstlane(base_ + DF_KB + wid * 1024)); \
        glds16s(vt_ + 128, voffs, (unsigned)__builtin_amdgcn_readfirstlane(base_ + DF_KB + (8 + wid) * 1024)); } while (0)
    const int vofs = ((lane >> 4) & 1) * 32 + (lane & 3) * 8 + (4 * hi + ((lane & 15) >> 2)) * 64;
    const int kofs = mp * 8192 + hi * 1024 + r32 * 16;
    const float sl2 = __builtin_amdgcn_exp2f(-2.f * (float)(h + 1)) * LOG2E;
    const int qpos = q0 + w4 * 32 + r32;
    const int t_d = (q0 + w4 * 32) >> 6;
    float mhat = 0.f, l_reg = 0.f; f32x16 o[4]; o[0] = f32x16{}; o[1] = f32x16{}; o[2] = f32x16{}; o[3] = f32x16{};
    f32x16 p0, p1; bf16x8 pa0, pa1, pa2, pa3; bf16x8 kf[8]; s16x4 vlo[8], vhh[8], vl2[8], vh2[8];
#define DF_KLOAD(sl) do { const lds_cptr kb_ = (lds_cptr)shm + (sl) + kofs; _Pragma("unroll") for (int d0 = 0; d0 < 4; ++d0) { \
        kf[2 * d0] = *(const LAS bf16x8*)(kb_ + d0 * 2048); kf[2 * d0 + 1] = *(const LAS bf16x8*)(kb_ + d0 * 2048 + 512); } } while (0)
#define DF_QK(t) do { f32x16 c0_, c1_; \
        if ((t) != t_d) { float sg_ = (t) < t_d ? sl2 : -sl2; asm volatile("" : "+v"(sg_)); const float base_ = sg_ * (float)((t) * 64 + 4 * hi - qpos) - mhat; \
            _Pragma("unroll") for (int r = 0; r < 16; ++r) { c0_[r] = fmaf(sg_, (float)((r & 3) + 8 * (r >> 2)), base_); c1_[r] = c0_[r] + 32.f * sg_; } } \
        else { _Pragma("unroll") for (int r = 0; r < 16; ++r) { c0_[r] = -mhat; c1_[r] = -mhat; } } \
        p0 = __builtin_amdgcn_mfma_f32_32x32x16_bf16(kf[0], qr[0], c0_, 0, 0, 0); p1 = __builtin_amdgcn_mfma_f32_32x32x16_bf16(kf[1], qr[0], c1_, 0, 0, 0); \
        _Pragma("unroll") for (int d0 = 1; d0 < 4; ++d0) { p0 = __builtin_amdgcn_mfma_f32_32x32x16_bf16(kf[2 * d0], qr[d0], p0, 0, 0, 0); p1 = __builtin_amdgcn_mfma_f32_32x32x16_bf16(kf[2 * d0 + 1], qr[d0], p1, 0, 0, 0); } \
        if ((t) == t_d) { int d0_ = qpos - ((t) * 64 + 4 * hi); asm volatile("" : "+v"(d0_)); \
            _Pragma("unroll") for (int r = 0; r < 16; ++r) { const int d = d0_ - ((r & 3) + 8 * (r >> 2)); p0[r] -= sl2 * fabsf((float)d); p1[r] -= sl2 * fabsf((float)(d - 32)); } } } while (0)
#define DF_VLOAD(sl) do { const lds_cptr vp_ = (lds_cptr)shm + (sl) + DF_KB + vofs; _Pragma("unroll") for (int i = 0; i < 8; ++i) { \
        vlo[i] = vtr(vp_ + (i >> 2) * 4096 + (i & 3) * 1024); vhh[i] = vtr(vp_ + (i >> 2) * 4096 + (i & 3) * 1024 + 512); } } while (0)
#define DF_VLOAD2(sl) do { const lds_cptr vp_ = (lds_cptr)shm + (sl) + DF_KB + vofs + 8192; _Pragma("unroll") for (int i = 0; i < 8; ++i) { \
        vl2[i] = vtr(vp_ + (i >> 2) * 4096 + (i & 3) * 1024); vh2[i] = vtr(vp_ + (i >> 2) * 4096 + (i & 3) * 1024 + 512); } } while (0)
#define DF_PV4(OB, VL, VH) do { _Pragma("unroll") for (int d0 = 0; d0 < 2; ++d0) { \
        o[OB + d0] = __builtin_amdgcn_mfma_f32_32x32x16_bf16(pa0, ATT_PK2(VL[d0 * 4 + 0], VH[d0 * 4 + 0]), o[OB + d0], 0, 0, 0); o[OB + d0] = __builtin_amdgcn_mfma_f32_32x32x16_bf16(pa1, ATT_PK2(VL[d0 * 4 + 1], VH[d0 * 4 + 1]), o[OB + d0], 0, 0, 0); \
        o[OB + d0] = __builtin_amdgcn_mfma_f32_32x32x16_bf16(pa2, ATT_PK2(VL[d0 * 4 + 2], VH[d0 * 4 + 2]), o[OB + d0], 0, 0, 0); o[OB + d0] = __builtin_amdgcn_mfma_f32_32x32x16_bf16(pa3, ATT_PK2(VL[d0 * 4 + 3], VH[d0 * 4 + 3]), o[OB + d0], 0, 0, 0); } } while (0)
#define DF_BAR(t) do { if ((t) + D < NT) ATT_WAIT_BARN(4); else ATT_WAIT_BAR0(); } while (0)
    DF_DMA(t_lo, 0); DF_DMA(t_lo + 1, BUF); DF_DMA(t_lo + 2, 2 * BUF);
    if (lead) { ATT_WAIT_BARN(8); } else { ATT_WAIT_BARN(8); ATT_WAIT_BARN(8); }
    int s_v = 0, s_k = BUF, s_d = 3 * BUF;
    DF_KLOAD(0); DF_QK(t_lo);
    for (int t = 0; t < NT; ++t) {
        DF_BAR(t);
        DF_VLOAD(s_v); ATT_SBAR();
        softmax_rel<4>(p0, p1, mhat, l_reg, o, wsf, r32, hi, pa0, pa1, pa2, pa3);
        DF_BAR(t);
        __builtin_amdgcn_s_setprio(2);
        if (t + 1 + D < NT) DF_DMA(t_lo + t + 1 + D, s_d);
        DF_VLOAD2(s_v); ATT_SBAR();
        DF_PV4(0, vlo, vhh); ATT_SBAR();
        if (t + 1 < NT) { DF_KLOAD(s_k); } ATT_SBAR();
        DF_PV4(2, vl2, vh2);
        if (t + 1 < NT) { DF_QK(t_lo + t + 1); }
        __builtin_amdgcn_s_setprio(0);
        s_v = s_k; s_k = ATT_NEXT(s_k); s_d = ATT_NEXT(s_d);
    }
    if (lead) ATT_LBAR();
#undef DF_DMA
#undef DF_KLOAD
#undef DF_QK
#undef DF_VLOAD
#undef DF_VLOAD2
#undef DF_PV4
#undef DF_BAR
    int lane_e = lane; asm volatile("" : "+v"(lane_e)); const int r32e = lane_e & 31, hie = lane_e >> 5;
    { auto rr = __builtin_amdgcn_permlane32_swap(__float_as_uint(l_reg), __float_as_uint(l_reg), false, false); l_reg = __uint_as_float(rr[0]) + __uint_as_float(rr[1]); }
    if (hie == 0) wsf[32 + r32e] = l_reg;
    asm volatile("s_waitcnt lgkmcnt(0)" ::: "memory");
#pragma unroll
    for (int r = 0; r < 16; ++r) { const float rl_ = __builtin_amdgcn_rcpf((wsf + 32 + 4 * hie)[(r & 3) + 8 * (r >> 2)]) * (mp == 1 ? lam : 1.f);
#pragma unroll
        for (int d0 = 0; d0 < 4; ++d0) o[d0][r] *= rl_; }
    ATT_LBAR();
    LAS float* X = (LAS float*)(shm + DF_X);
    if (mp == 1) {
#pragma unroll
        for (int r = 0; r < 16; ++r) { LAS float* xr = X + (w4 * 32 + 4 * hie) * 128 + r32e;
#pragma unroll
            for (int d0 = 0; d0 < 4; ++d0) xr[((r & 3) + 8 * (r >> 2)) * 128 + d0 * 32] = o[d0][r]; }
    }
    ATT_LBAR();
    if (mp == 0) {
        float gs[4];
#pragma unroll
        for (int d0 = 0; d0 < 4; ++d0) gs[d0] = gsub[d0 * 32 + r32e] * 0.8f;
        LAS bf16* stg = (LAS bf16*)(shm + DF_OST) + w4 * 4096 + 4 * hie * 128 + r32e;
        const LAS float* xr = X + (w4 * 32 + 4 * hie) * 128 + r32e;
#pragma unroll
        for (int r = 0; r < 16; ++r) { const int c0r = (r & 3) + 8 * (r >> 2); float v[4]; float ss = 0.f;
#pragma unroll
            for (int d0 = 0; d0 < 4; ++d0) { v[d0] = o[d0][r] - xr[c0r * 128 + d0 * 32]; ss += v[d0] * v[d0]; }
            ss += __int_as_float(__builtin_amdgcn_ds_swizzle(__float_as_int(ss), 0x041F)); ss += __int_as_float(__builtin_amdgcn_ds_swizzle(__float_as_int(ss), 0x081F));
            ss += __int_as_float(__builtin_amdgcn_ds_swizzle(__float_as_int(ss), 0x101F)); ss += __int_as_float(__builtin_amdgcn_ds_swizzle(__float_as_int(ss), 0x201F));
            ss += __int_as_float(__builtin_amdgcn_ds_swizzle(__float_as_int(ss), 0x401F));
            const float rr = __builtin_amdgcn_rsqf(ss * (1.f / 128.f) + EPS);
#pragma unroll
            for (int d0 = 0; d0 < 4; ++d0) stg[c0r * 128 + d0 * 32] = (bf16)(cvtpk_s(v[d0] * rr * gs[d0], 0.f) & 0xffffu); }
        asm volatile("s_waitcnt lgkmcnt(0)" ::: "memory");
        bf16* Ow = OCAT + (rowbase + q0 + w4 * 32) * 1024 + 512 + h * 128;
        const LAS bf16* stg0 = (const LAS bf16*)(shm + DF_OST) + w4 * 4096;
#pragma unroll
        for (int i = 0; i < 8; ++i) { const int row = i * 4 + (lane_e >> 4), ch = lane_e & 15; const v4u v = *(const LAS v4u*)(stg0 + row * 128 + ch * 8); *(v4u*)(Ow + (long)row * 1024 + ch * 8) = v; }
    }
    ATT_LBAR();
}
}
}
namespace mk {
namespace att {
constexpr int MKH0 = 32 * 128, MKH1 = 32 * 64;
__device__ __forceinline__ void mla_step_a(f32x16* o, f32x16& S0, f32x16& S1, f32x16& T0, f32x16& T1, const bf16x8 pw0, const bf16x8 pw1, const bf16x8 pw2, const bf16x8 pw3, v4u& n0, v4u& n1, v4u& n2, v4u& n3, const bf16x8* qr, lds_cptr vp, lds_cptr ks, const int* kb, lds_cptr vpn, s16x4& f0l, s16x4& f0h, s16x4& f1l, s16x4& f1h, s16x4& f2l, s16x4& f2h, s16x4& f3l, s16x4& f3h, s16x4& f4l, s16x4& f4h, bf16x8& k0, bf16x8& k1, bf16x8& k2, bf16x8& k3, bf16x8& k4, float& sacc) {
    f4l = vtr(vp + 4096); f4h = vtr(vp + 4096 + 512);
    o[0] = __builtin_amdgcn_mfma_f32_32x32x16_bf16(pw0, ATT_PK2(f0l, f0h), o[0], 0, 0, 0);
    T0[0] = __builtin_amdgcn_exp2f(T0[0]);
    T0[1] = __builtin_amdgcn_exp2f(T0[1]);
    sacc += T0[0]; sacc += T0[1];
    asm volatile("" : "+v"(T0), "+v"(T1), "+v"(n0), "+v"(n1), "+v"(n2), "+v"(n3), "+v"(sacc)); ATT_SBAR();
    f0l = vtr(vp + 5120); f0h = vtr(vp + 5120 + 512);
    o[0] = __builtin_amdgcn_mfma_f32_32x32x16_bf16(pw1, ATT_PK2(f1l, f1h), o[0], 0, 0, 0);
    n0[0] = cvtpk_s(T0[0], T0[1]);
    T0[2] = __builtin_amdgcn_exp2f(T0[2]);
    T0[3] = __builtin_amdgcn_exp2f(T0[3]);
    asm volatile("" : "+v"(T0), "+v"(T1), "+v"(n0), "+v"(n1), "+v"(n2), "+v"(n3), "+v"(sacc)); ATT_SBAR();
    f1l = vtr(vp + 6144); f1h = vtr(vp + 6144 + 512);
    o[0] = __builtin_amdgcn_mfma_f32_32x32x16_bf16(pw2, ATT_PK2(f2l, f2h), o[0], 0, 0, 0);
    sacc += T0[2]; sacc += T0[3];
    n0[1] = cvtpk_s(T0[2], T0[3]);
    T0[4] = __builtin_amdgcn_exp2f(T0[4]);
    asm volatile("" : "+v"(T0), "+v"(T1), "+v"(n0), "+v"(n1), "+v"(n2), "+v"(n3), "+v"(sacc)); ATT_SBAR();
    f2l = vtr(vp + 7168); f2h = vtr(vp + 7168 + 512);
    o[0] = __builtin_amdgcn_mfma_f32_32x32x16_bf16(pw3, ATT_PK2(f3l, f3h), o[0], 0, 0, 0);
    T0[5] = __builtin_amdgcn_exp2f(T0[5]);
    sacc += T0[4]; sacc += T0[5];
    n0[2] = cvtpk_s(T0[4], T0[5]);
    asm volatile("" : "+v"(T0), "+v"(T1), "+v"(n0), "+v"(n1), "+v"(n2), "+v"(n3), "+v"(sacc)); ATT_SBAR();
    k0 = *(const LAS bf16x8*)(ks + kb[0] + 0 * MKH0);
    o[1] = __builtin_amdgcn_mfma_f32_32x32x16_bf16(pw0, ATT_PK2(f4l, f4h), o[1], 0, 0, 0);
    T0[6] = __builtin_amdgcn_exp2f(T0[6]);
    T0[7] = __builtin_amdgcn_exp2f(T0[7]);
    sacc += T0[6]; sacc += T0[7];
    asm volatile("" : "+v"(T0), "+v"(T1), "+v"(n0), "+v"(n1), "+v"(n2), "+v"(n3), "+v"(sacc)); ATT_SBAR();
    k1 = *(const LAS bf16x8*)(ks + kb[0] + 1 * MKH0);
    o[1] = __builtin_amdgcn_mfma_f32_32x32x16_bf16(pw1, ATT_PK2(f0l, f0h), o[1], 0, 0, 0);
    n0[3] = cvtpk_s(T0[6], T0[7]);
    T0[8] = __builtin_amdgcn_exp2f(T0[8]);
    T0[9] = __builtin_amdgcn_exp2f(T0[9]);
    asm volatile("" : "+v"(T0), "+v"(T1), "+v"(n0), "+v"(n1), "+v"(n2), "+v"(n3), "+v"(sacc)); ATT_SBAR();
    k2 = *(const LAS bf16x8*)(ks + kb[1] + 0 * MKH0);
    o[1] = __builtin_amdgcn_mfma_f32_32x32x16_bf16(pw2, ATT_PK2(f1l, f1h), o[1], 0, 0, 0);
    sacc += T0[8]; sacc += T0[9];
    n1[0] = cvtpk_s(T0[8], T0[9]);
    T0[10] = __builtin_amdgcn_exp2f(T0[10]);
    asm volatile("" : "+v"(T0), "+v"(T1), "+v"(n0), "+v"(n1), "+v"(n2), "+v"(n3), "+v"(sacc)); ATT_SBAR();
    k3 = *(const LAS bf16x8*)(ks + kb[1] + 1 * MKH0);
    o[1] = __builtin_amdgcn_mfma_f32_32x32x16_bf16(pw3, ATT_PK2(f2l, f2h), o[1], 0, 0, 0);
    T0[11] = __builtin_amdgcn_exp2f(T0[11]);
    sacc += T0[10]; sacc += T0[11];
    n1[1] = cvtpk_s(T0[10], T0[11]);
    asm volatile("" : "+v"(T0), "+v"(T1), "+v"(n0), "+v"(n1), "+v"(n2), "+v"(n3), "+v"(sacc)); ATT_SBAR();
    k4 = *(const LAS bf16x8*)(ks + kb[2] + 0 * MKH0);
    S0 = __builtin_amdgcn_mfma_f32_32x32x16_bf16(k0, qr[0], f32x16{}, 0, 0, 0);
    T0[12] = __builtin_amdgcn_exp2f(T0[12]);
    T0[13] = __builtin_amdgcn_exp2f(T0[13]);
    sacc += T0[12]; sacc += T0[13];
    asm volatile("" : "+v"(T0), "+v"(T1), "+v"(n0), "+v"(n1), "+v"(n2), "+v"(n3), "+v"(sacc)); ATT_SBAR();
    k0 = *(const LAS bf16x8*)(ks + kb[2] + 1 * MKH0);
    S1 = __builtin_amdgcn_mfma_f32_32x32x16_bf16(k1, qr[0], f32x16{}, 0, 0, 0);
    n1[2] = cvtpk_s(T0[12], T0[13]);
    T0[14] = __builtin_amdgcn_exp2f(T0[14]);
    T0[15] = __builtin_amdgcn_exp2f(T0[15]);
    asm volatile("" : "+v"(T0), "+v"(T1), "+v"(n0), "+v"(n1), "+v"(n2), "+v"(n3), "+v"(sacc)); ATT_SBAR();
}
__device__ __forceinline__ void mla_step_b(f32x16* o, f32x16& S0, f32x16& S1, f32x16& T0, f32x16& T1, const bf16x8 pw0, const bf16x8 pw1, const bf16x8 pw2, const bf16x8 pw3, v4u& n0, v4u& n1, v4u& n2, v4u& n3, const bf16x8* qr, lds_cptr vp, lds_cptr ks, const int* kb, lds_cptr vpn, s16x4& f0l, s16x4& f0h, s16x4& f1l, s16x4& f1h, s16x4& f2l, s16x4& f2h, s16x4& f3l, s16x4& f3h, s16x4& f4l, s16x4& f4h, bf16x8& k0, bf16x8& k1, bf16x8& k2, bf16x8& k3, bf16x8& k4, float& sacc) {
    k1 = *(const LAS bf16x8*)(ks + kb[3] + 0 * MKH0);
    S0 = __builtin_amdgcn_mfma_f32_32x32x16_bf16(k2, qr[1], S0, 0, 0, 0);
    sacc += T0[14]; sacc += T0[15];
    n1[3] = cvtpk_s(T0[14], T0[15]);
    T1[0] = __builtin_amdgcn_exp2f(T1[0]);
    asm volatile("" : "+v"(T0), "+v"(T1), "+v"(n0), "+v"(n1), "+v"(n2), "+v"(n3), "+v"(sacc)); ATT_SBAR();
    k2 = *(const LAS bf16x8*)(ks + kb[3] + 1 * MKH0);
    S1 = __builtin_amdgcn_mfma_f32_32x32x16_bf16(k3, qr[1], S1, 0, 0, 0);
    T1[1] = __builtin_amdgcn_exp2f(T1[1]);
    sacc += T1[0]; sacc += T1[1];
    n2[0] = cvtpk_s(T1[0], T1[1]);
    asm volatile("" : "+v"(T0), "+v"(T1), "+v"(n0), "+v"(n1), "+v"(n2), "+v"(n3), "+v"(sacc)); ATT_SBAR();
    k3 = *(const LAS bf16x8*)(ks + kb[4] + 0 * MKH1);
    S0 = __builtin_amdgcn_mfma_f32_32x32x16_bf16(k4, qr[2], S0, 0, 0, 0);
    T1[2] = __builtin_amdgcn_exp2f(T1[2]);
    T1[3] = __builtin_amdgcn_exp2f(T1[3]);
    sacc += T1[2]; sacc += T1[3];
    asm volatile("" : "+v"(T0), "+v"(T1), "+v"(n0), "+v"(n1), "+v"(n2), "+v"(n3), "+v"(sacc)); ATT_SBAR();
    k4 = *(const LAS bf16x8*)(ks + kb[4] + 1 * MKH1);
    S1 = __builtin_amdgcn_mfma_f32_32x32x16_bf16(k0, qr[2], S1, 0, 0, 0);
    n2[1] = cvtpk_s(T1[2], T1[3]);
    T1[4] = __builtin_amdgcn_exp2f(T1[4]);
    T1[5] = __builtin_amdgcn_exp2f(T1[5]);
    asm volatile("" : "+v"(T0), "+v"(T1), "+v"(n0), "+v"(n1), "+v"(n2), "+v"(n3), "+v"(sacc)); ATT_SBAR();
    k0 = *(const LAS bf16x8*)(ks + kb[5] + 0 * MKH1);
    S0 = __builtin_amdgcn_mfma_f32_32x32x16_bf16(k1, qr[3], S0, 0, 0, 0);
    sacc += T1[4]; sacc += T1[5];
    n2[2] = cvtpk_s(T1[4], T1[5]);
    T1[6] = __builtin_amdgcn_exp2f(T1[6]);
    asm volatile("" : "+v"(T0), "+v"(T1), "+v"(n0), "+v"(n1), "+v"(n2), "+v"(n3), "+v"(sacc)); ATT_SBAR();
    k1 = *(const LAS bf16x8*)(ks + kb[5] + 1 * MKH1);
    S1 = __builtin_amdgcn_mfma_f32_32x32x16_bf16(k2, qr[3], S1, 0, 0, 0);
    T1[7] = __builtin_amdgcn_exp2f(T1[7]);
    sacc += T1[6]; sacc += T1[7];
    n2[3] = cvtpk_s(T1[6], T1[7]);
    asm volatile("" : "+v"(T0), "+v"(T1), "+v"(n0), "+v"(n1), "+v"(n2), "+v"(n3), "+v"(sacc)); ATT_SBAR();
    f0l = vtr(vpn + 0); f0h = vtr(vpn + 0 + 512);
    S0 = __builtin_amdgcn_mfma_f32_32x32x16_bf16(k3, qr[4], S0, 0, 0, 0);
    T1[8] = __builtin_amdgcn_exp2f(T1[8]);
    T1[9] = __builtin_amdgcn_exp2f(T1[9]);
    sacc += T1[8]; sacc += T1[9];
    asm volatile("" : "+v"(T0), "+v"(T1), "+v"(n0), "+v"(n1), "+v"(n2), "+v"(n3), "+v"(sacc)); ATT_SBAR();
    f1l = vtr(vpn + 1024); f1h = vtr(vpn + 1024 + 512);
    S1 = __builtin_amdgcn_mfma_f32_32x32x16_bf16(k4, qr[4], S1, 0, 0, 0);
    n3[0] = cvtpk_s(T1[8], T1[9]);
    T1[10] = __builtin_amdgcn_exp2f(T1[10]);
    T1[11] = __builtin_amdgcn_exp2f(T1[11]);
    asm volatile("" : "+v"(T0), "+v"(T1), "+v"(n0), "+v"(n1), "+v"(n2), "+v"(n3), "+v"(sacc)); ATT_SBAR();
    f2l = vtr(vpn + 2048); f2h = vtr(vpn + 2048 + 512);
    S0 = __builtin_amdgcn_mfma_f32_32x32x16_bf16(k0, qr[5], S0, 0, 0, 0);
    sacc += T1[10]; sacc += T1[11];
    n3[1] = cvtpk_s(T1[10], T1[11]);
    T1[12] = __builtin_amdgcn_exp2f(T1[12]);
    asm volatile("" : "+v"(T0), "+v"(T1), "+v"(n0), "+v"(n1), "+v"(n2), "+v"(n3), "+v"(sacc)); ATT_SBAR();
    f3l = vtr(vpn + 3072); f3h = vtr(vpn + 3072 + 512);
    S1 = __builtin_amdgcn_mfma_f32_32x32x16_bf16(k1, qr[5], S1, 0, 0, 0);
    T1[13] = __builtin_amdgcn_exp2f(T1[13]);
    sacc += T1[12]; sacc += T1[13];
    n3[2] = cvtpk_s(T1[12], T1[13]);
    T1[14] = __builtin_amdgcn_exp2f(T1[14]);
    T1[15] = __builtin_amdgcn_exp2f(T1[15]);
    sacc += T1[14]; sacc += T1[15];
    n3[3] = cvtpk_s(T1[14], T1[15]);
    asm volatile("" : "+v"(T0), "+v"(T1), "+v"(n0), "+v"(n1), "+v"(n2), "+v"(n3), "+v"(sacc)); ATT_SBAR();
}

constexpr int DKH0 = 32 * 256;
__device__ __forceinline__ void diff_step_a(f32x16* o, f32x16& S0, f32x16& S1, f32x16& T0, f32x16& T1, const bf16x8 pw0, const bf16x8 pw1, const bf16x8 pw2, const bf16x8 pw3, v4u& n0, v4u& n1, v4u& n2, v4u& n3, const bf16x8* qr, lds_cptr vp, lds_cptr ks, const int* kb, lds_cptr vpn, s16x4& f0l, s16x4& f0h, s16x4& f1l, s16x4& f1h, s16x4& f2l, s16x4& f2h, bf16x8& k0, bf16x8& k1, bf16x8& k2, float& sacc, float sg, float cbase) {
    f2l = vtr(vp + 2048); f2h = vtr(vp + 2048 + 512);
    o[0] = __builtin_amdgcn_mfma_f32_32x32x16_bf16(pw0, ATT_PK2(f0l, f0h), o[0], 0, 0, 0);
    S0[0] = fmaf(sg, 0.0f, cbase);
    S1[0] = fmaf(sg, 32.0f, cbase);
    S0[1] = fmaf(sg, 1.0f, cbase);
    T0[0] = __builtin_amdgcn_exp2f(T0[0]);
    T0[1] = __builtin_amdgcn_exp2f(T0[1]);
    asm volatile("" : "+v"(T0), "+v"(T1), "+v"(n0), "+v"(n1), "+v"(n2), "+v"(n3), "+v"(sacc), "+v"(S0), "+v"(S1)); ATT_SBAR();
    f0l = vtr(vp + 3072); f0h = vtr(vp + 3072 + 512);
    o[0] = __builtin_amdgcn_mfma_f32_32x32x16_bf16(pw1, ATT_PK2(f1l, f1h), o[0], 0, 0, 0);
    S1[1] = fmaf(sg, 33.0f, cbase);
    S0[2] = fmaf(sg, 2.0f, cbase);
    sacc += T0[0]; sacc += T0[1];
    n0[0] = cvtpk_s(T0[0], T0[1]);
    T0[2] = __builtin_amdgcn_exp2f(T0[2]);
    asm volatile("" : "+v"(T0), "+v"(T1), "+v"(n0), "+v"(n1), "+v"(n2), "+v"(n3), "+v"(sacc), "+v"(S0), "+v"(S1)); ATT_SBAR();
    f1l = vtr(vp + 4096); f1h = vtr(vp + 4096 + 512);
    o[0] = __builtin_amdgcn_mfma_f32_32x32x16_bf16(pw2, ATT_PK2(f2l, f2h), o[0], 0, 0, 0);
    S1[2] = fmaf(sg, 34.0f, cbase);
    S0[3] = fmaf(sg, 3.0f, cbase);
    T0[3] = __builtin_amdgcn_exp2f(T0[3]);
    sacc += T0[2]; sacc += T0[3];
    asm volatile("" : "+v"(T0), "+v"(T1), "+v"(n0), "+v"(n1), "+v"(n2), "+v"(n3), "+v"(sacc), "+v"(S0), "+v"(S1)); ATT_SBAR();
    f2l = vtr(vp + 5120); f2h = vtr(vp + 5120 + 512);
    o[0] = __builtin_amdgcn_mfma_f32_32x32x16_bf16(pw3, ATT_PK2(f0l, f0h), o[0], 0, 0, 0);
    S1[3] = fmaf(sg, 35.0f, cbase);
    S0[4] = fmaf(sg, 8.0f, cbase);
    S1[4] = fmaf(sg, 40.0f, cbase);
    n0[1] = cvtpk_s(T0[2], T0[3]);
    T0[4] = __builtin_amdgcn_exp2f(T0[4]);
    asm volatile("" : "+v"(T0), "+v"(T1), "+v"(n0), "+v"(n1), "+v"(n2), "+v"(n3), "+v"(sacc), "+v"(S0), "+v"(S1)); ATT_SBAR();
    f0l = vtr(vp + 6144); f0h = vtr(vp + 6144 + 512);
    o[1] = __builtin_amdgcn_mfma_f32_32x32x16_bf16(pw0, ATT_PK2(f1l, f1h), o[1], 0, 0, 0);
    S0[5] = fmaf(sg, 9.0f, cbase);
    S1[5] = fmaf(sg, 41.0f, cbase);
    T0[5] = __builtin_amdgcn_exp2f(T0[5]);
    sacc += T0[4]; sacc += T0[5];
    asm volatile("" : "+v"(T0), "+v"(T1), "+v"(n0), "+v"(n1), "+v"(n2), "+v"(n3), "+v"(sacc), "+v"(S0), "+v"(S1)); ATT_SBAR();
    f1l = vtr(vp + 7168); f1h = vtr(vp + 7168 + 512);
    o[1] = __builtin_amdgcn_mfma_f32_32x32x16_bf16(pw1, ATT_PK2(f2l, f2h), o[1], 0, 0, 0);
    S0[6] = fmaf(sg, 10.0f, cbase);
    S1[6] = fmaf(sg, 42.0f, cbase);
    n0[2] = cvtpk_s(T0[4], T0[5]);
    T0[6] = __builtin_amdgcn_exp2f(T0[6]);
    T0[7] = __builtin_amdgcn_exp2f(T0[7]);
    asm volatile("" : "+v"(T0), "+v"(T1), "+v"(n0), "+v"(n1), "+v"(n2), "+v"(n3), "+v"(sacc), "+v"(S0), "+v"(S1)); ATT_SBAR();
    f2l = vtr(vp + 8192); f2h = vtr(vp + 8192 + 512);
    o[1] = __builtin_amdgcn_mfma_f32_32x32x16_bf16(pw2, ATT_PK2(f0l, f0h), o[1], 0, 0, 0);
    S0[7] = fmaf(sg, 11.0f, cbase);
    S1[7] = fmaf(sg, 43.0f, cbase);
    sacc += T0[6]; sacc += T0[7];
    n0[3] = cvtpk_s(T0[6], T0[7]);
    T0[8] = __builtin_amdgcn_exp2f(T0[8]);
    asm volatile("" : "+v"(T0), "+v"(T1), "+v"(n0), "+v"(n1), "+v"(n2), "+v"(n3), "+v"(sacc), "+v"(S0), "+v"(S1)); ATT_SBAR();
    f0l = vtr(vp + 9216); f0h = vtr(vp + 9216 + 512);
    o[1] = __builtin_amdgcn_mfma_f32_32x32x16_bf16(pw3, ATT_PK2(f1l, f1h), o[1], 0, 0, 0);
    S0[8] = fmaf(sg, 16.0f, cbase);
    S1[8] = fmaf(sg, 48.0f, cbase);
    S0[9] = fmaf(sg, 17.0f, cbase);
    T0[9] = __builtin_amdgcn_exp2f(T0[9]);
    sacc += T0[8]; sacc += T0[9];
    asm volatile("" : "+v"(T0), "+v"(T1), "+v"(n0), "+v"(n1), "+v"(n2), "+v"(n3), "+v"(sacc), "+v"(S0), "+v"(S1)); ATT_SBAR();
    f1l = vtr(vp + 10240); f1h = vtr(vp + 10240 + 512);
    o[2] = __builtin_amdgcn_mfma_f32_32x32x16_bf16(pw0, ATT_PK2(f2l, f2h), o[2], 0, 0, 0);
    S1[9] = fmaf(sg, 49.0f, cbase);
    S0[10] = fmaf(sg, 18.0f, cbase);
    n1[0] = cvtpk_s(T0[8], T0[9]);
    T0[10] = __builtin_amdgcn_exp2f(T0[10]);
    T0[11] = __builtin_amdgcn_exp2f(T0[11]);
    asm volatile("" : "+v"(T0), "+v"(T1), "+v"(n0), "+v"(n1), "+v"(n2), "+v"(n3), "+v"(sacc), "+v"(S0), "+v"(S1)); ATT_SBAR();
    f2l = vtr(vp + 11264); f2h = vtr(vp + 11264 + 512);
    o[2] = __builtin_amdgcn_mfma_f32_32x32x16_bf16(pw1, ATT_PK2(f0l, f0h), o[2], 0, 0, 0);
    S1[10] = fmaf(sg, 50.0f, cbase);
    S0[11] = fmaf(sg, 19.0f, cbase);
    sacc += T0[10]; sacc += T0[11];
    n1[1] = cvtpk_s(T0[10], T0[11]);
    T0[12] = __builtin_amdgcn_exp2f(T0[12]);
    asm volatile("" : "+v"(T0), "+v"(T1), "+v"(n0), "+v"(n1), "+v"(n2), "+v"(n3), "+v"(sacc), "+v"(S0), "+v"(S1)); ATT_SBAR();
}
__device__ __forceinline__ void diff_step_b(f32x16* o, f32x16& S0, f32x16& S1, f32x16& T0, f32x16& T1, const bf16x8 pw0, const bf16x8 pw1, const bf16x8 pw2, const bf16x8 pw3, v4u& n0, v4u& n1, v4u& n2, v4u& n3, const bf16x8* qr, lds_cptr vp, lds_cptr ks, const int* kb, lds_cptr vpn, s16x4& f0l, s16x4& f0h, s16x4& f1l, s16x4& f1h, s16x4& f2l, s16x4& f2h, bf16x8& k0, bf16x8& k1, bf16x8& k2, float& sacc, float sg, float cbase) {
    f0l = vtr(vp + 12288); f0h = vtr(vp + 12288 + 512);
    o[2] = __builtin_amdgcn_mfma_f32_32x32x16_bf16(pw2, ATT_PK2(f1l, f1h), o[2], 0, 0, 0);
    S1[11] = fmaf(sg, 51.0f, cbase);
    S0[12] = fmaf(sg, 24.0f, cbase);
    S1[12] = fmaf(sg, 56.0f, cbase);
    T0[13] = __builtin_amdgcn_exp2f(T0[13]);
    sacc += T0[12]; sacc += T0[13];
    asm volatile("" : "+v"(T0), "+v"(T1), "+v"(n0), "+v"(n1), "+v"(n2), "+v"(n3), "+v"(sacc), "+v"(S0), "+v"(S1)); ATT_SBAR();
    f1l = vtr(vp + 13312); f1h = vtr(vp + 13312 + 512);
    o[2] = __builtin_amdgcn_mfma_f32_32x32x16_bf16(pw3, ATT_PK2(f2l, f2h), o[2], 0, 0, 0);
    S0[13] = fmaf(sg, 25.0f, cbase);
    S1[13] = fmaf(sg, 57.0f, cbase);
    n1[2] = cvtpk_s(T0[12], T0[13]);
    T0[14] = __builtin_amdgcn_exp2f(T0[14]);
    T0[15] = __builtin_amdgcn_exp2f(T0[15]);
    asm volatile("" : "+v"(T0), "+v"(T1), "+v"(n0), "+v"(n1), "+v"(n2), "+v"(n3), "+v"(sacc), "+v"(S0), "+v"(S1)); ATT_SBAR();
    f2l = vtr(vp + 14336); f2h = vtr(vp + 14336 + 512);
    o[3] = __builtin_amdgcn_mfma_f32_32x32x16_bf16(pw0, ATT_PK2(f0l, f0h), o[3], 0, 0, 0);
    S0[14] = fmaf(sg, 26.0f, cbase);
    S1[14] = fmaf(sg, 58.0f, cbase);
    sacc += T0[14]; sacc += T0[15];
    n1[3] = cvtpk_s(T0[14], T0[15]);
    T1[0] = __builtin_amdgcn_exp2f(T1[0]);
    asm volatile("" : "+v"(T0), "+v"(T1), "+v"(n0), "+v"(n1), "+v"(n2), "+v"(n3), "+v"(sacc), "+v"(S0), "+v"(S1)); ATT_SBAR();
    f0l = vtr(vp + 15360); f0h = vtr(vp + 15360 + 512);
    o[3] = __builtin_amdgcn_mfma_f32_32x32x16_bf16(pw1, ATT_PK2(f1l, f1h), o[3], 0, 0, 0);
    S0[15] = fmaf(sg, 27.0f, cbase);
    S1[15] = fmaf(sg, 59.0f, cbase);
    T1[1] = __builtin_amdgcn_exp2f(T1[1]);
    sacc += T1[0]; sacc += T1[1];
    asm volatile("" : "+v"(T0), "+v"(T1), "+v"(n0), "+v"(n1), "+v"(n2), "+v"(n3), "+v"(sacc), "+v"(S0), "+v"(S1)); ATT_SBAR();
    k0 = *(const LAS bf16x8*)(ks + kb[0] + 0 * DKH0);
    o[3] = __builtin_amdgcn_mfma_f32_32x32x16_bf16(pw2, ATT_PK2(f2l, f2h), o[3], 0, 0, 0);
    n2[0] = cvtpk_s(T1[0], T1[1]);
    T1[2] = __builtin_amdgcn_exp2f(T1[2]);
    T1[3] = __builtin_amdgcn_exp2f(T1[3]);
    sacc += T1[2]; sacc += T1[3];
    asm volatile("" : "+v"(T0), "+v"(T1), "+v"(n0), "+v"(n1), "+v"(n2), "+v"(n3), "+v"(sacc), "+v"(S0), "+v"(S1)); ATT_SBAR();
    k1 = *(const LAS bf16x8*)(ks + kb[0] + 1 * DKH0);
    o[3] = __builtin_amdgcn_mfma_f32_32x32x16_bf16(pw3, ATT_PK2(f0l, f0h), o[3], 0, 0, 0);
    n2[1] = cvtpk_s(T1[2], T1[3]);
    T1[4] = __builtin_amdgcn_exp2f(T1[4]);
    T1[5] = __builtin_amdgcn_exp2f(T1[5]);
    sacc += T1[4]; sacc += T1[5];
    asm volatile("" : "+v"(T0), "+v"(T1), "+v"(n0), "+v"(n1), "+v"(n2), "+v"(n3), "+v"(sacc)); ATT_SBAR();
    k2 = *(const LAS bf16x8*)(ks + kb[1] + 0 * DKH0);
    S0 = __builtin_amdgcn_mfma_f32_32x32x16_bf16(k0, qr[0], S0, 0, 0, 0);
    n2[2] = cvtpk_s(T1[4], T1[5]);
    T1[6] = __builtin_amdgcn_exp2f(T1[6]);
    T1[7] = __builtin_amdgcn_exp2f(T1[7]);
    sacc += T1[6]; sacc += T1[7];
    asm volatile("" : "+v"(T0), "+v"(T1), "+v"(n0), "+v"(n1), "+v"(n2), "+v"(n3), "+v"(sacc)); ATT_SBAR();
    k0 = *(const LAS bf16x8*)(ks + kb[1] + 1 * DKH0);
    S1 = __builtin_amdgcn_mfma_f32_32x32x16_bf16(k1, qr[0], S1, 0, 0, 0);
    n2[3] = cvtpk_s(T1[6], T1[7]);
    T1[8] = __builtin_amdgcn_exp2f(T1[8]);
    T1[9] = __builtin_amdgcn_exp2f(T1[9]);
    sacc += T1[8]; sacc += T1[9];
    asm volatile("" : "+v"(T0), "+v"(T1), "+v"(n0), "+v"(n1), "+v"(n2), "+v"(n3), "+v"(sacc)); ATT_SBAR();
    k1 = *(const LAS bf16x8*)(ks + kb[2] + 0 * DKH0);
    S0 = __builtin_amdgcn_mfma_f32_32x32x16_bf16(k2, qr[1], S0, 0, 0, 0);
    n3[0] = cvtpk_s(T1[8], T1[9]);
    T1[10] = __builtin_amdgcn_exp2f(T1[10]);
    T1[11] = __builtin_amdgcn_exp2f(T1[11]);
    sacc += T1[10]; sacc += T1[11];
    asm volatile("" : "+v"(T0), "+v"(T1), "+v"(n0), "+v"(n1), "+v"(n2), "+v"(n3), "+v"(sacc)); ATT_SBAR();
    k2 = *(const LAS bf16x8*)(ks + kb[2] + 1 * DKH0);
    S1 = __builtin_amdgcn_mfma_f32_32x32x16_bf16(k0, qr[1], S1, 0, 0, 0);
    n3[1] = cvtpk_s(T1[10], T1[11]);
    T1[12] = __builtin_amdgcn_exp2f(T1[12]);
    T1[13] = __builtin_amdgcn_exp2f(T1[13]);
    sacc += T1[12]; sacc += T1[13];
    asm volatile("" : "+v"(T0), "+v"(T1), "+v"(n0), "+v"(n1), "+v"(n2), "+v"(n3), "+v"(sacc)); ATT_SBAR();
    k0 = *(const LAS bf16x8*)(ks + kb[3] + 0 * DKH0);
    S0 = __builtin_amdgcn_mfma_f32_32x32x16_bf16(k1, qr[2], S0, 0, 0, 0);
    n3[2] = cvtpk_s(T1[12], T1[13]);
    T1[14] = __builtin_amdgcn_exp2f(T1[14]);
    T1[15] = __builtin_amdgcn_exp2f(T1[15]);
    sacc += T1[14]; sacc += T1[15];
    asm volatile("" : "+v"(T0), "+v"(T1), "+v"(n0), "+v"(n1), "+v"(n2), "+v"(n3), "+v"(sacc)); ATT_SBAR();
    k1 = *(const LAS bf16x8*)(ks + kb[3] + 1 * DKH0);
    S1 = __builtin_amdgcn_mfma_f32_32x32x16_bf16(k2, qr[2], S1, 0, 0, 0);
    n3[3] = cvtpk_s(T1[14], T1[15]);
    asm volatile("" : "+v"(T0), "+v"(T1), "+v"(n0), "+v"(n1), "+v"(n2), "+v"(n3), "+v"(sacc)); ATT_SBAR();
    f0l = vtr(vpn + 0); f0h = vtr(vpn + 0 + 512);
    S0 = __builtin_amdgcn_mfma_f32_32x32x16_bf16(k0, qr[3], S0, 0, 0, 0);
    asm volatile("" : "+v"(T0), "+v"(T1), "+v"(n0), "+v"(n1), "+v"(n2), "+v"(n3), "+v"(sacc)); ATT_SBAR();
    f1l = vtr(vpn + 1024); f1h = vtr(vpn + 1024 + 512);
    S1 = __builtin_amdgcn_mfma_f32_32x32x16_bf16(k1, qr[3], S1, 0, 0, 0);
    asm volatile("" : "+v"(T0), "+v"(T1), "+v"(n0), "+v"(n1), "+v"(n2), "+v"(n3), "+v"(sacc)); ATT_SBAR();
}
}
}
namespace mk {
namespace att {
#define ATT_NXT(x, n, sz) (((x) == ((n) - 1) * (sz)) ? 0 : (x) + (sz))
#define ATT_BC(x) __builtin_bit_cast(bf16x8, x)

constexpr int M4_KB = 12 * 1024, M4_VB = 8 * 1024, M4_NK = 4, M4_NV = 6, M4_VOFF = M4_NK * M4_KB, M4_OST = 0;
__device__ __forceinline__ void mla_unit4(int b, int h, int qb, const bf16* QM, const bf16* KVM, const bf16* KROT, bf16* OCAT, LAS char* shm) {
    const int tid = threadIdx.x, lane = tid & 63, r32 = lane & 31, hi = lane >> 5; const int wid = __builtin_amdgcn_readfirstlane(tid >> 6);
    const bool w03 = wid < 4;
    const long rowbase = (long)b * SEQ; const int q0 = qb * 256;
    const unsigned lds0 = (unsigned)(uintptr_t)shm;
    LAS float* wsf = (LAS float*)(shm + ATT_WS_OFF) + wid * 64;
    bf16x8 qr[6];
    { const bf16* Qw = QM + (rowbase + q0 + wid * 32 + r32) * 768 + h * 96 + hi * 8;
#pragma unroll
      for (int d0 = 0; d0 < 6; ++d0) qr[d0] = *(const bf16x8*)(Qw + d0 * 16); }
    const char* kvbase = (const char*)(KVM + rowbase * 1024 + h * 128); const char* krbase = (const char*)(KROT + rowbase * 32);
    const int kr8 = 8 * wid + (lane >> 3), kr16 = 16 * (wid & 3) + (lane >> 2);
    const unsigned koffA = (unsigned)(kr8 * 2048 + (((lane & 7) ^ ((kr8 >> 1) & 7)) << 4));
    const unsigned koffB = (unsigned)(kr16 * 64 + (((lane & 3) ^ ((kr16 >> 2) & 3)) << 4));
    const unsigned voffs = (unsigned)((16 * (wid & 3) + (lane >> 2)) * 1024 + 64 + (wid >> 2) * 32 + (lane & 3) * 8) * 2u;
#define M4_DMA(t, kd_, vd_) do { const char* kvt_ = uptr(kvbase + (size_t)(t) * (64 * 1024 * 2)); \
        glds16s(kvt_, koffA, (unsigned)__builtin_amdgcn_readfirstlane(lds0 + (kd_) + wid * 1024)); \
        if (w03) glds16s(uptr(krbase + (size_t)(t) * (64 * 32 * 2)), koffB, (unsigned)__builtin_amdgcn_readfirstlane(lds0 + (kd_) + (8 + wid) * 1024)); \
        glds16s(kvt_, voffs, (unsigned)__builtin_amdgcn_readfirstlane(lds0 + M4_VOFF + (vd_) + wid * 1024)); } while (0)
    const int vofs = M4_VOFF + ((lane >> 4) & 1) * 32 + (lane & 3) * 8 + (4 * hi + ((lane & 15) >> 2)) * 64;
    int kb[6];
#pragma unroll
    for (int d0 = 0; d0 < 4; ++d0) kb[d0] = r32 * 128 + (((2 * d0 + hi) ^ ((r32 >> 1) & 7)) << 4);
#pragma unroll
    for (int d0 = 4; d0 < 6; ++d0) kb[d0] = 8192 + r32 * 64 + (((2 * (d0 - 4) + hi) ^ ((r32 >> 2) & 3)) << 4);
    float l_reg = 0.f; f32x16 o[2]; o[0] = f32x16{}; o[1] = f32x16{};
    f32x16 SA0, SA1, SB0, SB1; v4u wA0 = {0u, 0u, 0u, 0u}, wA1 = wA0, wA2 = wA0, wA3 = wA0, wB0 = wA0, wB1 = wA0, wB2 = wA0, wB3 = wA0;
    s16x4 f0l, f0h, f1l, f1h, f2l, f2h, f3l, f3h, f4l, f4h; bf16x8 k0, k1, k2, k3, k4;
    constexpr int NT = SEQ / 64;
#define M4_BAR(t) do { if ((t) + 3 < NT) { if (w03) ATT_WAIT_BARN(6); else ATT_WAIT_BARN(4); } else ATT_WAIT_BAR0(); } while (0)
#define M4_ARGS(S, T, W, N) o, S##0, S##1, T##0, T##1, ATT_BC(W##0), ATT_BC(W##1), ATT_BC(W##2), ATT_BC(W##3), N##0, N##1, N##2, N##3, qr, \
                 (lds_cptr)shm + vsm1 + vofs, (lds_cptr)shm + ks1, kb, (lds_cptr)shm + vs0 + vofs, f0l, f0h, f1l, f1h, f2l, f2h, f3l, f3h, f4l, f4h, k0, k1, k2, k3, k4, l_reg
#define M4_STEP(t, S, T, W, N) do { M4_BAR(t); \
        mla_step_a(M4_ARGS(S, T, W, N)); \
        if ((t) + 4 < NT) M4_DMA((t) + 4, kd, vd);               \
        mla_step_b(M4_ARGS(S, T, W, N)); \
        vsm1 = vs0; vs0 = ATT_NXT(vs0, M4_NV, M4_VB); ks1 = ATT_NXT(ks1, M4_NK, M4_KB); kd = ATT_NXT(kd, M4_NK, M4_KB); vd = ATT_NXT(vd, M4_NV, M4_VB); } while (0)
    M4_DMA(0, 0, 0); M4_DMA(1, M4_KB, M4_VB); M4_DMA(2, 2 * M4_KB, 2 * M4_VB); M4_DMA(3, 3 * M4_KB, 3 * M4_VB);
    if (w03) ATT_WAIT_BARN(9); else ATT_WAIT_BARN(6);
    { SA0 = f32x16{}; SA1 = f32x16{};
#pragma unroll
      for (int d0 = 0; d0 < 6; ++d0) { const lds_cptr kp_ = (lds_cptr)shm + kb[d0]; const int kh_ = d0 < 4 ? 32 * 128 : 32 * 64;
          SA0 = __builtin_amdgcn_mfma_f32_32x32x16_bf16(*(const LAS bf16x8*)kp_, qr[d0], SA0, 0, 0, 0); SA1 = __builtin_amdgcn_mfma_f32_32x32x16_bf16(*(const LAS bf16x8*)(kp_ + kh_), qr[d0], SA1, 0, 0, 0); } }
    { const lds_cptr vp_ = (lds_cptr)shm + vofs; f0l = vtr(vp_); f0h = vtr(vp_ + 512); f1l = vtr(vp_ + 1024); f1h = vtr(vp_ + 1024 + 512); f2l = vtr(vp_ + 2048); f2h = vtr(vp_ + 2048 + 512); f3l = vtr(vp_ + 3072); f3h = vtr(vp_ + 3072 + 512); }
    int ks1 = M4_KB, vsm1 = 0, vs0 = 0, kd = 0, vd = 4 * M4_VB;
    for (int t = 0; t < NT; t += 2) {
        M4_STEP(t, SB, SA, wB, wA);
        M4_STEP(t + 1, SA, SB, wA, wB);
    }
    ATT_LBAR();
    pv<2>(o, (lds_cptr)shm + vsm1 + vofs, ATT_BC(wB0), ATT_BC(wB1), ATT_BC(wB2), ATT_BC(wB3));
    ATT_LBAR();
#undef M4_DMA
#undef M4_BAR
#undef M4_STEP
#undef M4_ARGS
    int lane_e = lane; asm volatile("" : "+v"(lane_e)); const int r32e = lane_e & 31, hie = lane_e >> 5;
    { auto rr = __builtin_amdgcn_permlane32_swap(__float_as_uint(l_reg), __float_as_uint(l_reg), false, false); l_reg = __uint_as_float(rr[0]) + __uint_as_float(rr[1]); }
    if (hie == 0) wsf[32 + r32e] = l_reg;
    asm volatile("s_waitcnt lgkmcnt(0)" ::: "memory");
    float rli[16];
#pragma unroll
    for (int r = 0; r < 16; ++r) rli[r] = __builtin_amdgcn_rcpf((wsf + 32 + 4 * hie)[(r & 3) + 8 * (r >> 2)]);
    bf16* Ow = OCAT + (rowbase + q0 + wid * 32) * 1024 + h * 64;
    { LAS bf16* stg = (LAS bf16*)(shm + M4_OST) + wid * 2048;
#pragma unroll
      for (int r = 0; r < 16; ++r) { const int orow = crow(r, hie);
#pragma unroll
          for (int d0 = 0; d0 < 2; ++d0) stg[orow * 64 + d0 * 32 + r32e] = (bf16)(cvtpk_s(o[d0][r] * rli[r], 0.f) & 0xffffu); }
      asm volatile("s_waitcnt lgkmcnt(0)" ::: "memory");
#pragma unroll
      for (int i = 0; i < 4; ++i) { const int row = i * 8 + (lane_e >> 3), ch = lane_e & 7; const v4u v = *(const LAS v4u*)(stg + row * 64 + ch * 8); *(v4u*)(Ow + (long)row * 1024 + ch * 8) = v; } }
    ATT_LBAR();
}

constexpr int D4_KB = 16 * 1024, D4_VB = 16 * 1024, D4_NK = 3, D4_NV = 5, D4_VOFF = D4_NK * D4_KB, D4_X = 0, D4_OST = 65536;
__device__ __forceinline__ void diff_unit4(int b, int h, int qb, int t_lo, int NT, const bf16* QD, const bf16* KD, const bf16* VD, bf16* OCAT, float lam, const float* gsub, LAS char* shm) {
    const int tid = threadIdx.x, lane = tid & 63, r32 = lane & 31, hi = lane >> 5; const int wid = __builtin_amdgcn_readfirstlane(tid >> 6);
    const int w4 = wid & 3, mp = wid >> 2;
    const long rowbase = (long)b * SEQ; const int q0 = qb * 128;
    const unsigned lds0 = (unsigned)(uintptr_t)shm;
    LAS float* wsf = (LAS float*)(shm + ATT_WS_OFF) + wid * 64;
    bf16x8 qr[4];
    { const bf16* Qw = QD + (rowbase + q0 + w4 * 32 + r32) * 512 + h * 128 + mp * 64 + hi * 8;
#pragma unroll
      for (int d0 = 0; d0 < 4; ++d0) qr[d0] = *(const bf16x8*)(Qw + d0 * 16); }
    const char* kbase = (const char*)(KD + rowbase * 512 + h * 128); const char* vbase = (const char*)(VD + rowbase * 512 + h * 128);
    const int kr4 = 4 * wid + (lane >> 4);
    const unsigned koffs = (unsigned)(kr4 * 1024 + (((lane & 15) ^ (kr4 & 15)) << 4));
    const unsigned voffs = (unsigned)((16 * (wid & 3) + (lane >> 2)) * 512 + (wid >> 2) * 32 + (lane & 3) * 8) * 2u;
#define D4_DMA(t, kd_, vd_) do { const char* kt_ = uptr(kbase + (size_t)(t) * (64 * 512 * 2)); const char* vt_ = uptr(vbase + (size_t)(t) * (64 * 512 * 2)); \
        glds16s(kt_, koffs, (unsigned)__builtin_amdgcn_readfirstlane(lds0 + (kd_) + wid * 1024)); \
        glds16s(kt_ + 32 * 1024, koffs, (unsigned)__builtin_amdgcn_readfirstlane(lds0 + (kd_) + (8 + wid) * 1024)); \
        glds16s(vt_, voffs, (unsigned)__builtin_amdgcn_readfirstlane(lds0 + D4_VOFF + (vd_) + wid * 1024)); \
        glds16s(vt_ + 128, voffs, (unsigned)__builtin_amdgcn_readfirstlane(lds0 + D4_VOFF + (vd_) + (8 + wid) * 1024)); } while (0)
    const int vofs = D4_VOFF + ((lane >> 4) & 1) * 32 + (lane & 3) * 8 + (4 * hi + ((lane & 15) >> 2)) * 64;
    int kb[4];
#pragma unroll
    for (int d0 = 0; d0 < 4; ++d0) kb[d0] = r32 * 256 + (((8 * mp + 2 * d0 + hi) ^ (r32 & 15)) << 4);
    const float sl2 = __builtin_amdgcn_exp2f(-2.f * (float)(h + 1)) * LOG2E;
    const int qpos = q0 + w4 * 32 + r32;
    const int t_d = (q0 + w4 * 32) >> 6;
    float l_reg = 0.f; f32x16 o[4]; o[0] = f32x16{}; o[1] = f32x16{}; o[2] = f32x16{}; o[3] = f32x16{};
    f32x16 SA0, SA1, SB0, SB1; v4u wA0 = {0u, 0u, 0u, 0u}, wA1 = wA0, wA2 = wA0, wA3 = wA0, wB0 = wA0, wB1 = wA0, wB2 = wA0, wB3 = wA0;
    s16x4 f0l, f0h, f1l, f1h, f2l, f2h; bf16x8 k0, k1, k2;
#define D4_DIAG(T, S0, S1) do { if ((T) == t_d) { int x0_ = (T) * 64 + 4 * hi - qpos; asm volatile("" : "+v"(x0_)); \
        _Pragma("unroll") for (int r = 0; r < 16; ++r) { const int x = x0_ + ((r & 3) + 8 * (r >> 2)); S0[r] -= 2.f * sl2 * fmaxf((float)x, 0.f); S1[r] -= 2.f * sl2 * fmaxf((float)(x + 32), 0.f); } } } while (0)
#define D4_BAR(t) do { if ((t) + 2 < NT) ATT_WAIT_BARN(4); else ATT_WAIT_BAR0(); } while (0)
#define D4_ARGS(S, T, W, N) o, S##0, S##1, T##0, T##1, ATT_BC(W##0), ATT_BC(W##1), ATT_BC(W##2), ATT_BC(W##3), N##0, N##1, N##2, N##3, qr, \
                    (lds_cptr)shm + vsm1 + vofs, (lds_cptr)shm + ks1, kb, (lds_cptr)shm + vs0 + vofs, f0l, f0h, f1l, f1h, f2l, f2h, k0, k1, k2, l_reg, sg_, cb_
#define D4_STEP(t, S, T, W, N) do { D4_BAR(t); \
        { const int T1_ = t_lo + (t) + 1; float sg_ = T1_ <= t_d ? sl2 : -sl2; asm volatile("" : "+v"(sg_)); const float cb_ = sg_ * (float)(T1_ * 64 + 4 * hi - qpos); \
          diff_step_a(D4_ARGS(S, T, W, N)); \
          if ((t) + 3 < NT) D4_DMA(t_lo + (t) + 3, kd, vd); \
          diff_step_b(D4_ARGS(S, T, W, N)); \
          D4_DIAG(T1_, S##0, S##1); } \
        vsm1 = vs0; vs0 = ATT_NXT(vs0, D4_NV, D4_VB); ks1 = ATT_NXT(ks1, D4_NK, D4_KB); kd = ATT_NXT(kd, D4_NK, D4_KB); vd = ATT_NXT(vd, D4_NV, D4_VB); } while (0)
    D4_DMA(t_lo, 0, 0); D4_DMA(t_lo + 1, D4_KB, D4_VB); D4_DMA(t_lo + 2, 2 * D4_KB, 2 * D4_VB);
    ATT_WAIT_BARN(8);
    { f32x16 c0_, c1_; const float sg_ = t_lo <= t_d ? sl2 : -sl2; const float cb_ = sg_ * (float)(t_lo * 64 + 4 * hi - qpos);
#pragma unroll
      for (int r = 0; r < 16; ++r) { c0_[r] = fmaf(sg_, (float)((r & 3) + 8 * (r >> 2)), cb_); c1_[r] = c0_[r] + 32.f * sg_; }
      SA0 = c0_; SA1 = c1_;
#pragma unroll
      for (int d0 = 0; d0 < 4; ++d0) { const lds_cptr kp_ = (lds_cptr)shm + kb[d0];
          SA0 = __builtin_amdgcn_mfma_f32_32x32x16_bf16(*(const LAS bf16x8*)kp_, qr[d0], SA0, 0, 0, 0); SA1 = __builtin_amdgcn_mfma_f32_32x32x16_bf16(*(const LAS bf16x8*)(kp_ + 32 * 256), qr[d0], SA1, 0, 0, 0); }
      D4_DIAG(t_lo, SA0, SA1); }
    { const lds_cptr vp_ = (lds_cptr)shm + vofs; f0l = vtr(vp_); f0h = vtr(vp_ + 512); f1l = vtr(vp_ + 1024); f1h = vtr(vp_ + 1024 + 512); }
    int ks1 = D4_KB, vsm1 = 0, vs0 = 0, kd = 0, vd = 3 * D4_VB;
    for (int t = 0; t < NT; t += 2) {
        D4_STEP(t, SB, SA, wB, wA);
        D4_STEP(t + 1, SA, SB, wA, wB);
    }
    ATT_LBAR();
    pv<4>(o, (lds_cptr)shm + vsm1 + vofs, ATT_BC(wB0), ATT_BC(wB1), ATT_BC(wB2), ATT_BC(wB3));
#undef D4_DMA
#undef D4_DIAG
#undef D4_BAR
#undef D4_STEP
#undef D4_ARGS
    int lane_e = lane; asm volatile("" : "+v"(lane_e)); const int r32e = lane_e & 31, hie = lane_e >> 5;
    { auto rr = __builtin_amdgcn_permlane32_swap(__float_as_uint(l_reg), __float_as_uint(l_reg), false, false); l_reg = __uint_as_float(rr[0]) + __uint_as_float(rr[1]); }
    if (hie == 0) wsf[32 + r32e] = l_reg;
    asm volatile("s_waitcnt lgkmcnt(0)" ::: "memory");
#pragma unroll
    for (int r = 0; r < 16; ++r) { const float rl_ = __builtin_amdgcn_rcpf((wsf + 32 + 4 * hie)[(r & 3) + 8 * (r >> 2)]) * (mp == 1 ? lam : 1.f);
#pragma unroll
        for (int d0 = 0; d0 < 4; ++d0) o[d0][r] *= rl_; }
    ATT_LBAR();
    LAS float* X = (LAS float*)(shm + D4_X);
    if (mp == 1) {
#pragma unroll
        for (int r = 0; r < 16; ++r) { LAS float* xr = X + (w4 * 32 + 4 * hie) * 128 + r32e;
#pragma unroll
            for (int d0 = 0; d0 < 4; ++d0) xr[((r & 3) + 8 * (r >> 2)) * 128 + d0 * 32] = o[d0][r]; }
    }
    ATT_LBAR();
    if (mp == 0) {
        float gs[4];
#pragma unroll
        for (int d0 = 0; d0 < 4; ++d0) gs[d0] = gsub[d0 * 32 + r32e] * 0.8f;
        LAS bf16* stg = (LAS bf16*)(shm + D4_OST) + w4 * 4096 + 4 * hie * 128 + r32e;
        const LAS float* xr = X + (w4 * 32 + 4 * hie) * 128 + r32e;
#pragma unroll
        for (int r = 0; r < 16; ++r) { const int c0r = (r & 3) + 8 * (r >> 2); float v[4]; float ss = 0.f;
#pragma unroll
            for (int d0 = 0; d0 < 4; ++d0) { v[d0] = o[d0][r] - xr[c0r * 128 + d0 * 32]; ss += v[d0] * v[d0]; }
            ss += __int_as_float(__builtin_amdgcn_ds_swizzle(__float_as_int(ss), 0x041F)); ss += __int_as_float(__builtin_amdgcn_ds_swizzle(__float_as_int(ss), 0x081F));
            ss += __int_as_float(__builtin_amdgcn_ds_swizzle(__float_as_int(ss), 0x101F)); ss += __int_as_float(__builtin_amdgcn_ds_swizzle(__float_as_int(ss), 0x201F));
            ss += __int_as_float(__builtin_amdgcn_ds_swizzle(__float_as_int(ss), 0x401F));
            const float rr = __builtin_amdgcn_rsqf(ss * (1.f / 128.f) + EPS);
#pragma unroll
            for (int d0 = 0; d0 < 4; ++d0) stg[c0r * 128 + d0 * 32] = (bf16)(cvtpk_s(v[d0] * rr * gs[d0], 0.f) & 0xffffu); }
        asm volatile("s_waitcnt lgkmcnt(0)" ::: "memory");
        bf16* Ow = OCAT + (rowbase + q0 + w4 * 32) * 1024 + 512 + h * 128;
        const LAS bf16* stg0 = (const LAS bf16*)(shm + D4_OST) + w4 * 4096;
#pragma unroll
        for (int i = 0; i < 8; ++i) { const int row = i * 4 + (lane_e >> 4), ch = lane_e & 15; const v4u v = *(const LAS v4u*)(stg0 + row * 128 + ch * 8); *(v4u*)(Ow + (long)row * 1024 + ch * 8) = v; }
    }
    ATT_LBAR();
}
#undef ATT_NXT
#undef ATT_BC
}
}
namespace mk {
namespace pg8 {
__device__ __forceinline__ v4u pack8(const f32x4 a, const f32x4 b, float s) { v4u w; w.x = cvt_pk_bf16(a[0] * s, a[1] * s); w.y = cvt_pk_bf16(a[2] * s, a[3] * s); w.z = cvt_pk_bf16(b[0] * s, b[1] * s); w.w = cvt_pk_bf16(b[2] * s, b[3] * s); return w; }
__device__ __forceinline__ float sq4(const f32x4 a) { return (a[0] * a[0] + a[1] * a[1]) + (a[2] * a[2] + a[3] * a[3]); }
__device__ __forceinline__ float fq_sum(float s) { s += __shfl_xor(s, 16); s += __shfl_xor(s, 32); return s; }
__device__ __forceinline__ void rope32(f32x4& x0, f32x4& x1, const float* g32, const float2* tabrow, int fq, float osc) {
    const float ms = fq_sum(sq4(x0) + sq4(x1)) * (1.f / 32.f);
    const float r = __builtin_amdgcn_rsqf(ms + EPS);
    const f32x4 g0 = *(const f32x4*)(g32 + 4 * fq), g1 = *(const f32x4*)(g32 + 16 + 4 * fq);
    const f32x4 t0 = *(const f32x4*)(tabrow + 4 * fq), t1 = *(const f32x4*)(tabrow + 4 * fq + 2);
    const float cs[4] = {t0[0], t0[2], t1[0], t1[2]}, sn[4] = {t0[1], t0[3], t1[1], t1[3]};
#pragma unroll
    for (int i = 0; i < 4; ++i) { const float a = x0[i] * r * g0[i], b = x1[i] * r * g1[i]; x0[i] = (a * cs[i] - b * sn[i]) * osc; x1[i] = (b * cs[i] + a * sn[i]) * osc; }
}
__device__ __forceinline__ void store_rope(bf16* dst, const f32x4 x0, const f32x4 x1, int fq) {
    v2u a; a.x = cvt_pk_bf16(x0[0], x0[1]); a.y = cvt_pk_bf16(x0[2], x0[3]); *(v2u*)(dst + 4 * fq) = a;
    v2u b; b.x = cvt_pk_bf16(x1[0], x1[1]); b.y = cvt_pk_bf16(x1[2], x1[3]); *(v2u*)(dst + 16 + 4 * fq) = b;
}

struct EpiWin {
    static constexpr bool PERM = true, AFTER_DRAIN = false, PRE = false;
    unsigned char* ws;
    __device__ __forceinline__ void operator()(const Acc& acc, const Unit& u, int wr, int wc, int fr, int fq) const {
        asm volatile("" : "+v"(fr), "+v"(fq));
        const float* ssq = (const float*)(ws + WS_S1); bf16* LATP = (bf16*)(ws + WS_LATP); float* QSS = (float*)(ws + WS_QSS); float* KSS = (float*)(ws + WS_KSS); bf16* KROT = (bf16*)(ws + WS_KROT);
        bf16* QD = (bf16*)(ws + WS_QD); bf16* KD = (bf16*)(ws + WS_KD); bf16* VD = (bf16*)(ws + WS_VD); const float2* tab = (const float2*)(ws + WS_TAB);
        const float* gdq = kin(I_GDQ); const float* gdk = kin(I_GDK); const float* gkr = kin(I_GMLAK) + 64;
        const int row0 = u.pm * BM + wr * 64 + fr, pn = u.pn;
        f32x4 g00 = {1.f, 1.f, 1.f, 1.f}, g01 = g00, g10 = g00, g11 = g00;
        if (pn >= 2 && pn < 6) { const float* g = (pn < 4 ? gdq : gdk) + 8 * fq; g00 = *(const f32x4*)g; g01 = *(const f32x4*)(g + 4); g10 = *(const f32x4*)(g + 32); g11 = *(const f32x4*)(g + 36); }
#pragma unroll
        for (int ai = 0; ai < 2; ++ai)
#pragma unroll
            for (int m = 0; m < 4; ++m) { const int row = row0 + ai * HALF + m * 16; const float r1 = rstd4(ssq, row, 1.f / DM);
                const f32x4 a00 = acc[ai][0][m][0] * r1, a01 = acc[ai][0][m][1] * r1, a10 = acc[ai][1][m][0] * r1, a11 = acc[ai][1][m][1] * r1;
                if (pn == 0) {
                    const float s = fq_sum((sq4(a00) + sq4(a01)) + (sq4(a10) + sq4(a11)));
                    if (fq == 0) QSS[(size_t)row * 4 + wc] = s;
                    bf16* d = LATP + (size_t)row * 768 + wc * 32 + 8 * fq;
                    *(v4u*)d = pack8(a00, a01, 1.f); *(v4u*)(d + HALF) = pack8(a10, a11, 1.f);
                } else if (pn == 1) {
                    const float s = fq_sum(sq4(a00) + sq4(a01));
                    if (fq == 0) KSS[(size_t)row * 4 + wc] = s;
                    bf16* d = LATP + (size_t)row * 768 + 256 + wc * 32 + 8 * fq;
                    *(v4u*)d = pack8(a00, a01, 1.f); *(v4u*)(d + HALF) = (v4u){0u, 0u, 0u, 0u};
                    if (wc == 0) { f32x4 x0 = a10, x1 = a11; rope32(x0, x1, gkr, tab + (size_t)(row % SEQ) * 16, fq, 1.f); store_rope(KROT + (size_t)row * 32, x0, x1, fq); }
                } else if (pn < 6) {
                    const bool isq = pn < 4; const int ch = 4 * ((pn - 2) & 1) + wc;
                    const float ms = fq_sum((sq4(a00) + sq4(a01)) + (sq4(a10) + sq4(a11))) * (1.f / 64.f);
                    const float r = __builtin_amdgcn_rsqf(ms + EPS) * (isq ? QSC_DIFF : 1.f);
                    bf16* d = (isq ? QD : KD) + (size_t)row * 512 + 64 * ch + 8 * fq;
                    *(v4u*)d = pack8(a00 * g00, a01 * g01, r); *(v4u*)(d + 32) = pack8(a10 * g10, a11 * g11, r);
                } else {
                    bf16* d = VD + (size_t)row * 512 + 256 * (pn - 6) + wc * 32 + 8 * fq;
                    *(v4u*)d = pack8(a00, a01, 1.f); *(v4u*)(d + HALF) = pack8(a10, a11, 1.f);
                }
            }
    }
};

struct EpiUp {
    static constexpr bool PERM = true, AFTER_DRAIN = false, PRE = false;
    unsigned char* ws;
    __device__ __forceinline__ void operator()(const Acc& acc, const Unit& u, int wr, int wc, int fr, int fq) const {
        asm volatile("" : "+v"(fr), "+v"(fq));
        const float* QSS = (const float*)(ws + WS_QSS); const float* KSS = (const float*)(ws + WS_KSS); bf16* QM = (bf16*)(ws + WS_QM); bf16* KVM = (bf16*)(ws + WS_KVM); const float2* tab = (const float2*)(ws + WS_TAB);
        const float* gq = kin(I_GMLAQ); const float* gk = kin(I_GMLAK);
        const int row0 = u.pm * BM + wr * 64 + fr, pn = u.pn;
        f32x4 g00 = {1.f, 1.f, 1.f, 1.f}, g01 = g00, g10 = g00, g11 = g00;
        if (pn < 2 || (pn >= 3 && (wc & 1) == 0)) { const float* g = (pn < 2 ? gq : gk) + 8 * fq; g00 = *(const f32x4*)g; g01 = *(const f32x4*)(g + 4); g10 = *(const f32x4*)(g + 32); g11 = *(const f32x4*)(g + 36); }
#pragma unroll
        for (int ai = 0; ai < 2; ++ai) {
#pragma unroll
            for (int m = 0; m < 4; ++m) { const int row = row0 + ai * HALF + m * 16;
                const float r2 = pn < 3 ? rstd4(QSS, row, 1.f / 256.f) : rstd4(KSS, row, 1.f / 128.f);
                const f32x4 a00 = acc[ai][0][m][0] * r2, a01 = acc[ai][0][m][1] * r2, a10 = acc[ai][1][m][0] * r2, a11 = acc[ai][1][m][1] * r2;
                if (pn < 2) {
                    const int h = 4 * pn + wc;
                    const float ms = fq_sum((sq4(a00) + sq4(a01)) + (sq4(a10) + sq4(a11))) * (1.f / 64.f);
                    const float r = __builtin_amdgcn_rsqf(ms + EPS) * QSC_MLA;
                    bf16* d = QM + (size_t)row * 768 + 96 * h + 8 * fq;
                    *(v4u*)d = pack8(a00 * g00, a01 * g01, r); *(v4u*)(d + 32) = pack8(a10 * g10, a11 * g11, r);
                } else if (pn == 2) {
                    const float2* tr = tab + (size_t)(row % SEQ) * 16;
                    { f32x4 x0 = a00, x1 = a01; rope32(x0, x1, gq + 64, tr, fq, QSC_MLA); store_rope(QM + (size_t)row * 768 + 96 * (2 * wc) + 64, x0, x1, fq); }
                    { f32x4 x0 = a10, x1 = a11; rope32(x0, x1, gq + 64, tr, fq, QSC_MLA); store_rope(QM + (size_t)row * 768 + 96 * (2 * wc + 1) + 64, x0, x1, fq); }
                } else {
                    const int cid = 4 * (pn - 3) + wc, head = cid >> 1, kind = cid & 1;
                    bf16* d = KVM + (size_t)row * 1024 + 128 * head + 64 * kind + 8 * fq;
                    if (kind == 0) {
                        const float ms = fq_sum((sq4(a00) + sq4(a01)) + (sq4(a10) + sq4(a11))) * (1.f / 64.f);
                        const float r = __builtin_amdgcn_rsqf(ms + EPS);
                        *(v4u*)d = pack8(a00 * g00, a01 * g01, r); *(v4u*)(d + 32) = pack8(a10 * g10, a11 * g11, r);
                    } else { *(v4u*)d = pack8(a00, a01, 1.f); *(v4u*)(d + 32) = pack8(a10, a11, 1.f); }
                }
            }
        }
    }
};
struct EpiPP {
    static constexpr bool PERM = true, AFTER_DRAIN = false, PRE = false;
    bf16* PP; float* SPP;
    __device__ __forceinline__ void operator()(const Acc& acc, const Unit& u, int wr, int wc, int fr, int fq) const {
        asm volatile("" : "+v"(fr), "+v"(fq));
        const int row0 = u.pm * BM + wr * 64 + fr, pn = u.pn;
#pragma unroll
        for (int ai = 0; ai < 2; ++ai)
#pragma unroll
            for (int m = 0; m < 4; ++m) { const int row = row0 + ai * HALF + m * 16;
                const f32x4 a00 = acc[ai][0][m][0], a01 = acc[ai][0][m][1], a10 = acc[ai][1][m][0], a11 = acc[ai][1][m][1];
                const float s = fq_sum((sq4(a00) + sq4(a01)) + (sq4(a10) + sq4(a11)));
                if (fq == 0) SPP[(size_t)row * 16 + pn * 4 + wc] = s;
                bf16* d = PP + (size_t)row * DM + 256 * pn + wc * 32 + 8 * fq;
                *(v4u*)d = pack8(a00, a01, 1.f); *(v4u*)(d + HALF) = pack8(a10, a11, 1.f); }
    }
};
}

__device__ __forceinline__ void pp_gemm(Frame& F, int G2, int c2) {
    pg8::Gemm g2{(const bf16*)F.ws, (const bf16*)(F.ws + WS_WUP) + (size_t)1792 * 256, M, DM, 256, 256, 1 << 30, 0, 1 << 30, 0, 1}; pg8::StaticOrder S2; S2.init(M, DM, G2, c2);
    pg8::EpiPP E2{(bf16*)(F.ws + WS_PP), (float*)(F.ws + WS_SPP)};
    pg8::gemm_phase<pg8::EpiPP, true>(F.lds + RING_OFF, g2, S2, E2);
}

struct Args;
template <class BarT>
__device__ __forceinline__ void mix_phases(Frame& F, const BarT& bar, int lo, int hi) {
#define IN(k) (lo <= (k) && (k) < hi)
#define BOTH(k) (IN(k) && IN((k) + 1))
    unsigned char* ws = F.ws;
    bf16* HB = (bf16*)(ws + WS_HB); bf16* LATP = (bf16*)(ws + WS_LATP); bf16* KROT = (bf16*)(ws + WS_KROT); bf16* QD = (bf16*)(ws + WS_QD); bf16* KD = (bf16*)(ws + WS_KD); bf16* VD = (bf16*)(ws + WS_VD);
    bf16* QM = (bf16*)(ws + WS_QM); bf16* KVM = (bf16*)(ws + WS_KVM); bf16* OCAT = (bf16*)(ws + WS_OCAT); bf16* PP = (bf16*)(ws + WS_PP);
    float* S1 = (float*)(ws + WS_S1); float* S2 = (float*)(ws + WS_S2); float* QSS = (float*)(ws + WS_QSS); float* KSS = (float*)(ws + WS_KSS); float* SPP = (float*)(ws + WS_SPP);
    const float2* tab = (const float2*)(ws + WS_TAB);
    const int NOPN = 1 << 30;
    if (IN(3)) {
        pg8::Gemm g{HB, (const bf16*)(ws + WS_WIN), M, 2048, DM, DM, NOPN, 0, NOPN, 0}; pg8::StaticOrder S; S.init(M, 2048, F.G, (int)blockIdx.x);
        pg8::EpiWin E{ws};
        pg8::gemm_phase<pg8::EpiWin, true>(F.lds + RING_OFF, g, S, E);
        if (BOTH(3)) PANEL_BAR();
    }
    if (IN(4)) {
        pg8::Gemm g{LATP, (const bf16*)(ws + WS_WUP), M, 1792, 256, 768, 3, 256, 7, 512}; pg8::StaticOrder S; S.init(M, 1792, F.G, (int)blockIdx.x);
        pg8::EpiUp E{ws};
        pg8::gemm_phase<pg8::EpiUp, true>(F.lds + RING_OFF, g, S, E);
        if (BOTH(4)) xcd_barrier(bar);
    }
    if (IN(5)) {
        float gq = fmaxf(fabsf(kin(I_GMLAQ)[F.lane]), F.lane < 32 ? fabsf(kin(I_GMLAQ)[64 + F.lane]) : 0.f), gk = fmaxf(fabsf(kin(I_GMLAK)[F.lane]), F.lane < 32 ? fabsf(kin(I_GMLAK)[64 + F.lane]) : 0.f);
#pragma unroll
        for (int o_ = 1; o_ < 64; o_ <<= 1) { gq = fmaxf(gq, __shfl_xor(gq, o_)); gk = fmaxf(gk, __shfl_xor(gk, o_)); }
        const bool fast = __builtin_amdgcn_readfirstlane((int)(9.7979590f * gq * gk * LOG2E * 1.02f + 1.f <= 40.f)) != 0;
        for (int i = 0; i < 2; ++i) { const int bh = F.vcu >> 4, qb = (F.vcu & 15) + 16 * i;
            if (fast) att::mla_unit4(bh >> 3, bh & 7, qb, QM, KVM, KROT, OCAT, (LAS char*)(F.lds + RING_OFF));
            else att::mla_unit(bh >> 3, bh & 7, qb, QM, KVM, KROT, OCAT, (LAS char*)(F.lds + RING_OFF)); }
    }
    if (IN(6)) {
        const float s1 = wave_sum(kin(I_LQ1)[F.lane] * kin(I_LK1)[F.lane]), s2 = wave_sum(kin(I_LQ2)[F.lane] * kin(I_LK2)[F.lane]);
        const float lam = __expf(s1) - __expf(s2) + 0.2f;
        float gq = fabsf(kin(I_GDQ)[F.lane]), gk = fabsf(kin(I_GDK)[F.lane]);
#pragma unroll
        for (int o_ = 1; o_ < 64; o_ <<= 1) { gq = fmaxf(gq, __shfl_xor(gq, o_)); gk = fmaxf(gk, __shfl_xor(gk, o_)); }
        const float B2 = 8.f * gq * gk * LOG2E * 1.02f + 1.f;
        const bool fastd = __builtin_amdgcn_readfirstlane((int)(B2 <= 40.f)) != 0;
        const int xj = F.vcu >> 5, bb = xj >> 2, pair = (xj >> 1) & 1, qb = 32 * (xj & 1) + (F.vcu & 31);
        for (int i = 0; i < 2; ++i) {
            const int h = pair == 0 ? (i == 0 ? 3 : 0) : (i == 0 ? 2 : 1);
            const float sl2 = exp2f(-2.f * (float)(h + 1)) * LOG2E;
            const float wdf = ceilf((B2 + 150.f) / sl2);
            const int Wd = __builtin_amdgcn_readfirstlane(wdf > 16384.f ? 16384 : (int)wdf);
            const int q0 = qb * 128;
            int t_lo = q0 - 63 - Wd; t_lo = t_lo < 0 ? 0 : (t_lo >> 6) + 1;
            int t_hi = (q0 + 127 + Wd + 63) / 64 - 1; t_hi = t_hi > SEQ / 64 - 1 ? SEQ / 64 - 1 : t_hi;
            if (t_hi - t_lo < 3) { if (t_lo >= 4) t_lo = t_hi - 3; else t_hi = t_lo + 3; }
            if (((t_hi - t_lo + 1) & 1) != 0) { if (t_lo > 0) --t_lo; else ++t_hi; }
            if (fastd) att::diff_unit4(bb, h, qb, t_lo, t_hi - t_lo + 1, QD, KD, VD, OCAT, lam, kin(I_GSUB), (LAS char*)(F.lds + RING_OFF));
            else att::diff_unit(bb, h, qb, t_lo, t_hi - t_lo + 1, QD, KD, VD, OCAT, lam, kin(I_GSUB), (LAS char*)(F.lds + RING_OFF));
        }
        if (F.G == 256 && pair == 0) { const int wrank = (xj >> 2) * 64 + (xj & 1) * 32 + (F.vcu & 31), rank = wrank * NWAVES + F.wave; p0_convert(F, 2, 4, rank, 128 * NWAVES); p0_convert(F, 6, 8, rank, 128 * NWAVES); __syncthreads(); pp_gemm(F, 128, wrank); }
        if (BOTH(6)) xcd_barrier(bar);
    }
    if (IN(7)) {
        pg8::Gemm g{OCAT, (const bf16*)(ws + WS_WOUT), M, DM, DM, DM, NOPN, 0, NOPN, 0}; pg8::StaticOrder S; S.init(M, DM, F.G, (int)blockIdx.x);
        pg8::EpiResid<true> E{HB, HB, S2, 1.0f, 0};
        pg8::gemm_phase<pg8::EpiResid<true>, false>(F.lds + RING_OFF, g, S, E);
        if (BOTH(7)) PANEL_BAR();
    }
#undef IN
#undef BOTH
}
}
namespace mk {
template <class BarT>
__device__ __forceinline__ void tail_phases(Frame& F, const BarT& bar, int lo, int hi) {
#define IN(k) (lo <= (k) && (k) < hi)
#define BOTH(k) (IN(k) && IN((k) + 1))
    unsigned char* ws = F.ws;
    bf16* HB = (bf16*)(ws + WS_HB); bf16* ACT = (bf16*)(ws + WS_ACT); bf16* PP = (bf16*)(ws + WS_PP);
    float* S2 = (float*)(ws + WS_S2); float* S3 = (float*)(ws + WS_S3); float* SPP = (float*)(ws + WS_SPP);
    const int NOPN = 1 << 30;
    if (IN(8)) {
        pg8::Gemm g{HB, (const bf16*)(ws + WS_WGU2), M, 2 * DFF, DM, DM, NOPN, 0, NOPN, 0}; pg8::StaticOrder S; S.init(M, 2 * DFF, F.G, (int)blockIdx.x);
        pg8::EpiSwiglu E{ACT, S2};
        pg8::gemm_phase<pg8::EpiSwiglu, true>(F.lds + RING_OFF, g, S, E);
        if (BOTH(8)) PANEL_BAR();
    }
    if (IN(9)) {
        pg8::Gemm g{ACT, (const bf16*)(ws + WS_WD2), M, DM, DFF, DFF, NOPN, 0, NOPN, 0}; pg8::StaticOrder S; S.init(M, DM, F.G, (int)blockIdx.x);
        pg8::EpiResid<true> E{HB, HB, S3, 0.5f, 0};
        pg8::gemm_phase<pg8::EpiResid<true>, false>(F.lds + RING_OFF, g, S, E);
        if (BOTH(9)) PANEL_BAR();
    }
    if (IN(10)) {
        pg8::Gemm g{HB, (const bf16*)(ws + WS_WPG), M, DM, DM, DM, NOPN, 0, NOPN, 0}; pg8::StaticOrder S; S.init(M, DM, F.G, (int)blockIdx.x);
        pg8::EpiPle E{HB, F.out, S3, SPP, PP, kin(I_BPG), kin(I_GPLEOUT)};
        pg8::gemm_phase<pg8::EpiPle, false>(F.lds + RING_OFF, g, S, E);
    }
#undef IN
#undef BOTH
}
}
namespace mk {
constexpr int NPHASE = 11;
struct Args { const float* in[31]; float* out; unsigned char* ws; int ph_lo, ph_hi, li, pad; };

__global__ void __launch_bounds__(NWAVES * 64, 2) mega_fwd(Args args) {
    extern __shared__ __attribute__((aligned(16))) unsigned char lds[];
    Frame F;
    F.lds = (LAS unsigned char*)lds;
    F.MISC = (volatile LAS unsigned*)(F.lds + MISC_OFF);
    F.tid = threadIdx.x; F.lane = F.tid & 63; F.wave = __builtin_amdgcn_readfirstlane(F.tid >> 6);
    F.G = gridDim.x; { const int bx = blockIdx.x; F.vcu = (F.G % 8 == 0) ? (bx % 8) * (F.G / 8) + bx / 8 : bx; }
    unsigned char* ws = args.ws; F.ws = ws; F.out = args.out;
    F.ctl = (gu32*)(ws + WS_CTL);
    for (int u = F.tid; u < (LDS_BYTES - LDSCTL_OFF) / 4; u += NWAVES * 64) ((LAS unsigned*)(F.lds + LDSCTL_OFF))[u] = 0u;
    __syncthreads();
    XcdBarrier bar = xcd_barrier_post((unsigned*)(F.ctl + CW_BAR) + args.li * XCD_BAR_STRIDE, F.MISC + 8);
#define GRID_BAR() xcd_barrier(bar)
    (void)grp_barrier_post(bar.bar, bar.bar, bar.x, F.MISC + 12);
    const int lo = args.ph_lo, hi = args.ph_hi;
#define IN(k) (lo <= (k) && (k) < hi)
#define BOTH(k) (IN(k) && IN((k) + 1))
    bf16* HB = (bf16*)(ws + WS_HB); bf16* ACT = (bf16*)(ws + WS_ACT);
    float* S0 = (float*)(ws + WS_S0); float* S1 = (float*)(ws + WS_S1); float* S2 = (float*)(ws + WS_S2); float* S3 = (float*)(ws + WS_S3);
    const int NOPN = 1 << 30;

    if (IN(0)) { p0_prologue(F); if (BOTH(0)) GRID_BAR(); }
    if (IN(1)) {
        pg8::Gemm g{HB, (const bf16*)(ws + WS_WGU1), M, 2 * DFF, DM, DM, NOPN, 0, NOPN, 0}; pg8::StaticOrder S; S.init(M, 2 * DFF, F.G, (int)blockIdx.x);
        pg8::EpiSwiglu E{ACT, S0};
        pg8::gemm_phase<pg8::EpiSwiglu, true>(F.lds + RING_OFF, g, S, E);
        if (F.G != 256) pp_gemm(F, F.G, (int)blockIdx.x);
        else if (blockIdx.x >= 128) { const int rank = ((int)blockIdx.x - 128) * NWAVES + F.wave; p0_convert(F, 4, 6, rank, 128 * NWAVES); }
        if (BOTH(1)) PANEL_BAR();
    }
    if (IN(2)) {
        pg8::Gemm g{ACT, (const bf16*)(ws + WS_WD1), M, DM, DFF, DFF, NOPN, 0, NOPN, 0}; pg8::StaticOrder S; S.init(M, DM, F.G, (int)blockIdx.x);
        pg8::EpiResid<true> E{HB, HB, S1, 0.5f, 0};
        pg8::gemm_phase<pg8::EpiResid<true>, false>(F.lds + RING_OFF, g, S, E);
        if (BOTH(2)) GRID_BAR();
    }
#ifdef MK_HAVE_MIX
    mix_phases(F, bar, lo, hi);
#endif
#ifdef MK_HAVE_TAIL
    tail_phases(F, bar, lo, hi);
#endif
#undef IN
#undef BOTH
}

static int mk_grid = 0;
static bool launch(void* const* d_in, float* out, unsigned char* ws, hipStream_t stream, int lo, int hi, int li) {
    if (mk_grid == 0) {
        int dev = 0, cus = 0, per_cu = 0;
        if (hipGetDevice(&dev) != hipSuccess || hipDeviceGetAttribute(&cus, hipDeviceAttributeMultiprocessorCount, dev) != hipSuccess) { fprintf(stderr, "kernel_launch: device query failed\n"); mk_grid = -1; return false; }
        if (hipFuncSetAttribute((const void*)mega_fwd, hipFuncAttributeMaxDynamicSharedMemorySize, LDS_BYTES) != hipSuccess) { fprintf(stderr, "kernel_launch: hipFuncSetAttribute failed\n"); mk_grid = -1; return false; }
        if (hipOccupancyMaxActiveBlocksPerMultiprocessor(&per_cu, (const void*)mega_fwd, NWAVES * 64, LDS_BYTES) != hipSuccess || per_cu < 1) { fprintf(stderr, "kernel_launch: occupancy query reports %d blocks per CU\n", per_cu); (void)hipGetLastError(); mk_grid = -1; return false; }
        if (cus != 256) { fprintf(stderr, "kernel_launch: built for 256 CUs, found %d\n", cus); mk_grid = -1; return false; }
        mk_grid = cus;
    }
    if (mk_grid < 0) return false;
    Args a; memset(&a, 0, sizeof(a));
    for (int i = 0; i < 31; ++i) a.in[i] = (const float*)d_in[i];
    a.out = out; a.ws = ws; a.ph_lo = lo; a.ph_hi = hi; a.li = li;
    hipLaunchKernelGGL(mega_fwd, dim3(mk_grid), dim3(NWAVES * 64), LDS_BYTES, stream, a);
    const hipError_t le = hipPeekAtLastError();
    if (le != hipSuccess) { fprintf(stderr, "kernel_launch: launch failed: %s\n", hipGetErrorName(le)); return false; }
    return true;
}
}
extern "C" void kernel_launch(void* const* d_in, const int* in_sizes, int n_in, void* d_out, int out_size, void* d_ws, size_t ws_size, hipStream_t stream) {
    if (n_in != 31 || out_size != mk::M * mk::DM || ws_size < (size_t)256 * mk::MiB) { fprintf(stderr, "kernel_launch: unexpected shapes n_in %d out %d ws %zu\n", n_in, out_size, ws_size); return; }
    if (hipMemsetAsync((char*)d_ws + mk::WS_CTL, 0, mk::CTL_ZERO_BYTES, stream) != hipSuccess) return;
    (void)mk::launch(d_in, (float*)d_out, (unsigned char*)d_ws, stream, 0, mk::NPHASE, 0);
}
```

```cpp
#define MK_HAVE_MIX
#define MK_HAVE_TAIL
#include <hip/hip_runtime.h>
#include <hip/hip_bf16.h>
#include <cstdio>
#include <cstdint>
#include <cstring>

namespace mk {
constexpr int BATCH = 2, SEQ = 8192, DM = 1024, M = BATCH * SEQ, DFF = 2816, PLE = 256, NIN = 1952;
constexpr float EPS = 1e-6f;
constexpr float LOG2E = 1.4426950408889634f;
constexpr float QSC_MLA = 0.10206207261596577f * LOG2E;
constexpr float QSC_DIFF = 0.125f * LOG2E;
constexpr int NWAVES = 8;

constexpr size_t MiB = 1u << 20;
constexpr size_t WS_CTL = 0, CTL_ZERO_BYTES = 128 * 1024;
constexpr size_t WS_TAB = 1 * MiB;
constexpr size_t WS_S0 = 2 * MiB;
constexpr size_t WS_S1 = WS_S0 + 256 * 1024, WS_S2 = WS_S1 + 256 * 1024, WS_S3 = WS_S2 + 256 * 1024;
constexpr size_t WS_QSS = WS_S3 + 256 * 1024, WS_KSS = WS_QSS + 256 * 1024;
constexpr size_t WS_SPP = WS_KSS + 256 * 1024;
constexpr size_t WS_WGU1 = 5 * MiB;
constexpr size_t WS_WD1 = 16 * MiB;
constexpr size_t WS_WGU2 = 22 * MiB;
constexpr size_t WS_WD2 = 33 * MiB;
constexpr size_t WS_WIN = 39 * MiB;
constexpr size_t WS_WUP = 43 * MiB;
constexpr size_t WS_WOUT = 45 * MiB;
constexpr size_t WS_WPG = 47 * MiB;
constexpr size_t WS_RA = 49 * MiB;
constexpr size_t WS_ACT = WS_RA;
constexpr size_t WS_KROT = WS_RA;
constexpr size_t WS_QD = WS_RA + 1 * MiB, WS_KD = WS_QD + 16 * MiB, WS_VD = WS_KD + 16 * MiB;
constexpr size_t WS_QM = WS_VD + 16 * MiB;
constexpr size_t WS_KVM = WS_QM + 24 * MiB;
constexpr size_t WS_LATP = WS_KVM + 32 * MiB;
constexpr size_t WS_OCAT = WS_LATP;
constexpr size_t WS_HB = WS_OCAT + 32 * MiB;
constexpr size_t WS_PP = WS_HB + 32 * MiB;
constexpr size_t WS_END = WS_PP + 32 * MiB;
constexpr size_t WS_PB0 = WS_END;
__host__ __device__ __forceinline__ size_t pb_panel_off(int pm) {
    if (pm < 48) return WS_PB0 + (size_t)pm * 131072;
    const int h = (pm - 48) >> 2; const size_t hb = h == 0 ? WS_SPP + 1 * MiB : (h == 1 ? WS_WD1 + 5632 * 1024 : (h == 2 ? WS_WD2 + 5632 * 1024 : WS_WUP + 1408 * 1024));
    return hb + (size_t)((pm - 48) & 3) * 131072;
}
static_assert(WS_PB0 + 48 * 131072 <= 256 * MiB && WS_SPP + 1 * MiB + 4 * 131072 <= WS_WGU1 && WS_WD1 + 5632 * 1024 + 4 * 131072 <= WS_WGU2 && WS_WD2 + 5632 * 1024 + 4 * 131072 <= WS_WIN && WS_WUP + 1408 * 1024 + 4 * 131072 <= WS_WOUT, "p-bf16 panels");
static_assert(WS_LATP >= WS_RA + 88 * MiB, "LATP must be clear of ACT");
static_assert(WS_END <= 256 * MiB, "d_ws map");
constexpr int CW_TMO = 0, CW_CODE = 1;
constexpr int CW_BAR = 4096;

constexpr int RING_OFF = 0, RING_BYTES = 131072;
constexpr int LDSCTL_OFF = RING_BYTES, MISC_OFF = LDSCTL_OFF + 320;
constexpr int LDS_BYTES = 147456;
constexpr int ROWSC_OFF = RING_BYTES + 4096;

#define GAS __attribute__((address_space(1)))
#define LAS __attribute__((address_space(3)))
typedef unsigned short bf16;
typedef unsigned v4u __attribute__((ext_vector_type(4)));
typedef unsigned v2u __attribute__((ext_vector_type(2)));
typedef float f32x4 __attribute__((ext_vector_type(4)));
typedef float f32x2 __attribute__((ext_vector_type(2)));
typedef short bf16x8 __attribute__((ext_vector_type(8)));
typedef GAS unsigned gu32;
#define RLX_AGENT __ATOMIC_RELAXED, __HIP_MEMORY_SCOPE_AGENT
#define LDS_WAIT() asm volatile("s_waitcnt lgkmcnt(0)" ::: "memory")
#define VM_WAIT() asm volatile("s_waitcnt vmcnt(0)" ::: "memory")
__device__ __forceinline__ unsigned cvt_pk_bf16(float lo, float hi) { unsigned r; asm volatile("v_cvt_pk_bf16_f32 %0, %1, %2" : "=v"(r) : "v"(lo), "v"(hi)); return r; }
__device__ __forceinline__ void st16_wt(void* p, v4u v) { asm volatile("global_store_dwordx4 %0, %1, off sc1\n\ts_nop 1" :: "v"(p), "v"(v) : "memory"); }
__device__ __forceinline__ void st8_wt(void* p, v2u v) { asm volatile("global_store_dwordx2 %0, %1, off sc1\n\ts_nop 1" :: "v"(p), "v"(v) : "memory"); }
__device__ __forceinline__ float bf_lo(unsigned w) { return __uint_as_float(w << 16); }
__device__ __forceinline__ float bf_hi(unsigned w) { return __uint_as_float(w & 0xffff0000u); }
__device__ __forceinline__ float wave_sum(float v) {
#pragma unroll
    for (int o = 1; o < 64; o <<= 1) v += __shfl_xor(v, o);
    return v;
}
__device__ __forceinline__ float fast_sigmoid(float x) { return __builtin_amdgcn_rcpf(1.f + __builtin_amdgcn_exp2f(-x * LOG2E)); }

#define XB_TMO      128
#define XB_XCNT(j)  (256  + 64 * (j))
#define XB_XSUB(j)  (1280 + 64 * (j))
#define XB_XGEN(j)  (2304 + 64 * (j))
#define XB_TOP      3328
#define XB_TOPGEN   3392
#define XCD_BAR_WORDS 3456
#define XB_SPIN_CAP (1u << 18)
__device__ __forceinline__ unsigned xb_ld(unsigned* p)              { return __hip_atomic_load(p, __ATOMIC_RELAXED, __HIP_MEMORY_SCOPE_AGENT); }
__device__ __forceinline__ unsigned xb_add(unsigned* p, unsigned v) { return __hip_atomic_fetch_add(p, v, __ATOMIC_RELAXED, __HIP_MEMORY_SCOPE_AGENT); }
__device__ __forceinline__ unsigned xb_xcc_id() { return (unsigned)__builtin_amdgcn_s_getreg((3 << 11) | 20) & 0xFu; }
#define XB_SPIN(cond, bar) do { unsigned _sp = 0; while (cond) { __builtin_amdgcn_s_sleep(1); \
    if ((++_sp & 255u) == 0u) { if (xb_ld(&(bar)[XB_TMO])) break; if (_sp > XB_SPIN_CAP) { atomicAdd(&(bar)[XB_TMO], 1u); break; } } } } while (0)
struct XcdBarrier { unsigned* bar; unsigned x; volatile LAS unsigned* st; };
__device__ __forceinline__ XcdBarrier xcd_barrier_post(unsigned* bar, volatile LAS unsigned* st) {
    XcdBarrier b; b.bar = bar; b.x = xb_xcc_id(); b.st = st;
    if (threadIdx.x == 0) (void)xb_add(&bar[XB_XCNT(b.x)], 1u);
    return b;
}
__device__ __forceinline__ void xcd_barrier_complete(unsigned* bar, unsigned x, unsigned& nloc, unsigned& nx) {
    const unsigned G = gridDim.x * gridDim.y * gridDim.z;
    unsigned sum, cnt, mine, sp = 0u;
    for (;;) {
        sum = 0u; cnt = 0u; mine = 0u;
#pragma unroll
        for (unsigned j = 0; j < 16; ++j) { const unsigned c = xb_ld(&bar[XB_XCNT(j)]); sum += c; cnt += (c > 0u) ? 1u : 0u; mine = (j == x) ? c : mine; }
        if (sum == G) break;
        __builtin_amdgcn_s_sleep(1);
        if ((++sp & 255u) == 0u) { if (xb_ld(&bar[XB_TMO])) break; if (sp > XB_SPIN_CAP) { atomicAdd(&bar[XB_TMO], 1u); break; } }
    }
    nloc = mine > 0u ? mine : 1u; nx = cnt > 0u ? cnt : 1u;
}
__device__ __forceinline__ void xcd_barrier(const XcdBarrier& b) {
    asm volatile("s_waitcnt vmcnt(0)" ::: "memory");
    __syncthreads();
    if (threadIdx.x == 0) {
        unsigned* bar = b.bar;
        __builtin_amdgcn_s_waitcnt(0);
        unsigned nloc = b.st[0], nx = b.st[1];
        if (nloc == 0u) { xcd_barrier_complete(bar, b.x, nloc, nx); b.st[0] = nloc; b.st[1] = nx; }
        const unsigned old = xb_add(&bar[XB_XSUB(b.x)], 1u);
        const unsigned gen = old / nloc;
        if (old + 1u == (gen + 1u) * nloc) {
            __builtin_amdgcn_fence(__ATOMIC_RELEASE, "agent");
            asm volatile("s_waitcnt vmcnt(0)" ::: "memory");
            const unsigned og = xb_add(&bar[XB_TOP], 1u);
            const unsigned tg = og / nx;
            if (og + 1u == (tg + 1u) * nx) xb_add(&bar[XB_TOPGEN], 1u);
            else XB_SPIN(xb_ld(&bar[XB_TOPGEN]) == tg, bar);
            __builtin_amdgcn_fence(__ATOMIC_ACQUIRE, "agent");
            xb_add(&bar[XB_XGEN(b.x)], 1u);
            asm volatile("s_waitcnt vmcnt(0)" ::: "memory");
        } else {
            XB_SPIN(xb_ld(&bar[XB_XGEN(b.x)]) == gen, bar);
            __builtin_amdgcn_fence(__ATOMIC_ACQUIRE, "agent");
            asm volatile("s_waitcnt vmcnt(0)" ::: "memory");
        }
    }
    __syncthreads();
}

#define GB_X(g)   (4096 + 16 * (g))
#define GB_CNT(g) (4352 + 64 * (g))
#define GB_GEN(g) (4864 + 64 * (g))
#define XCD_BAR_STRIDE 8192
struct GrpBarrier { unsigned* ctl; unsigned* tmo; unsigned g, x; volatile LAS unsigned* st; };
__device__ __forceinline__ GrpBarrier grp_barrier_post(unsigned* ctl, unsigned* tmo, unsigned x, volatile LAS unsigned* st) {
    GrpBarrier b; b.ctl = ctl; b.tmo = tmo; b.g = blockIdx.x & 7u; b.x = x; b.st = st;
    if (threadIdx.x == 0) (void)xb_add(&ctl[GB_X(b.g) + x], 1u);
    return b;
}
__device__ __forceinline__ void grp_barrier(const GrpBarrier& b) {
    asm volatile("s_waitcnt vmcnt(0)" ::: "memory");
    __syncthreads();
    if (threadIdx.x == 0) {
        unsigned* ctl = b.ctl;
        __builtin_amdgcn_s_waitcnt(0);
        unsigned mode = b.st[0];
        if (mode == 0u) {
            unsigned sp = 0u, sum, mine;
            for (;;) {
                sum = 0u; mine = 0u;
#pragma unroll
                for (unsigned j = 0; j < 16; ++j) { const unsigned c_ = xb_ld(&ctl[GB_X(b.g) + j]); sum += c_; mine = (j == b.x) ? c_ : mine; }
                if (sum == 32u) break;
                __builtin_amdgcn_s_sleep(1);
                if ((++sp & 255u) == 0u) { if (xb_ld(&b.tmo[XB_TMO])) break; if (sp > XB_SPIN_CAP) { atomicAdd(&b.tmo[XB_TMO], 1u); break; } }
            }
            mode = (sum == 32u && mine == 32u) ? 1u : 2u; b.st[0] = mode;
        }
        if (mode != 1u) __builtin_amdgcn_fence(__ATOMIC_RELEASE, "agent");
        asm volatile("s_waitcnt vmcnt(0)" ::: "memory");
        const unsigned old = xb_add(&ctl[GB_CNT(b.g)], 1u), gen = old / 32u;
        if (old + 1u == (gen + 1u) * 32u) xb_add(&ctl[GB_GEN(b.g)], 1u);
        else XB_SPIN(xb_ld(&ctl[GB_GEN(b.g)]) == gen, b.tmo);
        __builtin_amdgcn_fence(__ATOMIC_ACQUIRE, "agent");
        asm volatile("s_waitcnt vmcnt(0)" ::: "memory");
    }
    __syncthreads();
}

namespace pg8 {
constexpr int BM = 256, BK = 64, HALF = 128, HTB = HALF * BK * 2, STAGE_BYTES = 8 * HTB, NXCD = 8, WGM = 8;
__host__ __device__ __forceinline__ int lds_byte(int r, int c) { const int st = (r >> 4) * 2 + (c >> 5), rr = r & 15, cc = c & 31, ob = rr * 64 + cc * 2; return st * 1024 + (ob ^ (((ob >> 9) & 1) << 5)); }
__host__ __device__ __forceinline__ void stage_rc(int b, int& R, int& C) { const int st = b / 1024, sb = b % 1024, swz = sb ^ (((sb >> 9) & 1) << 5); R = (st >> 1) * 16 + swz / 64; C = (st & 1) * 32 + (swz % 64) / 2; }
__host__ __device__ __forceinline__ int perm32(int rho) { const int n = rho >> 4, i = rho & 15; return 8 * (i >> 2) + 4 * n + (i & 3); }
struct Unit { int pm, pn; };
struct Gemm { const bf16* A; const bf16* Bt; int M, N, K, lda; int pnA, acolA, pnB, acolB; int pmap;
    __device__ __forceinline__ int acol(int pn) const { return pn < pnA ? 0 : (pn < pnB ? acolA : acolB); }
    __device__ __forceinline__ const char* apanel(int pm, size_t tstepA) const { return pmap ? (const char*)A + pb_panel_off(pm) : (const char*)A + (size_t)pm * tstepA; } };
struct StaticOrder {
    int nM, nN, nwg, G, c;
    __host__ __device__ void init(int M, int N, int G_, int c_) { nM = M / BM; nN = N / BM; nwg = nM * nN; G = G_; c = c_; }
    __host__ __device__ bool next(int i, Unit& u) const {
        const long L = (long)i * G + c; if (L >= nwg) return false;
        int wgid = (int)L; { const int q = nwg / NXCD, r = nwg % NXCD, xcd = wgid % NXCD, off = wgid / NXCD; wgid = (xcd < r ? xcd * (q + 1) : r * (q + 1) + (xcd - r) * q) + off; }
        const int nig = WGM * nN, gid = wgid / nig, fm = gid * WGM, gsz = (nM - fm) < WGM ? (nM - fm) : WGM;
        u.pm = fm + ((wgid % nig) % gsz); u.pn = (wgid % nig) / gsz; return true;
    }
};
typedef f32x4 Acc[2][2][4][2];

template <class Epi, bool ALIGN_EPI>
__device__ __forceinline__ void gemm_phase(LAS unsigned char* lds, const Gemm g, const StaticOrder& S, const Epi& E) {
    const int tid = threadIdx.x, wid = __builtin_amdgcn_readfirstlane(tid >> 6), lane = tid & 63, wr = wid >> 2, wc = wid & 3, fr = lane & 15, fq = lane >> 4;
    const int K = g.K, nt = K / BK, lda = g.lda;
    unsigned voffA[2], voffB[2];
#pragma unroll
    for (int i = 0; i < 2; ++i) { int R, C; stage_rc(tid * 16 + i * 8192, R, C); const int Rb = Epi::PERM ? ((R & ~31) + perm32(R & 31)) : R;
        voffA[i] = (unsigned)(R * lda + C) * 2u; voffB[i] = (unsigned)(Rb * K + C) * 2u; }
    const size_t kstep = (size_t)(BK * 2);
    const size_t hstepA = (size_t)HALF * lda * 2, hstepB = (size_t)HALF * K * 2;
    const size_t tstepA = 2 * hstepA, tstepB = 2 * hstepB;
    const unsigned ldsw = (unsigned)wid * 1024u;
    const int aoff = lds_byte(wr * 64 + fr, fq * 8), boff = lds_byte(wc * 32 + fr, fq * 8);
#define PG8_SA(b, h) (((b) * 2 + (h)) * HTB)
#define PG8_SB(b, h) ((4 + (b) * 2 + (h)) * HTB)
#define PG8_STAGE(bufoff, gbase, voff) do { _Pragma("unroll") for (int _i = 0; _i < 2; ++_i) \
        __builtin_amdgcn_global_load_lds((const unsigned*)((const char*)(gbase) + (voff)[_i]), (LAS unsigned*)(lds + (bufoff) + ldsw + _i * 8192), 16, 0, 0); } while (0)
#define PG8_LDA(dst, b, h) do { _Pragma("unroll") for (int m = 0; m < 4; ++m) _Pragma("unroll") for (int k = 0; k < 2; ++k) dst[m][k] = *(const LAS bf16x8*)(lds + PG8_SA(b, h) + aoff + m * 2048 + k * 1024); } while (0)
#define PG8_LDB(dst, b, h) do { _Pragma("unroll") for (int n = 0; n < 2; ++n) _Pragma("unroll") for (int k = 0; k < 2; ++k) dst[n][k] = *(const LAS bf16x8*)(lds + PG8_SB(b, h) + boff + n * 2048 + k * 1024); } while (0)
#define PG8_MMA(ai, bj, At, Bt) do { __builtin_amdgcn_s_setprio(1); _Pragma("unroll") for (int m = 0; m < 4; ++m) _Pragma("unroll") for (int n = 0; n < 2; ++n) _Pragma("unroll") for (int k = 0; k < 2; ++k) \
        acc[ai][bj][m][n] = __builtin_amdgcn_mfma_f32_16x16x32_bf16(Bt[n][k], At[m][k], acc[ai][bj][m][n], 0, 0, 0); __builtin_amdgcn_s_setprio(0); } while (0)
#define PG8_WAIT_V(n) asm volatile("s_waitcnt vmcnt(" #n ")" ::: "memory")
#define PG8_WAIT_L(n) asm volatile("s_waitcnt lgkmcnt(" #n ")" ::: "memory")
#define PG8_BAR __builtin_amdgcn_s_barrier()
#define PG8_SCHED __builtin_amdgcn_sched_barrier(0)
    Unit cur, nxt; int ui = 0;
    if (!S.next(0, cur)) return;
    f32x4 acc[2][2][4][2];
#pragma unroll
    for (int a = 0; a < 2; ++a)
#pragma unroll
        for (int b = 0; b < 2; ++b)
#pragma unroll
            for (int m = 0; m < 4; ++m)
#pragma unroll
                for (int n = 0; n < 2; ++n) acc[a][b][m][n] = (f32x4){0.f, 0.f, 0.f, 0.f};
    bf16x8 At[4][2], B0[2][2], B1[2][2];
    const char* cA = g.apanel(cur.pm, tstepA) + (size_t)g.acol(cur.pn) * 2; const char* cB = (const char*)g.Bt + (size_t)cur.pn * tstepB;
    PG8_STAGE(PG8_SB(0, 0), cB, voffB); PG8_STAGE(PG8_SB(0, 1), cB + hstepB, voffB); PG8_STAGE(PG8_SA(0, 0), cA, voffA); PG8_STAGE(PG8_SA(0, 1), cA + hstepA, voffA);
    if (wr == 1) PG8_BAR;
    PG8_WAIT_V(2); PG8_BAR;
    PG8_STAGE(PG8_SB(1, 0), cB + kstep, voffB); PG8_STAGE(PG8_SA(1, 0), cA + kstep, voffA); PG8_STAGE(PG8_SB(1, 1), cB + hstepB + kstep, voffB);
    PG8_WAIT_V(6); PG8_BAR;
    for (;;) {
        const bool has_next = S.next(ui + 1, nxt);
        const char* nA = has_next ? g.apanel(nxt.pm, tstepA) + (size_t)g.acol(nxt.pn) * 2 : cA; const char* nB = has_next ? (const char*)g.Bt + (size_t)nxt.pn * tstepB : cB;
        for (int t = 0; t < nt; t += 2) {
            const bool last = (t == nt - 2);
            const char* a1 = cA + (size_t)(t + 1) * kstep;
            const char* a2 = last ? nA : cA + (size_t)(t + 2) * kstep; const char* b2 = last ? nB : cB + (size_t)(t + 2) * kstep;
            const char* a3 = a2 + kstep; const char* b3 = b2 + kstep;
            f32x4 praw;
            if constexpr (Epi::PRE) { if (last) { const float* pp_ = E.pre_addr(cur, wid, lane); asm volatile("global_load_dwordx4 %0, %1, off" : "=v"(praw) : "v"(pp_) : "memory"); } }
            PG8_LDB(B0, 0, 0); PG8_LDB(B1, 0, 1); PG8_SCHED; PG8_LDA(At, 0, 0); PG8_STAGE(PG8_SA(1, 1), a1 + hstepA, voffA);
            PG8_WAIT_V(8); PG8_WAIT_L(0); PG8_BAR; PG8_MMA(0, 0, At, B0); PG8_MMA(0, 1, At, B1); PG8_BAR; PG8_SCHED;
            PG8_LDA(At, 0, 1); PG8_STAGE(PG8_SB(0, 0), b2, voffB); PG8_STAGE(PG8_SB(0, 1), b2 + hstepB, voffB); PG8_STAGE(PG8_SA(0, 0), a2, voffA);
            PG8_WAIT_V(8); PG8_WAIT_L(0); PG8_BAR; PG8_MMA(1, 0, At, B0); PG8_MMA(1, 1, At, B1); PG8_BAR; PG8_SCHED;
            PG8_LDB(B0, 1, 0); PG8_LDB(B1, 1, 1); PG8_SCHED; PG8_LDA(At, 1, 0); PG8_STAGE(PG8_SA(0, 1), a2 + hstepA, voffA);
            PG8_WAIT_V(8); PG8_WAIT_L(0); PG8_BAR; PG8_MMA(0, 0, At, B0); PG8_MMA(0, 1, At, B1); PG8_BAR; PG8_SCHED;
            PG8_LDA(At, 1, 1); PG8_STAGE(PG8_SB(1, 0), b3, voffB); PG8_STAGE(PG8_SB(1, 1), b3 + hstepB, voffB); PG8_STAGE(PG8_SA(1, 0), a3, voffA);
            PG8_WAIT_V(8);
            if constexpr (Epi::PRE) { if (last) { asm volatile("" : "+v"(praw)); E.pre_store(praw, (LAS float*)(lds + ROWSC_OFF), wid, lane); } }
            PG8_WAIT_L(0); PG8_BAR; PG8_MMA(1, 0, At, B0); PG8_MMA(1, 1, At, B1); PG8_BAR; PG8_SCHED;
        }
        if constexpr (ALIGN_EPI) { if (wr == 0) PG8_BAR; }
        if constexpr (Epi::PRE) { static_assert(ALIGN_EPI, "PRE needs the aligned epilogue"); E(acc, cur, wr, wc, fr, fq, (const LAS float*)(lds + ROWSC_OFF)); }
        else if constexpr (!Epi::AFTER_DRAIN) { E(acc, cur, wr, wc, fr, fq); }
        if (!has_next) break;
#pragma unroll
        for (int a = 0; a < 2; ++a)
#pragma unroll
            for (int b = 0; b < 2; ++b)
#pragma unroll
                for (int m = 0; m < 4; ++m)
#pragma unroll
                    for (int n = 0; n < 2; ++n) acc[a][b][m][n] = (f32x4){0.f, 0.f, 0.f, 0.f};
        cur = nxt; cA = nA; cB = nB; ++ui;
        if constexpr (ALIGN_EPI) { if (wr == 1) PG8_BAR; }
    }
    PG8_WAIT_V(0);
    if constexpr (!ALIGN_EPI) { if (wr == 0) PG8_BAR; }
    PG8_BAR;
    if constexpr (Epi::AFTER_DRAIN) { E.fused(acc, cur, wr, wc, fr, fq, lds, wid, lane); }
#undef PG8_SA
#undef PG8_SB
#undef PG8_STAGE
#undef PG8_LDA
#undef PG8_LDB
#undef PG8_MMA
#undef PG8_WAIT_V
#undef PG8_WAIT_L
#undef PG8_BAR
#undef PG8_SCHED
}
}
}
namespace mk {
namespace pg8 {
__device__ __forceinline__ float rstd4(const float* ssq, int row, float inv_n) { const f32x4 s = *(const f32x4*)(ssq + (size_t)row * 4); return __builtin_amdgcn_rsqf(((s.x + s.y) + (s.z + s.w)) * inv_n + EPS); }

struct EpiSwiglu {
    static constexpr bool PERM = true, AFTER_DRAIN = false, PRE = true;
    bf16* O; const float* ssq;
    __device__ __forceinline__ const float* pre_addr(const Unit& u, int wid, int lane) const { return ssq + (size_t)(u.pm * BM + wid * 32 + (lane & 31)) * 4; }
    __device__ __forceinline__ void pre_store(const f32x4 s, LAS float* rowsc, int wid, int lane) const { if (lane < 32) rowsc[wid * 32 + lane] = ((s.x + s.y) + (s.z + s.w)) * (1.f / DM) + EPS; }
    __device__ __forceinline__ void operator()(const Acc& acc, const Unit& u, int wr, int wc, int fr, int fq, const LAS float* rowsc) const {
        asm volatile("" : "+v"(fr), "+v"(fq));
        const int row0 = u.pm * BM + wr * 64 + fr, col0 = u.pn * HALF + wc * 32 + 8 * fq;
        const LAS float* rsc = rowsc + wr * 64 + fr;
        float ms[2][4];
#pragma unroll
        for (int ai = 0; ai < 2; ++ai)
#pragma unroll
            for (int m = 0; m < 4; ++m) ms[ai][m] = rsc[ai * HALF + m * 16];
#pragma unroll
        for (int ai = 0; ai < 2; ++ai)
#pragma unroll
            for (int m = 0; m < 4; ++m) { const int row = row0 + ai * HALF + m * 16; const float msq = ms[ai][m], nr = __builtin_amdgcn_rsqf(msq) * -LOG2E;
                const f32x2 ms2 = {msq, msq}, nr2 = {nr, nr};
                unsigned w[4];
#pragma unroll
                for (int n = 0; n < 2; ++n)
#pragma unroll
                    for (int h = 0; h < 2; ++h) { const f32x4 ga = acc[ai][0][m][n], ua = acc[ai][1][m][n];
                        const f32x2 gt = h ? (f32x2){ga.z, ga.w} : (f32x2){ga.x, ga.y}, up = h ? (f32x2){ua.z, ua.w} : (f32x2){ua.x, ua.y};
                        const f32x2 t = gt * nr2;
                        const f32x2 ex = {__builtin_amdgcn_exp2f(t.x), __builtin_amdgcn_exp2f(t.y)};
                        const f32x2 d = __builtin_elementwise_fma(ex, ms2, ms2);
                        const f32x2 rc = {__builtin_amdgcn_rcpf(d.x), __builtin_amdgcn_rcpf(d.y)};
                        const f32x2 o = (gt * up) * rc;
                        w[n * 2 + h] = cvt_pk_bf16(o.x, o.y); }
                v4u wv; wv.x = w[0]; wv.y = w[1]; wv.z = w[2]; wv.w = w[3];
                *(v4u*)(O + (size_t)row * DFF + col0) = wv; }
    }
};

template <bool BASE_BF16> struct EpiResid {
    static constexpr bool PERM = false, AFTER_DRAIN = true, PRE = false;
    const void* base; bf16* hb; float* ssq_out; float sc; int pad;
    __device__ __forceinline__ void fused(const Acc& acc, const Unit& u, int wr, int wc, int fr, int fq, LAS unsigned char* lds, int wid, int lane) const {
        LAS float* P = (LAS float*)lds;
        const int col0 = u.pn * BM + wc * 32 + 4 * fq;
#pragma unroll
        for (int ai = 0; ai < 2; ++ai)
#pragma unroll
            for (int m = 0; m < 4; ++m) { const int rl = ai * HALF + wr * 64 + m * 16 + fr; const size_t off = (size_t)(u.pm * BM + rl) * DM + col0; float s = 0.f;
#pragma unroll
                for (int bj = 0; bj < 2; ++bj)
#pragma unroll
                    for (int n = 0; n < 2; ++n) { const size_t o2 = off + bj * HALF + n * 16; f32x4 b;
                        if (BASE_BF16) { const v2u pw = *(const v2u*)((const bf16*)base + o2); b = (f32x4){bf_lo(pw.x), bf_hi(pw.x), bf_lo(pw.y), bf_hi(pw.y)}; } else b = *(const f32x4*)((const float*)base + o2);
                        const f32x4 o = b + acc[ai][bj][m][n] * sc;
                        v2u w; w.x = cvt_pk_bf16(o[0], o[1]); w.y = cvt_pk_bf16(o[2], o[3]); *(v2u*)(hb + o2) = w;
                        s += (o[0] * o[0] + o[1] * o[1]) + (o[2] * o[2] + o[3] * o[3]); }
                s += __shfl_xor(s, 16); s += __shfl_xor(s, 32);
                if (fq == 0) P[rl * 4 + wc] = s;
                if (m == 3) asm volatile("" ::: "memory"); }
        asm volatile("s_waitcnt lgkmcnt(0)" ::: "memory"); __builtin_amdgcn_s_barrier(); asm volatile("" ::: "memory");
        const int t = wid * 64 + lane;
        if (t < 256) { const f32x4 p = *(const LAS f32x4*)(P + t * 4); ssq_out[(size_t)(u.pm * BM + t) * 4 + u.pn] = (p.x + p.y) + (p.z + p.w); }
    }
};

struct EpiPle {
    static constexpr bool PERM = false, AFTER_DRAIN = false, PRE = false;
    const bf16* base; float* out; const float* ssq3; const float* spp; const bf16* pp; const float* bias; const float* gout;
    __device__ __forceinline__ void operator()(const Acc& acc, const Unit& u, int wr, int wc, int fr, int fq) const {
        asm volatile("" : "+v"(fr), "+v"(fq));
        const int col0 = u.pn * BM + wc * 32 + 4 * fq;
        f32x4 nb[2][2], gv[2][2];
#pragma unroll
        for (int bj = 0; bj < 2; ++bj)
#pragma unroll
            for (int n = 0; n < 2; ++n) { nb[bj][n] = *(const f32x4*)(bias + col0 + bj * HALF + n * 16) * -LOG2E; gv[bj][n] = *(const f32x4*)(gout + col0 + bj * HALF + n * 16); }
        float nr3s[2][4], rpps[2][4];
#pragma unroll
        for (int ai = 0; ai < 2; ++ai)
#pragma unroll
            for (int m = 0; m < 4; ++m) { const int row = u.pm * BM + ai * HALF + wr * 64 + m * 16 + fr;
                nr3s[ai][m] = rstd4(ssq3, row, 1.f / DM) * -LOG2E;
                const f32x4 a = *(const f32x4*)(spp + (size_t)row * 16), b = *(const f32x4*)(spp + (size_t)row * 16 + 4), c = *(const f32x4*)(spp + (size_t)row * 16 + 8), d = *(const f32x4*)(spp + (size_t)row * 16 + 12);
                const float sp = (((a.x + a.y) + (a.z + a.w)) + ((b.x + b.y) + (b.z + b.w))) + (((c.x + c.y) + (c.z + c.w)) + ((d.x + d.y) + (d.z + d.w)));
                rpps[ai][m] = __builtin_amdgcn_rsqf(sp * (1.f / DM) + EPS); }
#pragma unroll
        for (int ai = 0; ai < 2; ++ai)
#pragma unroll
            for (int m = 0; m < 4; ++m) { const int row = u.pm * BM + ai * HALF + wr * 64 + m * 16 + fr; const size_t off = (size_t)row * DM + col0;
                const f32x2 nr3 = {nr3s[ai][m], nr3s[ai][m]}, rpp = {rpps[ai][m], rpps[ai][m]}, one = {1.f, 1.f};
#pragma unroll
                for (int bj = 0; bj < 2; ++bj)
#pragma unroll
                    for (int n = 0; n < 2; ++n) { const size_t o2 = off + bj * HALF + n * 16; const v2u hw = *(const v2u*)(base + o2); const v2u pw = *(const v2u*)(pp + o2);
                        const f32x4 a4 = acc[ai][bj][m][n], b4 = nb[bj][n], g4 = gv[bj][n]; f32x4 o;
#pragma unroll
                        for (int h = 0; h < 2; ++h) {
                            const f32x2 a = h ? (f32x2){a4.z, a4.w} : (f32x2){a4.x, a4.y}, b = h ? (f32x2){b4.z, b4.w} : (f32x2){b4.x, b4.y}, g = h ? (f32x2){g4.z, g4.w} : (f32x2){g4.x, g4.y};
                            const unsigned hx = h ? hw.y : hw.x, px = h ? pw.y : pw.x;
                            const f32x2 hv = {bf_lo(hx), bf_hi(hx)}, pv = {bf_lo(px), bf_hi(px)};
                            const f32x2 t = __builtin_elementwise_fma(a, nr3, b);
                            const f32x2 d = (f32x2){__builtin_amdgcn_exp2f(t.x), __builtin_amdgcn_exp2f(t.y)} + one;
                            const f32x2 rc = {__builtin_amdgcn_rcpf(d.x), __builtin_amdgcn_rcpf(d.y)};
                            const f32x2 r = __builtin_elementwise_fma(rc, (pv * rpp) * g, hv);
                            if (h) { o.z = r.x; o.w = r.y; } else { o.x = r.x; o.y = r.y; } }
                        __builtin_nontemporal_store(o, (f32x4*)(out + o2)); }
                if (m == 3) asm volatile("" ::: "memory"); }
    }
};
}
}
namespace mk {
struct Frame {
    LAS unsigned char* lds;
    volatile LAS unsigned* MISC;
    gu32* ctl;
    int tid, lane, wave;
    int vcu, G;
    float* out; unsigned char* ws;
};
#define PANEL_BAR() do { if (F.G == 256) { GrpBarrier gb_; gb_.ctl = bar.bar; gb_.tmo = bar.bar; gb_.g = blockIdx.x & 7u; gb_.x = bar.x; gb_.st = F.MISC + 12; grp_barrier(gb_); } else xcd_barrier(bar); } while (0)
__device__ __forceinline__ const float* kin(int i) { return ((const float* const __attribute__((address_space(4)))*)__builtin_amdgcn_kernarg_segment_ptr())[i]; }
enum { I_X = 0, I_P, I_GFFN1, I_W1G, I_W1U, I_W1D, I_GMIX, I_WIN, I_GQLAT, I_WQUP, I_GKVLAT, I_WKVUP, I_GMLAQ, I_GMLAK, I_GDQ, I_GDK, I_LQ1, I_LK1, I_LQ2, I_LK2, I_GSUB, I_WOUT,
       I_GFFN2, I_W2G, I_W2U, I_W2D, I_GPLEIN, I_WPG, I_BPG, I_WPP, I_GPLEOUT };

struct ColSrc { const float* p; int ld; int krows; const float* gain; };
__device__ __forceinline__ int erope(int j) { return 4 * (j >> 3) + (j & 3) + 16 * ((j >> 2) & 1); }
__device__ __forceinline__ ColSrc colsrc(const Frame& F, int id, int np) {
    ColSrc c; c.p = nullptr; c.ld = 0; c.krows = 0; c.gain = nullptr;
    const int t = np >> 8, tc = np & 255, bj = tc >> 7, wc = (tc >> 5) & 3, j = tc & 31, e = 32 * bj + j;
    if (id == 0 || id == 2) { const float* wg = kin(id == 0 ? I_W1G : I_W2G); const float* wu = kin(id == 0 ? I_W1U : I_W2U);
        c.p = (bj ? wu : wg) + 128 * t + (tc & 127); c.ld = DFF; c.krows = DM; c.gain = kin(id == 0 ? I_GFFN1 : I_GFFN2); }
    else if (id == 1 || id == 3) { c.p = kin(id == 1 ? I_W1D : I_W2D) + np; c.ld = DM; c.krows = DFF; }
    else if (id == 4) { int lg = -1;
        if (t == 0) lg = tc;
        else if (t == 1) { if (bj == 0) lg = 256 + tc; else if (wc == 0) lg = 384 + erope(j); }
        else if (t < 4) lg = 416 + 64 * (4 * (t - 2) + wc) + e;
        else if (t < 6) lg = 928 + 64 * (4 * (t - 4) + wc) + e;
        else lg = 1440 + 256 * (t - 6) + tc;
        if (lg >= 0) { c.p = kin(I_WIN) + lg; c.ld = NIN; c.krows = DM; c.gain = kin(I_GMIX); } }
    else if (id == 5) {
        if (t < 2) { c.p = kin(I_WQUP) + 96 * (4 * t + wc) + e; c.ld = 768; c.krows = 256; c.gain = kin(I_GQLAT); }
        else if (t == 2) { c.p = kin(I_WQUP) + 96 * (2 * wc + bj) + 64 + erope(j); c.ld = 768; c.krows = 256; c.gain = kin(I_GQLAT); }
        else if (t < 7) { const int cid = 4 * (t - 3) + wc; c.p = kin(I_WKVUP) + 128 * (cid >> 1) + 64 * (cid & 1) + e; c.ld = 1024; c.krows = 128; c.gain = kin(I_GKVLAT); }
        else { c.p = kin(I_WPP) + 256 * (t - 7) + tc; c.ld = DM; c.krows = 256; } }
    else if (id == 6) { c.p = kin(I_WOUT) + np; c.ld = DM; c.krows = DM; }
    else { c.p = kin(I_WPG) + np; c.ld = DM; c.krows = DM; c.gain = kin(I_GPLEIN); }
    return c;
}
__device__ __forceinline__ void p0_transpose_item(const Frame& F, int id, int K, bf16* WT, LAS float* scr, int kb, int nb, int lane) {
    const int k0 = 64 * kb, n0 = 32 * nb;
    const int cg = lane & 7, kr = lane >> 3;
    const ColSrc cs = colsrc(F, id, n0 + 4 * cg);
#pragma unroll
    for (int i = 0; i < 8; ++i) { const int kk = 8 * i + kr; const int k = k0 + kk; f32x4 v = {0.f, 0.f, 0.f, 0.f};
        if (cs.p != nullptr && k < cs.krows) { v = __builtin_nontemporal_load((const f32x4*)(cs.p + (size_t)k * cs.ld)); if (cs.gain != nullptr) v = v * cs.gain[k]; }
        *(LAS f32x4*)(scr + kk * 36 + 4 * cg) = v; }
    LDS_WAIT(); asm volatile("" ::: "memory");
    const int c = lane & 7;
#pragma unroll
    for (int jj = 0; jj < 4; ++jj) { const int n = (lane >> 3) + 8 * jj; const LAS float* s = scr + (8 * c) * 36 + n;
        v4u o; o.x = cvt_pk_bf16(s[0 * 36], s[1 * 36]); o.y = cvt_pk_bf16(s[2 * 36], s[3 * 36]); o.z = cvt_pk_bf16(s[4 * 36], s[5 * 36]); o.w = cvt_pk_bf16(s[6 * 36], s[7 * 36]);
        *(GAS v4u*)(WT + (size_t)(n0 + n) * K + k0 + 8 * c) = o; }
    LDS_WAIT(); asm volatile("" ::: "memory");
}
__device__ __forceinline__ void sincos_acc(float ang, float& s, float& c) {
    const double a = (double)ang;
    const double k = rint(a * 0.15915494309189535);
    const double r = a - k * 6.283185307179586;
    const double r2 = r * r;
    double ps = 1.0, pc = 1.0;
#pragma unroll
    for (int i = 12; i >= 1; --i) {
        ps = 1.0 - ps * r2 * (1.0 / (double)((2 * i) * (2 * i + 1)));
        pc = 1.0 - pc * r2 * (1.0 / (double)((2 * i - 1) * (2 * i)));
    }
    s = (float)(r * ps); c = (float)pc;
}
__device__ __forceinline__ void p0_convert(Frame& F, int id_lo, int id_hi, int gw, int NGW) {
    LAS float* scr = (LAS float*)(F.lds + RING_OFF + F.wave * 16384);
    constexpr int NMAT = 8;
    const int Ks[NMAT] = {DM, DFF, DM, DFF, DM, 256, DM, DM};
    const int Ns[NMAT] = {2 * DFF, DM, 2 * DFF, DM, 2048, 2816, DM, DM};
    const size_t Ds[NMAT] = {WS_WGU1, WS_WD1, WS_WGU2, WS_WD2, WS_WIN, WS_WUP, WS_WOUT, WS_WPG};
    int base = 0;
#pragma unroll
    for (int id = 0; id < NMAT; ++id) {
        if (id < id_lo || id >= id_hi) continue;
        const int nkb = Ks[id] / 64, nnb = Ns[id] / 32, nit = nkb * nnb;
        int first = base + ((gw - base % NGW) + NGW) % NGW;
        for (int it = first; it < base + nit; it += NGW) { const int r = it - base; p0_transpose_item(F, id, Ks[id], (bf16*)(F.ws + Ds[id]), scr, r / nnb, r % nnb, F.lane); }
        base += nit;
    }
}
__device__ __forceinline__ void p0_prologue(Frame& F) {
    const int gw = F.vcu * NWAVES + F.wave, NGW = F.G * NWAVES;
    p0_convert(F, 0, 2, gw, NGW);
    if (F.G != 256) { p0_convert(F, 2, 8, gw, NGW); }
    const float* x = kin(I_X); const float* p = kin(I_P);
    bf16* HB = (bf16*)(F.ws + WS_HB); float* S0 = (float*)(F.ws + WS_S0);
    for (int m = gw; m < M; m += 2 * NGW) {
        const int m2 = m + NGW;
        const GAS f32x4* xr = (const GAS f32x4*)(x + (size_t)m * DM) + F.lane; const GAS f32x4* xr2 = (const GAS f32x4*)(x + (size_t)m2 * DM) + F.lane;
        f32x4 v[4], w2[4];
#pragma unroll
        for (int j = 0; j < 4; ++j) { v[j] = __builtin_nontemporal_load(xr + 64 * j); w2[j] = __builtin_nontemporal_load(xr2 + 64 * j); }
        const f32x4 pv = __builtin_nontemporal_load((const GAS f32x4*)(p + (size_t)m * PLE) + F.lane), pv2 = __builtin_nontemporal_load((const GAS f32x4*)(p + (size_t)m2 * PLE) + F.lane);
        GAS v2u* o8 = (GAS v2u*)(HB + (size_t)m * DM) + F.lane; GAS v2u* o82 = (GAS v2u*)(HB + (size_t)m2 * DM) + F.lane; float s = 0.f, s2 = 0.f;
#pragma unroll
        for (int j = 0; j < 4; ++j) { s += (v[j].x * v[j].x + v[j].y * v[j].y) + (v[j].z * v[j].z + v[j].w * v[j].w); v2u w; w.x = cvt_pk_bf16(v[j].x, v[j].y); w.y = cvt_pk_bf16(v[j].z, v[j].w); o8[64 * j] = w;
            s2 += (w2[j].x * w2[j].x + w2[j].y * w2[j].y) + (w2[j].z * w2[j].z + w2[j].w * w2[j].w); v2u u; u.x = cvt_pk_bf16(w2[j].x, w2[j].y); u.y = cvt_pk_bf16(w2[j].z, w2[j].w); o82[64 * j] = u; }
        s = wave_sum(s); s2 = wave_sum(s2);
        if (F.lane == 0) { *(GAS f32x4*)(S0 + (size_t)m * 4) = (f32x4){s, 0.f, 0.f, 0.f}; *(GAS f32x4*)(S0 + (size_t)m2 * 4) = (f32x4){s2, 0.f, 0.f, 0.f}; }
        v2u w; w.x = cvt_pk_bf16(pv.x, pv.y); w.y = cvt_pk_bf16(pv.z, pv.w); *((GAS v2u*)(F.ws + pb_panel_off(m >> 8) + (size_t)(m & 255) * 512) + F.lane) = w;
        v2u u; u.x = cvt_pk_bf16(pv2.x, pv2.y); u.y = cvt_pk_bf16(pv2.z, pv2.w); *((GAS v2u*)(F.ws + pb_panel_off(m2 >> 8) + (size_t)(m2 & 255) * 512) + F.lane) = u;
    }
    float2* tab = (float2*)(F.ws + WS_TAB);
    for (int idx = gw * 64 + F.lane; idx < SEQ * 16; idx += NGW * 64) {
        const int s = idx >> 4, i = idx & 15;
        const float inv = (float)exp2(-(double)(2 * i) / 32.0 * 13.287712379549449);
        const float ang = (float)s * inv; float sn, cs; sincos_acc(ang, sn, cs);
        tab[idx] = make_float2(cs, sn);
    }
}
}
namespace mk {
namespace att {
using s16x4 = __attribute__((ext_vector_type(4))) short;
using f32x16 = __attribute__((ext_vector_type(16))) float;
typedef LAS const char* lds_cptr;
typedef short v4i16_t __attribute__((ext_vector_type(4)));
typedef __bf16 bf16x2_t __attribute__((ext_vector_type(2)));
constexpr float THRL = 8.f;
__device__ __forceinline__ int crow(int r, int hi) { return (r & 3) + 8 * (r >> 2) + 4 * hi; }
__device__ __forceinline__ void glds16(const void* gsrc, unsigned lds_dst) { unsigned keep;
    asm volatile("s_mov_b32 %0, m0\n\ts_mov_b32 m0, %2\n\ts_nop 0\n\tglobal_load_lds_dwordx4 %1, off\n\ts_mov_b32 m0, %0" : "=&s"(keep) : "v"(gsrc), "s"(lds_dst) : "memory"); }
__device__ __forceinline__ void glds16s(const void* sbase, unsigned voff, unsigned lds_dst) { unsigned keep;
    asm volatile("s_nop 4\n\ts_mov_b32 %0, m0\n\ts_mov_b32 m0, %3\n\ts_nop 0\n\tglobal_load_lds_dwordx4 %1, %2\n\ts_mov_b32 m0, %0" : "=&s"(keep) : "v"(voff), "s"(sbase), "s"(lds_dst) : "memory"); }
__device__ __forceinline__ const char* uptr(const void* p) { const unsigned long long v = (unsigned long long)p; const unsigned lo = __builtin_amdgcn_readfirstlane((unsigned)v), hi = __builtin_amdgcn_readfirstlane((unsigned)(v >> 32)); return (const char*)(((unsigned long long)hi << 32) | lo); }
__device__ __forceinline__ unsigned cvtpk_s(float lo, float hi) { f32x2 v = {lo, hi}; bf16x2_t b = __builtin_convertvector(v, bf16x2_t); return __builtin_bit_cast(unsigned, b); }
#define ATT_WAIT_BAR0() asm volatile("s_waitcnt vmcnt(0) lgkmcnt(0)\n\ts_barrier" ::: "memory")
#define ATT_LBAR() asm volatile("s_waitcnt lgkmcnt(0)\n\ts_barrier" ::: "memory")
#define ATT_WAIT_BARN(N) asm volatile("s_waitcnt vmcnt(" #N ") lgkmcnt(0)\n\ts_barrier" ::: "memory")
constexpr int ATT_WS_OFF = 131072 + 1024;
__device__ __forceinline__ s16x4 vtr(lds_cptr p) { return __builtin_bit_cast(s16x4, __builtin_amdgcn_ds_read_tr16_b64_v4i16((LAS v4i16_t*)p)); }

template <int ND0> __device__ __forceinline__ void qkt(f32x16& p0, f32x16& p1, lds_cptr kslot, const bf16x8* qr, int r32, int hi) {
    const lds_cptr kb = kslot + hi * 1024 + r32 * 16;
    p0 = f32x16{}; p1 = f32x16{};
#pragma unroll
    for (int d0 = 0; d0 < ND0; ++d0) {
        const bf16x8 b0 = *(const LAS bf16x8*)(kb + d0 * 2048);
        const bf16x8 b1 = *(const LAS bf16x8*)(kb + d0 * 2048 + 512);
        p0 = __builtin_amdgcn_mfma_f32_32x32x16_bf16(b0, qr[d0], p0, 0, 0, 0);
        p1 = __builtin_amdgcn_mfma_f32_32x32x16_bf16(b1, qr[d0], p1, 0, 0, 0);
    }
}
template <int NVB> __device__ __forceinline__ void pv(f32x16* o, lds_cptr vp, bf16x8 pa0, bf16x8 pa1, bf16x8 pa2, bf16x8 pa3) {
#pragma unroll
    for (int d0 = 0; d0 < NVB; ++d0) { s16x4 lo[4], hh[4];
#pragma unroll
        for (int ks = 0; ks < 4; ++ks) { lo[ks] = vtr(vp + d0 * 4096 + ks * 1024); hh[ks] = vtr(vp + d0 * 4096 + ks * 1024 + 512); }
#define ATT_PK(k) (bf16x8){lo[k][0], lo[k][1], lo[k][2], lo[k][3], hh[k][0], hh[k][1], hh[k][2], hh[k][3]}
        o[d0] = __builtin_amdgcn_mfma_f32_32x32x16_bf16(pa0, ATT_PK(0), o[d0], 0, 0, 0);
        o[d0] = __builtin_amdgcn_mfma_f32_32x32x16_bf16(pa1, ATT_PK(1), o[d0], 0, 0, 0);
        o[d0] = __builtin_amdgcn_mfma_f32_32x32x16_bf16(pa2, ATT_PK(2), o[d0], 0, 0, 0);
        o[d0] = __builtin_amdgcn_mfma_f32_32x32x16_bf16(pa3, ATT_PK(3), o[d0], 0, 0, 0);
#undef ATT_PK
    }
}
__device__ __forceinline__ float rowmax(const f32x16& p0, const f32x16& p1) {
    float a = fmaxf(p0[0], p1[0]);
#pragma unroll
    for (int r = 1; r < 16; ++r) a = fmaxf(a, fmaxf(p0[r], p1[r]));
    auto rr = __builtin_amdgcn_permlane32_swap(__float_as_uint(a), __float_as_uint(a), false, false);
    return fmaxf(__uint_as_float(rr[0]), __uint_as_float(rr[1]));
}
template <int NVB> __device__ __forceinline__ void softmax_step(f32x16& p0, f32x16& p1, float& m_reg, float& l_reg, f32x16* o, LAS float* wsf, int r32, int hi,
                                                                 bf16x8& pa0, bf16x8& pa1, bf16x8& pa2, bf16x8& pa3) {
    const float rm = rowmax(p0, p1);
    if (!__all(rm - m_reg <= THRL)) {
        const float mn = fmaxf(m_reg, rm), f = __builtin_amdgcn_exp2f(m_reg - mn);
        m_reg = mn; l_reg *= f;
        if (hi == 0) wsf[r32] = f;
        asm volatile("s_waitcnt lgkmcnt(0)" ::: "memory");
#pragma unroll
        for (int d = 0; d < NVB; ++d)
#pragma unroll
            for (int r = 0; r < 16; ++r) o[d][r] *= wsf[crow(r, hi)];
    }
    float s = 0.f;
#pragma unroll
    for (int r = 0; r < 16; ++r) { p0[r] = __builtin_amdgcn_exp2f(p0[r] - m_reg); p1[r] = __builtin_amdgcn_exp2f(p1[r] - m_reg); s += p0[r] + p1[r]; }
    l_reg += s;
    v4u w0 = {cvtpk_s(p0[0], p0[1]), cvtpk_s(p0[2], p0[3]), cvtpk_s(p0[4], p0[5]), cvtpk_s(p0[6], p0[7])};
    v4u w1 = {cvtpk_s(p0[8], p0[9]), cvtpk_s(p0[10], p0[11]), cvtpk_s(p0[12], p0[13]), cvtpk_s(p0[14], p0[15])};
    v4u w2 = {cvtpk_s(p1[0], p1[1]), cvtpk_s(p1[2], p1[3]), cvtpk_s(p1[4], p1[5]), cvtpk_s(p1[6], p1[7])};
    v4u w3 = {cvtpk_s(p1[8], p1[9]), cvtpk_s(p1[10], p1[11]), cvtpk_s(p1[12], p1[13]), cvtpk_s(p1[14], p1[15])};
    pa0 = __builtin_bit_cast(bf16x8, w0); pa1 = __builtin_bit_cast(bf16x8, w1); pa2 = __builtin_bit_cast(bf16x8, w2); pa3 = __builtin_bit_cast(bf16x8, w3);
}

template <int NVB> __device__ __forceinline__ void softmax_rel(f32x16& p0, f32x16& p1, float& mhat, float& l_reg, f32x16* o, LAS float* wsf, int r32, int hi,
                                                                bf16x8& pa0, bf16x8& pa1, bf16x8& pa2, bf16x8& pa3) {
    float a = fmaxf(fmaxf(p0[0], p0[1]), p1[0]), b = fmaxf(fmaxf(p0[2], p0[3]), p1[1]); a = fmaxf(fmaxf(a, p1[2]), p1[3]);
#pragma unroll
    for (int r = 4; r < 16; r += 4) { a = fmaxf(fmaxf(a, p0[r]), p0[r + 1]); b = fmaxf(fmaxf(b, p0[r + 2]), p0[r + 3]); a = fmaxf(fmaxf(a, p1[r]), p1[r + 1]); b = fmaxf(fmaxf(b, p1[r + 2]), p1[r + 3]); }
    float rm = fmaxf(a, b);
    { auto rr = __builtin_amdgcn_permlane32_swap(__float_as_uint(rm), __float_as_uint(rm), false, false); rm = fmaxf(__uint_as_float(rr[0]), __uint_as_float(rr[1])); }
    if (__builtin_expect(__any(rm > THRL), 0)) {
        const float dl = fmaxf(rm, 0.f), f = __builtin_amdgcn_exp2f(-dl);
        mhat += dl; l_reg *= f;
#pragma unroll
        for (int r = 0; r < 16; ++r) { p0[r] -= dl; p1[r] -= dl; }
        if (hi == 0) wsf[r32] = f;
        asm volatile("s_waitcnt lgkmcnt(0)" ::: "memory");
#pragma unroll
        for (int d = 0; d < NVB; ++d)
#pragma unroll
            for (int r = 0; r < 16; ++r) o[d][r] *= (wsf + 4 * hi)[(r & 3) + 8 * (r >> 2)];
    }
    float s = 0.f;
#pragma unroll
    for (int r = 0; r < 16; ++r) { p0[r] = __builtin_amdgcn_exp2f(p0[r]); p1[r] = __builtin_amdgcn_exp2f(p1[r]); s += p0[r] + p1[r]; }
    l_reg += s;
    v4u w0 = {cvtpk_s(p0[0], p0[1]), cvtpk_s(p0[2], p0[3]), cvtpk_s(p0[4], p0[5]), cvtpk_s(p0[6], p0[7])};
    v4u w1 = {cvtpk_s(p0[8], p0[9]), cvtpk_s(p0[10], p0[11]), cvtpk_s(p0[12], p0[13]), cvtpk_s(p0[14], p0[15])};
    v4u w2 = {cvtpk_s(p1[0], p1[1]), cvtpk_s(p1[2], p1[3]), cvtpk_s(p1[4], p1[5]), cvtpk_s(p1[6], p1[7])};
    v4u w3 = {cvtpk_s(p1[8], p1[9]), cvtpk_s(p1[10], p1[11]), cvtpk_s(p1[12], p1[13]), cvtpk_s(p1[14], p1[15])};
    pa0 = __builtin_bit_cast(bf16x8, w0); pa1 = __builtin_bit_cast(bf16x8, w1); pa2 = __builtin_bit_cast(bf16x8, w2); pa3 = __builtin_bit_cast(bf16x8, w3);
}
template <int ND0> __device__ __forceinline__ void qkt_c(f32x16& p0, f32x16& p1, lds_cptr kslot, const bf16x8* qr, const f32x16& c0, const f32x16& c1, int r32, int hi) {
    const lds_cptr kb = kslot + hi * 1024 + r32 * 16;
#pragma unroll
    for (int d0 = 0; d0 < ND0; ++d0) {
        const bf16x8 b0 = *(const LAS bf16x8*)(kb + d0 * 2048);
        const bf16x8 b1 = *(const LAS bf16x8*)(kb + d0 * 2048 + 512);
        if (d0 == 0) { p0 = __builtin_amdgcn_mfma_f32_32x32x16_bf16(b0, qr[0], c0, 0, 0, 0); p1 = __builtin_amdgcn_mfma_f32_32x32x16_bf16(b1, qr[0], c1, 0, 0, 0); }
        else { p0 = __builtin_amdgcn_mfma_f32_32x32x16_bf16(b0, qr[d0], p0, 0, 0, 0); p1 = __builtin_amdgcn_mfma_f32_32x32x16_bf16(b1, qr[d0], p1, 0, 0, 0); }
    }
}
#define ATT_NEXT(x) (((x) == (NSLOT - 1) * BUF) ? 0 : (x) + BUF)
#define ATT_SBAR() __builtin_amdgcn_sched_barrier(0)
#define ATT_PK2(L, H) (bf16x8){L[0], L[1], L[2], L[3], H[0], H[1], H[2], H[3]}


constexpr int MLA_KB = 12 * 1024, MLA_VB = 8 * 1024, MLA_BUF = MLA_KB + MLA_VB, MLA_NSLOT = 5, MLA_D = 3, MLA_WS = ATT_WS_OFF, MLA_OST = 0;
__device__ __forceinline__ void mla_unit(int b, int h, int qb, const bf16* QM, const bf16* KVM, const bf16* KROT, bf16* OCAT, LAS char* shm) {
    constexpr int BUF = MLA_BUF, NSLOT = MLA_NSLOT, D = MLA_D;
    const int tid = threadIdx.x, lane = tid & 63, r32 = lane & 31, hi = lane >> 5; const int wid = __builtin_amdgcn_readfirstlane(tid >> 6);
    const bool lead = wid < 4;
    const long rowbase = (long)b * SEQ; const int q0 = qb * 256;
    const unsigned lds0 = (unsigned)(uintptr_t)shm;
    LAS float* wsf = (LAS float*)(shm + MLA_WS) + wid * 64;
    bf16x8 qr[6];
    { const bf16* Qw = QM + (rowbase + q0 + wid * 32 + r32) * 768 + h * 96 + hi * 8;
#pragma unroll
      for (int d0 = 0; d0 < 6; ++d0) qr[d0] = *(const bf16x8*)(Qw + d0 * 16); }
    const char* kvbase = (const char*)(KVM + rowbase * 1024 + h * 128); const char* krbase = (const char*)(KROT + rowbase * 32);
    const unsigned koffA = (unsigned)(lane * 1024 + wid * 8) * 2u;
    const unsigned koffB = (unsigned)(lane * 32 + (wid & 3) * 8) * 2u;
    const unsigned voffs = (unsigned)((16 * (wid & 3) + (lane >> 2)) * 1024 + 64 + (wid >> 2) * 32 + (lane & 3) * 8) * 2u;
#define MLA_DMA(t, sl) do { const unsigned base_ = lds0 + (sl); const char* kvt_ = uptr(kvbase + (size_t)(t) * (64 * 1024 * 2)); \
        glds16s(kvt_, koffA, (unsigned)__builtin_amdgcn_readfirstlane(base_ + wid * 1024)); \
        if (wid < 4) glds16s(uptr(krbase + (size_t)(t) * (64 * 32 * 2)), koffB, (unsigned)__builtin_amdgcn_readfirstlane(base_ + (8 + wid) * 1024)); \
        glds16s(kvt_, voffs, (unsigned)__builtin_amdgcn_readfirstlane(base_ + MLA_KB + wid * 1024)); } while (0)
    const int vofs = ((lane >> 4) & 1) * 32 + (lane & 3) * 8 + (4 * hi + ((lane & 15) >> 2)) * 64;
    const int kofs = hi * 1024 + r32 * 16;
    float mhat = 0.f, l_reg = 0.f; f32x16 o[2]; o[0] = f32x16{}; o[1] = f32x16{};
    f32x16 p0, p1; bf16x8 pa0, pa1, pa2, pa3; bf16x8 kf[12]; s16x4 vlo[8], vhh[8];
    constexpr int NT = SEQ / 64;
#define MLA_KLOAD(sl) do { const lds_cptr kb_ = (lds_cptr)shm + (sl) + kofs; _Pragma("unroll") for (int d0 = 0; d0 < 6; ++d0) { \
        kf[2 * d0] = *(const LAS bf16x8*)(kb_ + d0 * 2048); kf[2 * d0 + 1] = *(const LAS bf16x8*)(kb_ + d0 * 2048 + 512); } } while (0)
#define MLA_QK() do { f32x16 c_; _Pragma("unroll") for (int r = 0; r < 16; ++r) c_[r] = -mhat; \
        p0 = __builtin_amdgcn_mfma_f32_32x32x16_bf16(kf[0], qr[0], c_, 0, 0, 0); p1 = __builtin_amdgcn_mfma_f32_32x32x16_bf16(kf[1], qr[0], c_, 0, 0, 0); \
        _Pragma("unroll") for (int d0 = 1; d0 < 6; ++d0) { p0 = __builtin_amdgcn_mfma_f32_32x32x16_bf16(kf[2 * d0], qr[d0], p0, 0, 0, 0); p1 = __builtin_amdgcn_mfma_f32_32x32x16_bf16(kf[2 * d0 + 1], qr[d0], p1, 0, 0, 0); } } while (0)
#define MLA_VLOAD(sl) do { const lds_cptr vp_ = (lds_cptr)shm + (sl) + MLA_KB + vofs; _Pragma("unroll") for (int i = 0; i < 8; ++i) { \
        vlo[i] = vtr(vp_ + (i >> 2) * 4096 + (i & 3) * 1024); vhh[i] = vtr(vp_ + (i >> 2) * 4096 + (i & 3) * 1024 + 512); } } while (0)
#define MLA_PV() do { _Pragma("unroll") for (int d0 = 0; d0 < 2; ++d0) { \
        o[d0] = __builtin_amdgcn_mfma_f32_32x32x16_bf16(pa0, ATT_PK2(vlo[d0 * 4 + 0], vhh[d0 * 4 + 0]), o[d0], 0, 0, 0); o[d0] = __builtin_amdgcn_mfma_f32_32x32x16_bf16(pa1, ATT_PK2(vlo[d0 * 4 + 1], vhh[d0 * 4 + 1]), o[d0], 0, 0, 0); \
        o[d0] = __builtin_amdgcn_mfma_f32_32x32x16_bf16(pa2, ATT_PK2(vlo[d0 * 4 + 2], vhh[d0 * 4 + 2]), o[d0], 0, 0, 0); o[d0] = __builtin_amdgcn_mfma_f32_32x32x16_bf16(pa3, ATT_PK2(vlo[d0 * 4 + 3], vhh[d0 * 4 + 3]), o[d0], 0, 0, 0); } } while (0)
#define MLA_BAR(t) do { if ((t) + D < NT) { if (lead) ATT_WAIT_BARN(6); else ATT_WAIT_BARN(4); } else ATT_WAIT_BAR0(); } while (0)
    MLA_DMA(0, 0); MLA_DMA(1, BUF); MLA_DMA(2, 2 * BUF); MLA_DMA(3, 3 * BUF);
    if (lead) { ATT_WAIT_BARN(9); } else { ATT_WAIT_BARN(6); ATT_WAIT_BARN(6); }
    int s_v = 0, s_k = BUF, s_d = 4 * BUF;
    MLA_KLOAD(0); MLA_QK();
    for (int t = 0; t < NT; ++t) {
        MLA_BAR(t);
        if (t + 1 + D < NT) MLA_DMA(t + 1 + D, s_d);
        MLA_VLOAD(s_v); ATT_SBAR();
        softmax_rel<2>(p0, p1, mhat, l_reg, o, wsf, r32, hi, pa0, pa1, pa2, pa3);
        MLA_BAR(t);
        __builtin_amdgcn_s_setprio(2);
        if (t + 1 < NT) { MLA_KLOAD(s_k); } ATT_SBAR();
        MLA_PV();
        if (t + 1 < NT) { MLA_QK(); }
        __builtin_amdgcn_s_setprio(0);
        s_v = s_k; s_k = ATT_NEXT(s_k); s_d = ATT_NEXT(s_d);
    }
    if (lead) ATT_LBAR();
    ATT_LBAR();
#undef MLA_DMA
#undef MLA_KLOAD
#undef MLA_QK
#undef MLA_VLOAD
#undef MLA_PV
#undef MLA_BAR
    int lane_e = lane; asm volatile("" : "+v"(lane_e)); const int r32e = lane_e & 31, hie = lane_e >> 5;
    { auto rr = __builtin_amdgcn_permlane32_swap(__float_as_uint(l_reg), __float_as_uint(l_reg), false, false); l_reg = __uint_as_float(rr[0]) + __uint_as_float(rr[1]); }
    if (hie == 0) wsf[32 + r32e] = l_reg;
    asm volatile("s_waitcnt lgkmcnt(0)" ::: "memory");
    float rli[16];
#pragma unroll
    for (int r = 0; r < 16; ++r) rli[r] = __builtin_amdgcn_rcpf((wsf + 32 + 4 * hie)[(r & 3) + 8 * (r >> 2)]);
    bf16* Ow = OCAT + (rowbase + q0 + wid * 32) * 1024 + h * 64;
    { LAS bf16* stg = (LAS bf16*)(shm + MLA_OST) + wid * 2048;
#pragma unroll
      for (int r = 0; r < 16; ++r) { const int orow = crow(r, hie);
#pragma unroll
          for (int d0 = 0; d0 < 2; ++d0) stg[orow * 64 + d0 * 32 + r32e] = (bf16)(cvtpk_s(o[d0][r] * rli[r], 0.f) & 0xffffu); }
      asm volatile("s_waitcnt lgkmcnt(0)" ::: "memory");
#pragma unroll
      for (int i = 0; i < 4; ++i) { const int row = i * 8 + (lane_e >> 3), ch = lane_e & 7; const v4u v = *(const LAS v4u*)(stg + row * 64 + ch * 8); *(v4u*)(Ow + (long)row * 1024 + ch * 8) = v; } }
    ATT_LBAR();
}

constexpr int DF_KB = 16 * 1024, DF_VB = 16 * 1024, DF_BUF = DF_KB + DF_VB, DF_NSLOT = 4, DF_D = 2, DF_WS = ATT_WS_OFF, DF_X = 0, DF_OST = 65536;
__device__ __forceinline__ void diff_unit(int b, int h, int qb, int t_lo, int NT, const bf16* QD, const bf16* KD, const bf16* VD, bf16* OCAT, float lam, const float* gsub, LAS char* shm) {
    constexpr int BUF = DF_BUF, NSLOT = DF_NSLOT, D = DF_D;
    const int tid = threadIdx.x, lane = tid & 63, r32 = lane & 31, hi = lane >> 5; const int wid = __builtin_amdgcn_readfirstlane(tid >> 6);
    const int w4 = wid & 3, mp = wid >> 2; const bool lead = mp == 0;
    const long rowbase = (long)b * SEQ; const int q0 = qb * 128;
    const unsigned lds0 = (unsigned)(uintptr_t)shm;
    LAS float* wsf = (LAS float*)(shm + DF_WS) + wid * 64;
    bf16x8 qr[4];
    { const bf16* Qw = QD + (rowbase + q0 + w4 * 32 + r32) * 512 + h * 128 + mp * 64 + hi * 8;
#pragma unroll
      for (int d0 = 0; d0 < 4; ++d0) qr[d0] = *(const bf16x8*)(Qw + d0 * 16); }
    const char* kbase = (const char*)(KD + rowbase * 512 + h * 128); const char* vbase = (const char*)(VD + rowbase * 512 + h * 128);
    const unsigned koffs = (unsigned)(lane * 512 + wid * 8) * 2u;
    const unsigned voffs = (unsigned)((16 * (wid & 3) + (lane >> 2)) * 512 + (wid >> 2) * 32 + (lane & 3) * 8) * 2u;
#define DF_DMA(t, sl) do { const unsigned base_ = lds0 + (sl); const char* kt_ = uptr(kbase + (size_t)(t) * (64 * 512 * 2)); const char* vt_ = uptr(vbase + (size_t)(t) * (64 * 512 * 2)); \
        glds16s(kt_, koffs, (unsigned)__builtin_amdgcn_readfirstlane(base_ + wid * 1024)); \
        glds16s(kt_ + 128, koffs, (unsigned)__builtin_amdgcn_readfirstlane(base_ + (8 + wid) * 1024)); \
        glds16s(vt_, voffs, (unsigned)__builtin_amdgcn_readfirstlane(base_ + DF_KB + wid * 1024)); \
        glds16s(vt_ + 128, voffs, (unsigned)__builtin_amdgcn_readfirstlane(base_ + DF_KB + (8 + wid) * 1024)); } while (0)
    const int vofs = ((lane >> 4) & 1) * 32 + (lane & 3) * 8 + (4 * hi + ((lane & 15) >> 2)) * 64;
    const int kofs = mp * 8192 + hi * 1024 + r32 * 16;
    const float sl2 = __builtin_amdgcn_exp2f(-2.f * (float)(h + 1)) * LOG2E;
    const int qpos = q0 + w4 * 32 + r32;
    const int t_d = (q0 + w4 * 32) >> 6;
    float mhat = 0.f, l_reg = 0.f; f32x16 o[4]; o[0] = f32x16{}; o[1] = f32x16{}; o[2] = f32x16{}; o[3] = f32x16{};
    f32x16 p0, p1; bf16x8 pa0, pa1, pa2, pa3; bf16x8 kf[8]; s16x4 vlo[8], vhh[8], vl2[8], vh2[8];
#define DF_KLOAD(sl) do { const lds_cptr kb_ = (lds_cptr)shm + (sl) + kofs; _Pragma("unroll") for (int d0 = 0; d0 < 4; ++d0) { \
        kf[2 * d0] = *(const LAS bf16x8*)(kb_ + d0 * 2048); kf[2 * d0 + 1] = *(const LAS bf16x8*)(kb_ + d0 * 2048 + 512); } } while (0)
#define DF_QK(t) do { f32x16 c0_, c1_; \
        if ((t) != t_d) { float sg_ = (t) < t_d ? sl2 : -sl2; asm volatile("" : "+v"(sg_)); const float base_ = sg_ * (float)((t) * 64 + 4 * hi - qpos) - mhat; \
            _Pragma("unroll") for (int r = 0; r < 16; ++r) { c0_[r] = fmaf(sg_, (float)((r & 3) + 8 * (r >> 2)), base_); c1_[r] = c0_[r] + 32.f * sg_; } } \
        else { _Pragma("unroll") for (int r = 0; r < 16; ++r) { c0_[r] = -mhat; c1_[r] = -mhat; } } \
        p0 = __builtin_amdgcn_mfma_f32_32x32x16_bf16(kf[0], qr[0], c0_, 0, 0, 0); p1 = __builtin_amdgcn_mfma_f32_32x32x16_bf16(kf[1], qr[0], c1_, 0, 0, 0); \
        _Pragma("unroll") for (int d0 = 1; d0 < 4; ++d0) { p0 = __builtin_amdgcn_mfma_f32_32x32x16_bf16(kf[2 * d0], qr[d0], p0, 0, 0, 0); p1 = __builtin_amdgcn_mfma_f32_32x32x16_bf16(kf[2 * d0 + 1], qr[d0], p1, 0, 0, 0); } \
        if ((t) == t_d) { int d0_ = qpos - ((t) * 64 + 4 * hi); asm volatile("" : "+v"(d0_)); \
            _Pragma("unroll") for (int r = 0; r < 16; ++r) { const int d = d0_ - ((r & 3) + 8 * (r >> 2)); p0[r] -= sl2 * fabsf((float)d); p1[r] -= sl2 * fabsf((float)(d - 32)); } } } while (0)
#define DF_VLOAD(sl) do { const lds_cptr vp_ = (lds_cptr)shm + (sl) + DF_KB + vofs; _Pragma("unroll") for (int i = 0; i < 8; ++i) { \
        vlo[i] = vtr(vp_ + (i >> 2) * 4096 + (i & 3) * 1024); vhh[i] = vtr(vp_ + (i >> 2) * 4096 + (i & 3) * 1024 + 512); } } while (0)
#define DF_VLOAD2(sl) do { const lds_cptr vp_ = (lds_cptr)shm + (sl) + DF_KB + vofs + 8192; _Pragma("unroll") for (int i = 0; i < 8; ++i) { \
        vl2[i] = vtr(vp_ + (i >> 2) * 4096 + (i & 3) * 1024); vh2[i] = vtr(vp_ + (i >> 2) * 4096 + (i & 3) * 1024 + 512); } } while (0)
#define DF_PV4(OB, VL, VH) do { _Pragma("unroll") for (int d0 = 0; d0 < 2; ++d0) { \
        o[OB + d0] = __builtin_amdgcn_mfma_f32_32x32x16_bf16(pa0, ATT_PK2(VL[d0 * 4 + 0], VH[d0 * 4 + 0]), o[OB + d0], 0, 0, 0); o[OB + d0] = __builtin_amdgcn_mfma_f32_32x32x16_bf16(pa1, ATT_PK2(VL[d0 * 4 + 1], VH[d0 * 4 + 1]), o[OB + d0], 0, 0, 0); \
        o[OB + d0] = __builtin_amdgcn_mfma_f32_32x32x16_bf16(pa2, ATT_PK2(VL[d0 * 4 + 2], VH[d0 * 4 + 2]), o[OB + d0], 0, 0, 0); o[OB + d0] = __builtin_amdgcn_mfma_f32_32x32x16_bf16(pa3, ATT_PK2(VL[d0 * 4 + 3], VH[d0 * 4 + 3]), o[OB + d0], 0, 0, 0); } } while (0)
#define DF_BAR(t) do { if ((t) + D < NT) ATT_WAIT_BARN(4); else ATT_WAIT_BAR0(); } while (0)
    DF_DMA(t_lo, 0); DF_DMA(t_lo + 1, BUF); DF_DMA(t_lo + 2, 2 * BUF);
    if (lead) { ATT_WAIT_BARN(8); } else { ATT_WAIT_BARN(8); ATT_WAIT_BARN(8); }
    int s_v = 0, s_k = BUF, s_d = 3 * BUF;
    DF_KLOAD(0); DF_QK(t_lo);
    for (int t = 0; t < NT; ++t) {
        DF_BAR(t);
        DF_VLOAD(s_v); ATT_SBAR();
        softmax_rel<4>(p0, p1, mhat, l_reg, o, wsf, r32, hi, pa0, pa1, pa2, pa3);
        DF_BAR(t);
        __builtin_amdgcn_s_setprio(2);
        if (t + 1 + D < NT) DF_DMA(t_lo + t + 1 + D, s_d);
        DF_VLOAD2(s_v); ATT_SBAR();
        DF_PV4(0, vlo, vhh); ATT_SBAR();
        if (t + 1 < NT) { DF_KLOAD(s_k); } ATT_SBAR();
        DF_PV4(2, vl2, vh2);
        if (t + 1 < NT) { DF_QK(t_lo + t + 1); }
        __builtin_amdgcn_s_setprio(0);
        s_v = s_k; s_k = ATT_NEXT(s_k); s_d = ATT_NEXT(s_d);
    }
    if (lead) ATT_LBAR();
#undef DF_DMA
#undef DF_KLOAD
#undef DF_QK
#undef DF_VLOAD
#undef DF_VLOAD2
#undef DF_PV4
#undef DF_BAR
    int lane_e = lane; asm volatile("" : "+v"(lane_e)); const int r32e = lane_e & 31, hie = lane_e >> 5;
    { auto rr = __builtin_amdgcn_permlane32_swap(__float_as_uint(l_reg), __float_as_uint(l_reg), false, false); l_reg = __uint_as_float(rr[0]) + __uint_as_float(rr[1]); }
    if (hie == 0) wsf[32 + r32e] = l_reg;
    asm volatile("s_waitcnt lgkmcnt(0)" ::: "memory");
#pragma unroll
    for (int r = 0; r < 16; ++r) { const float rl_ = __builtin_amdgcn_rcpf((wsf + 32 + 4 * hie)[(r & 3) + 8 * (r >> 2)]) * (mp == 1 ? lam : 1.f);
#pragma unroll
        for (int d0 = 0; d0 < 4; ++d0) o[d0][r] *= rl_; }
    ATT_LBAR();
    LAS float* X = (LAS float*)(shm + DF_X);
    if (mp == 1) {
#pragma unroll
        for (int r = 0; r < 16; ++r) { LAS float* xr = X + (w4 * 32 + 4 * hie) * 128 + r32e;
#pragma unroll
            for (int d0 = 0; d0 < 4; ++d0) xr[((r & 3) + 8 * (r >> 2)) * 128 + d0 * 32] = o[d0][r]; }
    }
    ATT_LBAR();
    if (mp == 0) {
        float gs[4];
#pragma unroll
        for (int d0 = 0; d0 < 4; ++d0) gs[d0] = gsub[d0 * 32 + r32e] * 0.8f;
        LAS bf16* stg = (LAS bf16*)(shm + DF_OST) + w4 * 4096 + 4 * hie * 128 + r32e;
        const LAS float* xr = X + (w4 * 32 + 4 * hie) * 128 + r32e;
#pragma unroll
        for (int r = 0; r < 16; ++r) { const int c0r = (r & 3) + 8 * (r >> 2); float v[4]; float ss = 0.f;
#pragma unroll
            for (int d0 = 0; d0 < 4; ++d0) { v[d0] = o[d0][r] - xr[c0r * 128 + d0 * 32]; ss += v[d0] * v[d0]; }
            ss += __int_as_float(__builtin_amdgcn_ds_swizzle(__float_as_int(ss), 0x041F)); ss += __int_as_float(__builtin_amdgcn_ds_swizzle(__float_as_int(ss), 0x081F));
            ss += __int_as_float(__builtin_amdgcn_ds_swizzle(__float_as_int(ss), 0x101F)); ss += __int_as_float(__builtin_amdgcn_ds_swizzle(__float_as_int(ss), 0x201F));
            ss += __int_as_float(__builtin_amdgcn_ds_swizzle(__float_as_int(ss), 0x401F));
            const float rr = __builtin_amdgcn_rsqf(ss * (1.f / 128.f) + EPS);
#pragma unroll
            for (int d0 = 0; d0 < 4; ++d0) stg[c0r * 128 + d0 * 32] = (bf16)(cvtpk_s(v[d0] * rr * gs[d0], 0.f) & 0xffffu); }
        asm volatile("s_waitcnt lgkmcnt(0)" ::: "memory");
        bf16* Ow = OCAT + (rowbase + q0 + w4 * 32) * 1024 + 512 + h * 128;
        const LAS bf16* stg0 = (const LAS bf16*)(shm + DF_OST) + w4 * 4096;
#pragma unroll
        for (int i = 0; i < 8; ++i) { const int row = i * 4 + (lane_e >> 4), ch = lane_e & 15; const v4u v = *(const LAS v4u*)(stg0 + row * 128 + ch * 8); *(v4u*)(Ow + (long)row * 1024 + ch * 8) = v; }
    }
    ATT_LBAR();
}
}
}
namespace mk {
namespace att {
constexpr int MKH0 = 32 * 128, MKH1 = 32 * 64;
__device__ __forceinline__ void mla_step_a(f32x16* o, f32x16& S0, f32x16& S1, f32x16& T0, f32x16& T1, const bf16x8 pw0, const bf16x8 pw1, const bf16x8 pw2, const bf16x8 pw3, v4u& n0, v4u& n1, v4u& n2, v4u& n3, const bf16x8* qr, lds_cptr vp, lds_cptr ks, const int* kb, lds_cptr vpn, s16x4& f0l, s16x4& f0h, s16x4& f1l, s16x4& f1h, s16x4& f2l, s16x4& f2h, s16x4& f3l, s16x4& f3h, s16x4& f4l, s16x4& f4h, bf16x8& k0, bf16x8& k1, bf16x8& k2, bf16x8& k3, bf16x8& k4, float& sacc) {
    f4l = vtr(vp + 4096); f4h = vtr(vp + 4096 + 512);
    o[0] = __builtin_amdgcn_mfma_f32_32x32x16_bf16(pw0, ATT_PK2(f0l, f0h), o[0], 0, 0, 0);
    T0[0] = __builtin_amdgcn_exp2f(T0[0]);
    T0[1] = __builtin_amdgcn_exp2f(T0[1]);
    sacc += T0[0]; sacc += T0[1];
    asm volatile("" : "+v"(T0), "+v"(T1), "+v"(n0), "+v"(n1), "+v"(n2), "+v"(n3), "+v"(sacc)); ATT_SBAR();
    f0l = vtr(vp + 5120); f0h = vtr(vp + 5120 + 512);
    o[0] = __builtin_amdgcn_mfma_f32_32x32x16_bf16(pw1, ATT_PK2(f1l, f1h), o[0], 0, 0, 0);
    n0[0] = cvtpk_s(T0[0], T0[1]);
    T0[2] = __builtin_amdgcn_exp2f(T0[2]);
    T0[3] = __builtin_amdgcn_exp2f(T0[3]);
    asm volatile("" : "+v"(T0), "+v"(T1), "+v"(n0), "+v"(n1), "+v"(n2), "+v"(n3), "+v"(sacc)); ATT_SBAR();
    f1l = vtr(vp + 6144); f1h = vtr(vp + 6144 + 512);
    o[0] = __builtin_amdgcn_mfma_f32_32x32x16_bf16(pw2, ATT_PK2(f2l, f2h), o[0], 0, 0, 0);
    sacc += T0[2]; sacc += T0[3];
    n0[1] = cvtpk_s(T0[2], T0[3]);
    T0[4] = __builtin_amdgcn_exp2f(T0[4]);
    asm volatile("" : "+v"(T0), "+v"(T1), "+v"(n0), "+v"(n1), "+v"(n2), "+v"(n3), "+v"(sacc)); ATT_SBAR();
    f2l = vtr(vp + 7168); f2h = vtr(vp + 7168 + 512);
    o[0] = __builtin_amdgcn_mfma_f32_32x32x16_bf16(pw3, ATT_PK2(f3l, f3h), o[0], 0, 0, 0);
    T0[5] = __builtin_amdgcn_exp2f(T0[5]);
    sacc += T0[4]; sacc += T0[5];
    n0[2] = cvtpk_s(T0[4], T0[5]);
    asm volatile("" : "+v"(T0), "+v"(T1), "+v"(n0), "+v"(n1), "+v"(n2), "+v"(n3), "+v"(sacc)); ATT_SBAR();
    k0 = *(const LAS bf16x8*)(ks + kb[0] + 0 * MKH0);
    o[1] = __builtin_amdgcn_mfma_f32_32x32x16_bf16(pw0, ATT_PK2(f4l, f4h), o[1], 0, 0, 0);
    T0[6] = __builtin_amdgcn_exp2f(T0[6]);
    T0[7] = __builtin_amdgcn_exp2f(T0[7]);
    sacc += T0[6]; sacc += T0[7];
    asm volatile("" : "+v"(T0), "+v"(T1), "+v"(n0), "+v"(n1), "+v"(n2), "+v"(n3), "+v"(sacc)); ATT_SBAR();
    k1 = *(const LAS bf16x8*)(ks + kb[0] + 1 * MKH0);
    o[1] = __builtin_amdgcn_mfma_f32_32x32x16_bf16(pw1, ATT_PK2(f0l, f0h), o[1], 0, 0, 0);
    n0[3] = cvtpk_s(T0[6], T0[7]);
    T0[8] = __builtin_amdgcn_exp2f(T0[8]);
    T0[9] = __builtin_amdgcn_exp2f(T0[9]);
    asm volatile("" : "+v"(T0), "+v"(T1), "+v"(n0), "+v"(n1), "+v"(n2), "+v"(n3), "+v"(sacc)); ATT_SBAR();
    k2 = *(const LAS bf16x8*)(ks + kb[1] + 0 * MKH0);
    o[1] = __builtin_amdgcn_mfma_f32_32x32x16_bf16(pw2, ATT_PK2(f1l, f1h), o[1], 0, 0, 0);
    sacc += T0[8]; sacc += T0[9];
    n1[0] = cvtpk_s(T0[8], T0[9]);
    T0[10] = __builtin_amdgcn_exp2f(T0[10]);
    asm volatile("" : "+v"(T0), "+v"(T1), "+v"(n0), "+v"(n1), "+v"(n2), "+v"(n3), "+v"(sacc)); ATT_SBAR();
    k3 = *(const LAS bf16x8*)(ks + kb[1] + 1 * MKH0);
    o[1] = __builtin_amdgcn_mfma_f32_32x32x16_bf16(pw3, ATT_PK2(f2l, f2h), o[1], 0, 0, 0);
    T0[11] = __builtin_amdgcn_exp2f(T0[11]);
    sacc += T0[10]; sacc += T0[11];
    n1[1] = cvtpk_s(T0[10], T0[11]);
    asm volatile("" : "+v"(T0), "+v"(T1), "+v"(n0), "+v"(n1), "+v"(n2), "+v"(n3), "+v"(sacc)); ATT_SBAR();
    k4 = *(const LAS bf16x8*)(ks + kb[2] + 0 * MKH0);
    S0 = __builtin_amdgcn_mfma_f32_32x32x16_bf16(k0, qr[0], f32x16{}, 0, 0, 0);
    T0[12] = __builtin_amdgcn_exp2f(T0[12]);
    T0[13] = __builtin_amdgcn_exp2f(T0[13]);
    sacc += T0[12]; sacc += T0[13];
    asm volatile("" : "+v"(T0), "+v"(T1), "+v"(n0), "+v"(n1), "+v"(n2), "+v"(n3), "+v"(sacc)); ATT_SBAR();
    k0 = *(const LAS bf16x8*)(ks + kb[2] + 1 * MKH0);
    S1 = __builtin_amdgcn_mfma_f32_32x32x16_bf16(k1, qr[0], f32x16{}, 0, 0, 0);
    n1[2] = cvtpk_s(T0[12], T0[13]);
    T0[14] = __builtin_amdgcn_exp2f(T0[14]);
    T0[15] = __builtin_amdgcn_exp2f(T0[15]);
    asm volatile("" : "+v"(T0), "+v"(T1), "+v"(n0), "+v"(n1), "+v"(n2), "+v"(n3), "+v"(sacc)); ATT_SBAR();
}
__device__ __forceinline__ void mla_step_b(f32x16* o, f32x16& S0, f32x16& S1, f32x16& T0, f32x16& T1, const bf16x8 pw0, const bf16x8 pw1, const bf16x8 pw2, const bf16x8 pw3, v4u& n0, v4u& n1, v4u& n2, v4u& n3, const bf16x8* qr, lds_cptr vp, lds_cptr ks, const int* kb, lds_cptr vpn, s16x4& f0l, s16x4& f0h, s16x4& f1l, s16x4& f1h, s16x4& f2l, s16x4& f2h, s16x4& f3l, s16x4& f3h, s16x4& f4l, s16x4& f4h, bf16x8& k0, bf16x8& k1, bf16x8& k2, bf16x8& k3, bf16x8& k4, float& sacc) {
    k1 = *(const LAS bf16x8*)(ks + kb[3] + 0 * MKH0);
    S0 = __builtin_amdgcn_mfma_f32_32x32x16_bf16(k2, qr[1], S0, 0, 0, 0);
    sacc += T0[14]; sacc += T0[15];
    n1[3] = cvtpk_s(T0[14], T0[15]);
    T1[0] = __builtin_amdgcn_exp2f(T1[0]);
    asm volatile("" : "+v"(T0), "+v"(T1), "+v"(n0), "+v"(n1), "+v"(n2), "+v"(n3), "+v"(sacc)); ATT_SBAR();
    k2 = *(const LAS bf16x8*)(ks + kb[3] + 1 * MKH0);
    S1 = __builtin_amdgcn_mfma_f32_32x32x16_bf16(k3, qr[1], S1, 0, 0, 0);
    T1[1] = __builtin_amdgcn_exp2f(T1[1]);
    sacc += T1[0]; sacc += T1[1];
    n2[0] = cvtpk_s(T1[0], T1[1]);
    asm volatile("" : "+v"(T0), "+v"(T1), "+v"(n0), "+v"(n1), "+v"(n2), "+v"(n3), "+v"(sacc)); ATT_SBAR();
    k3 = *(const LAS bf16x8*)(ks + kb[4] + 0 * MKH1);
    S0 = __builtin_amdgcn_mfma_f32_32x32x16_bf16(k4, qr[2], S0, 0, 0, 0);
    T1[2] = __builtin_amdgcn_exp2f(T1[2]);
    T1[3] = __builtin_amdgcn_exp2f(T1[3]);
    sacc += T1[2]; sacc += T1[3];
    asm volatile("" : "+v"(T0), "+v"(T1), "+v"(n0), "+v"(n1), "+v"(n2), "+v"(n3), "+v"(sacc)); ATT_SBAR();
    k4 = *(const LAS bf16x8*)(ks + kb[4] + 1 * MKH1);
    S1 = __builtin_amdgcn_mfma_f32_32x32x16_bf16(k0, qr[2], S1, 0, 0, 0);
    n2[1] = cvtpk_s(T1[2], T1[3]);
    T1[4] = __builtin_amdgcn_exp2f(T1[4]);
    T1[5] = __builtin_amdgcn_exp2f(T1[5]);
    asm volatile("" : "+v"(T0), "+v"(T1), "+v"(n0), "+v"(n1), "+v"(n2), "+v"(n3), "+v"(sacc)); ATT_SBAR();
    k0 = *(const LAS bf16x8*)(ks + kb[5] + 0 * MKH1);
    S0 = __builtin_amdgcn_mfma_f32_32x32x16_bf16(k1, qr[3], S0, 0, 0, 0);
    sacc += T1[4]; sacc += T1[5];
    n2[2] = cvtpk_s(T1[4], T1[5]);
    T1[6] = __builtin_amdgcn_exp2f(T1[6]);
    asm volatile("" : "+v"(T0), "+v"(T1), "+v"(n0), "+v"(n1), "+v"(n2), "+v"(n3), "+v"(sacc)); ATT_SBAR();
    k1 = *(const LAS bf16x8*)(ks + kb[5] + 1 * MKH1);
    S1 = __builtin_amdgcn_mfma_f32_32x32x16_bf16(k2, qr[3], S1, 0, 0, 0);
    T1[7] = __builtin_amdgcn_exp2f(T1[7]);
    sacc += T1[6]; sacc += T1[7];
    n2[3] = cvtpk_s(T1[6], T1[7]);
    asm volatile("" : "+v"(T0), "+v"(T1), "+v"(n0), "+v"(n1), "+v"(n2), "+v"(n3), "+v"(sacc)); ATT_SBAR();
    f0l = vtr(vpn + 0); f0h = vtr(vpn + 0 + 512);
    S0 = __builtin_amdgcn_mfma_f32_32x32x16_bf16(k3, qr[4], S0, 0, 0, 0);
    T1[8] = __builtin_amdgcn_exp2f(T1[8]);
    T1[9] = __builtin_amdgcn_exp2f(T1[9]);
    sacc += T1[8]; sacc += T1[9];
    asm volatile("" : "+v"(T0), "+v"(T1), "+v"(n0), "+v"(n1), "+v"(n2), "+v"(n3), "+v"(sacc)); ATT_SBAR();
    f1l = vtr(vpn + 1024); f1h = vtr(vpn + 1024 + 512);
    S1 = __builtin_amdgcn_mfma_f32_32x32x16_bf16(k4, qr[4], S1, 0, 0, 0);
    n3[0] = cvtpk_s(T1[8], T1[9]);
    T1[10] = __builtin_amdgcn_exp2f(T1[10]);
    T1[11] = __builtin_amdgcn_exp2f(T1[11]);
    asm volatile("" : "+v"(T0), "+v"(T1), "+v"(n0), "+v"(n1), "+v"(n2), "+v"(n3), "+v"(sacc)); ATT_SBAR();
    f2l = vtr(vpn + 2048); f2h = vtr(vpn + 2048 + 512);
    S0 = __builtin_amdgcn_mfma_f32_32x32x16_bf16(k0, qr[5], S0, 0, 0, 0);
    sacc += T1[10]; sacc += T1[11];
    n3[1] = cvtpk_s(T1[10], T1[11]);
    T1[12] = __builtin_amdgcn_exp2f(T1[12]);
    asm volatile("" : "+v"(T0), "+v"(T1), "+v"(n0), "+v"(n1), "+v"(n2), "+v"(n3), "+v"(sacc)); ATT_SBAR();
    f3l = vtr(vpn + 3072); f3h = vtr(vpn + 3072 + 512);
    S1 = __builtin_amdgcn_mfma_f32_32x32x16_bf16(k1, qr[5], S1, 0, 0, 0);
    T1[13] = __builtin_amdgcn_exp2f(T1[13]);
    sacc += T1[12]; sacc += T1[13];
    n3[2] = cvtpk_s(T1[12], T1[13]);
    T1[14] = __builtin_amdgcn_exp2f(T1[14]);
    T1[15] = __builtin_amdgcn_exp2f(T1[15]);
    sacc += T1[14]; sacc += T1[15];
    n3[3] = cvtpk_s(T1[14], T1[15]);
    asm volatile("" : "+v"(T0), "+v"(T1), "+v"(n0), "+v"(n1), "+v"(n2), "+v"(n3), "+v"(sacc)); ATT_SBAR();
}

constexpr int DKH0 = 32 * 256;
__device__ __forceinline__ void diff_step_a(f32x16* o, f32x16& S0, f32x16& S1, f32x16& T0, f32x16& T1, const bf16x8 pw0, const bf16x8 pw1, const bf16x8 pw2, const bf16x8 pw3, v4u& n0, v4u& n1, v4u& n2, v4u& n3, const bf16x8* qr, lds_cptr vp, lds_cptr ks, const int* kb, lds_cptr vpn, s16x4& f0l, s16x4& f0h, s16x4& f1l, s16x4& f1h, s16x4& f2l, s16x4& f2h, bf16x8& k0, bf16x8& k1, bf16x8& k2, float& sacc, float sg, float cbase) {
    f2l = vtr(vp + 2048); f2h = vtr(vp + 2048 + 512);
    o[0] = __builtin_amdgcn_mfma_f32_32x32x16_bf16(pw0, ATT_PK2(f0l, f0h), o[0], 0, 0, 0);
    S0[0] = fmaf(sg, 0.0f, cbase);
    S1[0] = fmaf(sg, 32.0f, cbase);
    S0[1] = fmaf(sg, 1.0f, cbase);
    T0[0] = __builtin_amdgcn_exp2f(T0[0]);
    T0[1] = __builtin_amdgcn_exp2f(T0[1]);
    asm volatile("" : "+v"(T0), "+v"(T1), "+v"(n0), "+v"(n1), "+v"(n2), "+v"(n3), "+v"(sacc), "+v"(S0), "+v"(S1)); ATT_SBAR();
    f0l = vtr(vp + 3072); f0h = vtr(vp + 3072 + 512);
    o[0] = __builtin_amdgcn_mfma_f32_32x32x16_bf16(pw1, ATT_PK2(f1l, f1h), o[0], 0, 0, 0);
    S1[1] = fmaf(sg, 33.0f, cbase);
    S0[2] = fmaf(sg, 2.0f, cbase);
    sacc += T0[0]; sacc += T0[1];
    n0[0] = cvtpk_s(T0[0], T0[1]);
    T0[2] = __builtin_amdgcn_exp2f(T0[2]);
    asm volatile("" : "+v"(T0), "+v"(T1), "+v"(n0), "+v"(n1), "+v"(n2), "+v"(n3), "+v"(sacc), "+v"(S0), "+v"(S1)); ATT_SBAR();
    f1l = vtr(vp + 4096); f1h = vtr(vp + 4096 + 512);
    o[0] = __builtin_amdgcn_mfma_f32_32x32x16_bf16(pw2, ATT_PK2(f2l, f2h), o[0], 0, 0, 0);
    S1[2] = fmaf(sg, 34.0f, cbase);
    S0[3] = fmaf(sg, 3.0f, cbase);
    T0[3] = __builtin_amdgcn_exp2f(T0[3]);
    sacc += T0[2]; sacc += T0[3];
    asm volatile("" : "+v"(T0), "+v"(T1), "+v"(n0), "+v"(n1), "+v"(n2), "+v"(n3), "+v"(sacc), "+v"(S0), "+v"(S1)); ATT_SBAR();
    f2l = vtr(vp + 5120); f2h = vtr(vp + 5120 + 512);
    o[0] = __builtin_amdgcn_mfma_f32_32x32x16_bf16(pw3, ATT_PK2(f0l, f0h), o[0], 0, 0, 0);
    S1[3] = fmaf(sg, 35.0f, cbase);
    S0[4] = fmaf(sg, 8.0f, cbase);
    S1[4] = fmaf(sg, 40.0f, cbase);
    n0[1] = cvtpk_s(T0[2], T0[3]);
    T0[4] = __builtin_amdgcn_exp2f(T0[4]);
    asm volatile("" : "+v"(T0), "+v"(T1), "+v"(n0), "+v"(n1), "+v"(n2), "+v"(n3), "+v"(sacc), "+v"(S0), "+v"(S1)); ATT_SBAR();
    f0l = vtr(vp + 6144); f0h = vtr(vp + 6144 + 512);
    o[1] = __builtin_amdgcn_mfma_f32_32x32x16_bf16(pw0, ATT_PK2(f1l, f1h), o[1], 0, 0, 0);
    S0[5] = fmaf(sg, 9.0f, cbase);
    S1[5] = fmaf(sg, 41.0f, cbase);
    T0[5] = __builtin_amdgcn_exp2f(T0[5]);
    sacc += T0[4]; sacc += T0[5];
    asm volatile("" : "+v"(T0), "+v"(T1), "+v"(n0), "+v"(n1), "+v"(n2), "+v"(n3), "+v"(sacc), "+v"(S0), "+v"(S1)); ATT_SBAR();
    f1l = vtr(vp + 7168); f1h = vtr(vp + 7168 + 512);
    o[1] = __builtin_amdgcn_mfma_f32_32x32x16_bf16(pw1, ATT_PK2(f2l, f2h), o[1], 0, 0, 0);
    S0[6] = fmaf(sg, 10.0f, cbase);
    S1[6] = fmaf(sg, 42.0f, cbase);
    n0[2] = cvtpk_s(T0[4], T0[5]);
    T0[6] = __builtin_amdgcn_exp2f(T0[6]);
    T0[7] = __builtin_amdgcn_exp2f(T0[7]);
    asm volatile("" : "+v"(T0), "+v"(T1), "+v"(n0), "+v"(n1), "+v"(n2), "+v"(n3), "+v"(sacc), "+v"(S0), "+v"(S1)); ATT_SBAR();
    f2l = vtr(vp + 8192); f2h = vtr(vp + 8192 + 512);
    o[1] = __builtin_amdgcn_mfma_f32_32x32x16_bf16(pw2, ATT_PK2(f0l, f0h), o[1], 0, 0, 0);
    S0[7] = fmaf(sg, 11.0f, cbase);
    S1[7] = fmaf(sg, 43.0f, cbase);
    sacc += T0[6]; sacc += T0[7];
    n0[3] = cvtpk_s(T0[6], T0[7]);
    T0[8] = __builtin_amdgcn_exp2f(T0[8]);
    asm volatile("" : "+v"(T0), "+v"(T1), "+v"(n0), "+v"(n1), "+v"(n2), "+v"(n3), "+v"(sacc), "+v"(S0), "+v"(S1)); ATT_SBAR();
    f0l = vtr(vp + 9216); f0h = vtr(vp + 9216 + 512);
    o[1] = __builtin_amdgcn_mfma_f32_32x32x16_bf16(pw3, ATT_PK2(f1l, f1h), o[1], 0, 0, 0);
    S0[8] = fmaf(sg, 16.0f, cbase);
    S1[8] = fmaf(sg, 48.0f, cbase);
    S0[9] = fmaf(sg, 17.0f, cbase);
    T0[9] = __builtin_amdgcn_exp2f(T0[9]);
    sacc += T0[8]; sacc += T0[9];
    asm volatile("" : "+v"(T0), "+v"(T1), "+v"(n0), "+v"(n1), "+v"(n2), "+v"(n3), "+v"(sacc), "+v"(S0), "+v"(S1)); ATT_SBAR();
    f1l = vtr(vp + 10240); f1h = vtr(vp + 10240 + 512);
    o[2] = __builtin_amdgcn_mfma_f32_32x32x16_bf16(pw0, ATT_PK2(f2l, f2h), o[2], 0, 0, 0);
    S1[9] = fmaf(sg, 49.0f, cbase);
    S0[10] = fmaf(sg, 18.0f, cbase);
    n1[0] = cvtpk_s(T0[8], T0[9]);
    T0[10] = __builtin_amdgcn_exp2f(T0[10]);
    T0[11] = __builtin_amdgcn_exp2f(T0[11]);
    asm volatile("" : "+v"(T0), "+v"(T1), "+v"(n0), "+v"(n1), "+v"(n2), "+v"(n3), "+v"(sacc), "+v"(S0), "+v"(S1)); ATT_SBAR();
    f2l = vtr(vp + 11264); f2h = vtr(vp + 11264 + 512);
    o[2] = __builtin_amdgcn_mfma_f32_32x32x16_bf16(pw1, ATT_PK2(f0l, f0h), o[2], 0, 0, 0);
    S1[10] = fmaf(sg, 50.0f, cbase);
    S0[11] = fmaf(sg, 19.0f, cbase);
    sacc += T0[10]; sacc += T0[11];
    n1[1] = cvtpk_s(T0[10], T0[11]);
    T0[12] = __builtin_amdgcn_exp2f(T0[12]);
    asm volatile("" : "+v"(T0), "+v"(T1), "+v"(n0), "+v"(n1), "+v"(n2), "+v"(n3), "+v"(sacc), "+v"(S0), "+v"(S1)); ATT_SBAR();
}
__device__ __forceinline__ void diff_step_b(f32x16* o, f32x16& S0, f32x16& S1, f32x16& T0, f32x16& T1, const bf16x8 pw0, const bf16x8 pw1, const bf16x8 pw2, const bf16x8 pw3, v4u& n0, v4u& n1, v4u& n2, v4u& n3, const bf16x8* qr, lds_cptr vp, lds_cptr ks, const int* kb, lds_cptr vpn, s16x4& f0l, s16x4& f0h, s16x4& f1l, s16x4& f1h, s16x4& f2l, s16x4& f2h, bf16x8& k0, bf16x8& k1, bf16x8& k2, float& sacc, float sg, float cbase) {
    f0l = vtr(vp + 12288); f0h = vtr(vp + 12288 + 512);
    o[2] = __builtin_amdgcn_mfma_f32_32x32x16_bf16(pw2, ATT_PK2(f1l, f1h), o[2], 0, 0, 0);
    S1[11] = fmaf(sg, 51.0f, cbase);
    S0[12] = fmaf(sg, 24.0f, cbase);
    S1[12] = fmaf(sg, 56.0f, cbase);
    T0[13] = __builtin_amdgcn_exp2f(T0[13]);
    sacc += T0[12]; sacc += T0[13];
    asm volatile("" : "+v"(T0), "+v"(T1), "+v"(n0), "+v"(n1), "+v"(n2), "+v"(n3), "+v"(sacc), "+v"(S0), "+v"(S1)); ATT_SBAR();
    f1l = vtr(vp + 13312); f1h = vtr(vp + 13312 + 512);
    o[2] = __builtin_amdgcn_mfma_f32_32x32x16_bf16(pw3, ATT_PK2(f2l, f2h), o[2], 0, 0, 0);
    S0[13] = fmaf(sg, 25.0f, cbase);
    S1[13] = fmaf(sg, 57.0f, cbase);
    n1[2] = cvtpk_s(T0[12], T0[13]);
    T0[14] = __builtin_amdgcn_exp2f(T0[14]);
    T0[15] = __builtin_amdgcn_exp2f(T0[15]);
    asm volatile("" : "+v"(T0), "+v"(T1), "+v"(n0), "+v"(n1), "+v"(n2), "+v"(n3), "+v"(sacc), "+v"(S0), "+v"(S1)); ATT_SBAR();
    f2l = vtr(vp + 14336); f2h = vtr(vp + 14336 + 512);
    o[3] = __builtin_amdgcn_mfma_f32_32x32x16_bf16(pw0, ATT_PK2(f0l, f0h), o[3], 0, 0, 0);
    S0[14] = fmaf(sg, 26.0f, cbase);
    S1[14] = fmaf(sg, 58.0f, cbase);
    sacc += T0[14]; sacc += T0[15];
    n1[3] = cvtpk_s(T0[14], T0[15]);
    T1[0] = __builtin_amdgcn_exp2f(T1[0]);
    asm volatile("" : "+v"(T0), "+v"(T1), "+v"(n0), "+v"(n1), "+v"(n2), "+v"(n3), "+v"(sacc), "+v"(S0), "+v"(S1)); ATT_SBAR();
    f0l = vtr(vp + 15360); f0h = vtr(vp + 15360 + 512);
    o[3] = __builtin_amdgcn_mfma_f32_32x32x16_bf16(pw1, ATT_PK2(f1l, f1h), o[3], 0, 0, 0);
    S0[15] = fmaf(sg, 27.0f, cbase);
    S1[15] = fmaf(sg, 59.0f, cbase);
    T1[1] = __builtin_amdgcn_exp2f(T1[1]);
    sacc += T1[0]; sacc += T1[1];
    asm volatile("" : "+v"(T0), "+v"(T1), "+v"(n0), "+v"(n1), "+v"(n2), "+v"(n3), "+v"(sacc), "+v"(S0), "+v"(S1)); ATT_SBAR();
    k0 = *(const LAS bf16x8*)(ks + kb[0] + 0 * DKH0);
    o[3] = __builtin_amdgcn_mfma_f32_32x32x16_bf16(pw2, ATT_PK2(f2l, f2h), o[3], 0, 0, 0);
    n2[0] = cvtpk_s(T1[0], T1[1]);
    T1[2] = __builtin_amdgcn_exp2f(T1[2]);
    T1[3] = __builtin_amdgcn_exp2f(T1[3]);
    sacc += T1[2]; sacc += T1[3];
    asm volatile("" : "+v"(T0), "+v"(T1), "+v"(n0), "+v"(n1), "+v"(n2), "+v"(n3), "+v"(sacc), "+v"(S0), "+v"(S1)); ATT_SBAR();
    k1 = *(const LAS bf16x8*)(ks + kb[0] + 1 * DKH0);
    o[3] = __builtin_amdgcn_mfma_f32_32x32x16_bf16(pw3, ATT_PK2(f0l, f0h), o[3], 0, 0, 0);
    n2[1] = cvtpk_s(T1[2], T1[3]);
    T1[4] = __builtin_amdgcn_exp2f(T1[4]);
    T1[5] = __builtin_amdgcn_exp2f(T1[5]);
    sacc += T1[4]; sacc += T1[5];
    asm volatile("" : "+v"(T0), "+v"(T1), "+v"(n0), "+v"(n1), "+v"(n2), "+v"(n3), "+v"(sacc)); ATT_SBAR();
    k2 = *(const LAS bf16x8*)(ks + kb[1] + 0 * DKH0);
    S0 = __builtin_amdgcn_mfma_f32_32x32x16_bf16(k0, qr[0], S0, 0, 0, 0);
    n2[2] = cvtpk_s(T1[4], T1[5]);
    T1[6] = __builtin_amdgcn_exp2f(T1[6]);
    T1[7] = __builtin_amdgcn_exp2f(T1[7]);
    sacc += T1[6]; sacc += T1[7];
    asm volatile("" : "+v"(T0), "+v"(T1), "+v"(n0), "+v"(n1), "+v"(n2), "+v"(n3), "+v"(sacc)); ATT_SBAR();
    k0 = *(const LAS bf16x8*)(ks + kb[1] + 1 * DKH0);
    S1 = __builtin_amdgcn_mfma_f32_32x32x16_bf16(k1, qr[0], S1, 0, 0, 0);
    n2[3] = cvtpk_s(T1[6], T1[7]);
    T1[8] = __builtin_amdgcn_exp2f(T1[8]);
    T1[9] = __builtin_amdgcn_exp2f(T1[9]);
    sacc += T1[8]; sacc += T1[9];
    asm volatile("" : "+v"(T0), "+v"(T1), "+v"(n0), "+v"(n1), "+v"(n2), "+v"(n3), "+v"(sacc)); ATT_SBAR();
    k1 = *(const LAS bf16x8*)(ks + kb[2] + 0 * DKH0);
    S0 = __builtin_amdgcn_mfma_f32_32x32x16_bf16(k2, qr[1], S0, 0, 0, 0);
    n3[0] = cvtpk_s(T1[8], T1[9]);
    T1[10] = __builtin_amdgcn_exp2f(T1[10]);
    T1[11] = __builtin_amdgcn_exp2f(T1[11]);
    sacc += T1[10]; sacc += T1[11];
    asm volatile("" : "+v"(T0), "+v"(T1), "+v"(n0), "+v"(n1), "+v"(n2), "+v"(n3), "+v"(sacc)); ATT_SBAR();
    k2 = *(const LAS bf16x8*)(ks + kb[2] + 1 * DKH0);
    S1 = __builtin_amdgcn_mfma_f32_32x32x16_bf16(k0, qr[1], S1, 0, 0, 0);
    n3[1] = cvtpk_s(T1[10], T1[11]);
    T1[12] = __builtin_amdgcn_exp2f(T1[12]);
    T1[13] = __builtin_amdgcn_exp2f(T1[13]);
    sacc += T1[12]; sacc += T1[13];
    asm volatile("" : "+v"(T0), "+v"(T1), "+v"(n0), "+v"(n1), "+v"(n2), "+v"(n3), "+v"(sacc)); ATT_SBAR();
    k0 = *(const LAS bf16x8*)(ks + kb[3] + 0 * DKH0);
    S0 = __builtin_amdgcn_mfma_f32_32x32x16_bf16(k1, qr[2], S0, 0, 0, 0);
    n3[2] = cvtpk_s(T1[12], T1[13]);
    T1[14] = __builtin_amdgcn_exp2f(T1[14]);
    T1[15] = __builtin_amdgcn_exp2f(T1[15]);
    sacc += T1[14]; sacc += T1[15];
    asm volatile("" : "+v"(T0), "+v"(T1), "+v"(n0), "+v"(n1), "+v"(n2), "+v"(n3), "+v"(sacc)); ATT_SBAR();
    k1 = *(const LAS bf16x8*)(ks + kb[3] + 1 * DKH0);
    S1 = __builtin_amdgcn_mfma_f32_32x32x16_bf16(k2, qr[2], S1, 0, 0, 0);
    n3[3] = cvtpk_s(T1[14], T1[15]);
    asm volatile("" : "+v"(T0), "+v"(T1), "+v"(n0), "+v"(n1), "+v"(n2), "+v"(n3), "+v"(sacc)); ATT_SBAR();
    f0l = vtr(vpn + 0); f0h = vtr(vpn + 0 + 512);
    S0 = __builtin_amdgcn_mfma_f32_32x32x16_bf16(k0, qr[3], S0, 0, 0, 0);
    asm volatile("" : "+v"(T0), "+v"(T1), "+v"(n0), "+v"(n1), "+v"(n2), "+v"(n3), "+v"(sacc)); ATT_SBAR();
    f1l = vtr(vpn + 1024); f1h = vtr(vpn + 1024 + 512);
    S1 = __builtin_amdgcn_mfma_f32_32x32x16_bf16(k1, qr[3], S1, 0, 0, 0);
    asm volatile("" : "+v"(T0), "+v"(T1), "+v"(n0), "+v"(n1), "+v"(n2), "+v"(n3), "+v"(sacc)); ATT_SBAR();
}
}
}
namespace mk {
namespace att {
#define ATT_NXT(x, n, sz) (((x) == ((n) - 1) * (sz)) ? 0 : (x) + (sz))
#define ATT_BC(x) __builtin_bit_cast(bf16x8, x)

constexpr int M4_KB = 12 * 1024, M4_VB = 8 * 1024, M4_NK = 4, M4_NV = 6, M4_VOFF = M4_NK * M4_KB, M4_OST = 0;
__device__ __forceinline__ void mla_unit4(int b, int h, int qb, const bf16* QM, const bf16* KVM, const bf16* KROT, bf16* OCAT, LAS char* shm) {
    const int tid = threadIdx.x, lane = tid & 63, r32 = lane & 31, hi = lane >> 5; const int wid = __builtin_amdgcn_readfirstlane(tid >> 6);
    const bool w03 = wid < 4;
    const long rowbase = (long)b * SEQ; const int q0 = qb * 256;
    const unsigned lds0 = (unsigned)(uintptr_t)shm;
    LAS float* wsf = (LAS float*)(shm + ATT_WS_OFF) + wid * 64;
    bf16x8 qr[6];
    { const bf16* Qw = QM + (rowbase + q0 + wid * 32 + r32) * 768 + h * 96 + hi * 8;
#pragma unroll
      for (int d0 = 0; d0 < 6; ++d0) qr[d0] = *(const bf16x8*)(Qw + d0 * 16); }
    const char* kvbase = (const char*)(KVM + rowbase * 1024 + h * 128); const char* krbase = (const char*)(KROT + rowbase * 32);
    const int kr8 = 8 * wid + (lane >> 3), kr16 = 16 * (wid & 3) + (lane >> 2);
    const unsigned koffA = (unsigned)(kr8 * 2048 + (((lane & 7) ^ ((kr8 >> 1) & 7)) << 4));
    const unsigned koffB = (unsigned)(kr16 * 64 + (((lane & 3) ^ ((kr16 >> 2) & 3)) << 4));
    const unsigned voffs = (unsigned)((16 * (wid & 3) + (lane >> 2)) * 1024 + 64 + (wid >> 2) * 32 + (lane & 3) * 8) * 2u;
#define M4_DMA(t, kd_, vd_) do { const char* kvt_ = uptr(kvbase + (size_t)(t) * (64 * 1024 * 2)); \
        glds16s(kvt_, koffA, (unsigned)__builtin_amdgcn_readfirstlane(lds0 + (kd_) + wid * 1024)); \
        if (w03) glds16s(uptr(krbase + (size_t)(t) * (64 * 32 * 2)), koffB, (unsigned)__builtin_amdgcn_readfirstlane(lds0 + (kd_) + (8 + wid) * 1024)); \
        glds16s(kvt_, voffs, (unsigned)__builtin_amdgcn_readfirstlane(lds0 + M4_VOFF + (vd_) + wid * 1024)); } while (0)
    const int vofs = M4_VOFF + ((lane >> 4) & 1) * 32 + (lane & 3) * 8 + (4 * hi + ((lane & 15) >> 2)) * 64;
    int kb[6];
#pragma unroll
    for (int d0 = 0; d0 < 4; ++d0) kb[d0] = r32 * 128 + (((2 * d0 + hi) ^ ((r32 >> 1) & 7)) << 4);
#pragma unroll
    for (int d0 = 4; d0 < 6; ++d0) kb[d0] = 8192 + r32 * 64 + (((2 * (d0 - 4) + hi) ^ ((r32 >> 2) & 3)) << 4);
    float l_reg = 0.f; f32x16 o[2]; o[0] = f32x16{}; o[1] = f32x16{};
    f32x16 SA0, SA1, SB0, SB1; v4u wA0 = {0u, 0u, 0u, 0u}, wA1 = wA0, wA2 = wA0, wA3 = wA0, wB0 = wA0, wB1 = wA0, wB2 = wA0, wB3 = wA0;
    s16x4 f0l, f0h, f1l, f1h, f2l, f2h, f3l, f3h, f4l, f4h; bf16x8 k0, k1, k2, k3, k4;
    constexpr int NT = SEQ / 64;
#define M4_BAR(t) do { if ((t) + 3 < NT) { if (w03) ATT_WAIT_BARN(6); else ATT_WAIT_BARN(4); } else ATT_WAIT_BAR0(); } while (0)
#define M4_ARGS(S, T, W, N) o, S##0, S##1, T##0, T##1, ATT_BC(W##0), ATT_BC(W##1), ATT_BC(W##2), ATT_BC(W##3), N##0, N##1, N##2, N##3, qr, \
                 (lds_cptr)shm + vsm1 + vofs, (lds_cptr)shm + ks1, kb, (lds_cptr)shm + vs0 + vofs, f0l, f0h, f1l, f1h, f2l, f2h, f3l, f3h, f4l, f4h, k0, k1, k2, k3, k4, l_reg
#define M4_STEP(t, S, T, W, N) do { M4_BAR(t); \
        mla_step_a(M4_ARGS(S, T, W, N)); \
        if ((t) + 4 < NT) M4_DMA((t) + 4, kd, vd);               \
        mla_step_b(M4_ARGS(S, T, W, N)); \
        vsm1 = vs0; vs0 = ATT_NXT(vs0, M4_NV, M4_VB); ks1 = ATT_NXT(ks1, M4_NK, M4_KB); kd = ATT_NXT(kd, M4_NK, M4_KB); vd = ATT_NXT(vd, M4_NV, M4_VB); } while (0)
    M4_DMA(0, 0, 0); M4_DMA(1, M4_KB, M4_VB); M4_DMA(2, 2 * M4_KB, 2 * M4_VB); M4_DMA(3, 3 * M4_KB, 3 * M4_VB);
    if (w03) ATT_WAIT_BARN(9); else ATT_WAIT_BARN(6);
    { SA0 = f32x16{}; SA1 = f32x16{};
#pragma unroll
      for (int d0 = 0; d0 < 6; ++d0) { const lds_cptr kp_ = (lds_cptr)shm + kb[d0]; const int kh_ = d0 < 4 ? 32 * 128 : 32 * 64;
          SA0 = __builtin_amdgcn_mfma_f32_32x32x16_bf16(*(const LAS bf16x8*)kp_, qr[d0], SA0, 0, 0, 0); SA1 = __builtin_amdgcn_mfma_f32_32x32x16_bf16(*(const LAS bf16x8*)(kp_ + kh_), qr[d0], SA1, 0, 0, 0); } }
    { const lds_cptr vp_ = (lds_cptr)shm + vofs; f0l = vtr(vp_); f0h = vtr(vp_ + 512); f1l = vtr(vp_ + 1024); f1h = vtr(vp_ + 1024 + 512); f2l = vtr(vp_ + 2048); f2h = vtr(vp_ + 2048 + 512); f3l = vtr(vp_ + 3072); f3h = vtr(vp_ + 3072 + 512); }
    int ks1 = M4_KB, vsm1 = 0, vs0 = 0, kd = 0, vd = 4 * M4_VB;
    for (int t = 0; t < NT; t += 2) {
        M4_STEP(t, SB, SA, wB, wA);
        M4_STEP(t + 1, SA, SB, wA, wB);
    }
    ATT_LBAR();
    pv<2>(o, (lds_cptr)shm + vsm1 + vofs, ATT_BC(wB0), ATT_BC(wB1), ATT_BC(wB2), ATT_BC(wB3));
    ATT_LBAR();
#undef M4_DMA
#undef M4_BAR
#undef M4_STEP
#undef M4_ARGS
    int lane_e = lane; asm volatile("" : "+v"(lane_e)); const int r32e = lane_e & 31, hie = lane_e >> 5;
    { auto rr = __builtin_amdgcn_permlane32_swap(__float_as_uint(l_reg), __float_as_uint(l_reg), false, false); l_reg = __uint_as_float(rr[0]) + __uint_as_float(rr[1]); }
    if (hie == 0) wsf[32 + r32e] = l_reg;
    asm volatile("s_waitcnt lgkmcnt(0)" ::: "memory");
    float rli[16];
#pragma unroll
    for (int r = 0; r < 16; ++r) rli[r] = __builtin_amdgcn_rcpf((wsf + 32 + 4 * hie)[(r & 3) + 8 * (r >> 2)]);
    bf16* Ow = OCAT + (rowbase + q0 + wid * 32) * 1024 + h * 64;
    { LAS bf16* stg = (LAS bf16*)(shm + M4_OST) + wid * 2048;
#pragma unroll
      for (int r = 0; r < 16; ++r) { const int orow = crow(r, hie);
#pragma unroll
          for (int d0 = 0; d0 < 2; ++d0) stg[orow * 64 + d0 * 32 + r32e] = (bf16)(cvtpk_s(o[d0][r] * rli[r], 0.f) & 0xffffu); }
      asm volatile("s_waitcnt lgkmcnt(0)" ::: "memory");
#pragma unroll
      for (int i = 0; i < 4; ++i) { const int row = i * 8 + (lane_e >> 3), ch = lane_e & 7; const v4u v = *(const LAS v4u*)(stg + row * 64 + ch * 8); *(v4u*)(Ow + (long)row * 1024 + ch * 8) = v; } }
    ATT_LBAR();
}

constexpr int D4_KB = 16 * 1024, D4_VB = 16 * 1024, D4_NK = 3, D4_NV = 5, D4_VOFF = D4_NK * D4_KB, D4_X = 0, D4_OST = 65536;
__device__ __forceinline__ void diff_unit4(int b, int h, int qb, int t_lo, int NT, const bf16* QD, const bf16* KD, const bf16* VD, bf16* OCAT, float lam, const float* gsub, LAS char* shm) {
    const int tid = threadIdx.x, lane = tid & 63, r32 = lane & 31, hi = lane >> 5; const int wid = __builtin_amdgcn_readfirstlane(tid >> 6);
    const int w4 = wid & 3, mp = wid >> 2;
    const long rowbase = (long)b * SEQ; const int q0 = qb * 128;
    const unsigned lds0 = (unsigned)(uintptr_t)shm;
    LAS float* wsf = (LAS float*)(shm + ATT_WS_OFF) + wid * 64;
    bf16x8 qr[4];
    { const bf16* Qw = QD + (rowbase + q0 + w4 * 32 + r32) * 512 + h * 128 + mp * 64 + hi * 8;
#pragma unroll
      for (int d0 = 0; d0 < 4; ++d0) qr[d0] = *(const bf16x8*)(Qw + d0 * 16); }
    const char* kbase = (const char*)(KD + rowbase * 512 + h * 128); const char* vbase = (const char*)(VD + rowbase * 512 + h * 128);
    const int kr4 = 4 * wid + (lane >> 4);
    const unsigned koffs = (unsigned)(kr4 * 1024 + (((lane & 15) ^ (kr4 & 15)) << 4));
    const unsigned voffs = (unsigned)((16 * (wid & 3) + (lane >> 2)) * 512 + (wid >> 2) * 32 + (lane & 3) * 8) * 2u;
#define D4_DMA(t, kd_, vd_) do { const char* kt_ = uptr(kbase + (size_t)(t) * (64 * 512 * 2)); const char* vt_ = uptr(vbase + (size_t)(t) * (64 * 512 * 2)); \
        glds16s(kt_, koffs, (unsigned)__builtin_amdgcn_readfirstlane(lds0 + (kd_) + wid * 1024)); \
        glds16s(kt_ + 32 * 1024, koffs, (unsigned)__builtin_amdgcn_readfirstlane(lds0 + (kd_) + (8 + wid) * 1024)); \
        glds16s(vt_, voffs, (unsigned)__builtin_amdgcn_readfirstlane(lds0 + D4_VOFF + (vd_) + wid * 1024)); \
        glds16s(vt_ + 128, voffs, (unsigned)__builtin_amdgcn_readfirstlane(lds0 + D4_VOFF + (vd_) + (8 + wid) * 1024)); } while (0)
    const int vofs = D4_VOFF + ((lane >> 4) & 1) * 32 + (lane & 3) * 8 + (4 * hi + ((lane & 15) >> 2)) * 64;
    int kb[4];
#pragma unroll
    for (int d0 = 0; d0 < 4; ++d0) kb[d0] = r32 * 256 + (((8 * mp + 2 * d0 + hi) ^ (r32 & 15)) << 4);
    const float sl2 = __builtin_amdgcn_exp2f(-2.f * (float)(h + 1)) * LOG2E;
    const int qpos = q0 + w4 * 32 + r32;
    const int t_d = (q0 + w4 * 32) >> 6;
    float l_reg = 0.f; f32x16 o[4]; o[0] = f32x16{}; o[1] = f32x16{}; o[2] = f32x16{}; o[3] = f32x16{};
    f32x16 SA0, SA1, SB0, SB1; v4u wA0 = {0u, 0u, 0u, 0u}, wA1 = wA0, wA2 = wA0, wA3 = wA0, wB0 = wA0, wB1 = wA0, wB2 = wA0, wB3 = wA0;
    s16x4 f0l, f0h, f1l, f1h, f2l, f2h; bf16x8 k0, k1, k2;
#define D4_DIAG(T, S0, S1) do { if ((T) == t_d) { int x0_ = (T) * 64 + 4 * hi - qpos; asm volatile("" : "+v"(x0_)); \
        _Pragma("unroll") for (int r = 0; r < 16; ++r) { const int x = x0_ + ((r & 3) + 8 * (r >> 2)); S0[r] -= 2.f * sl2 * fmaxf((float)x, 0.f); S1[r] -= 2.f * sl2 * fmaxf((float)(x + 32), 0.f); } } } while (0)
#define D4_BAR(t) do { if ((t) + 2 < NT) ATT_WAIT_BARN(4); else ATT_WAIT_BAR0(); } while (0)
#define D4_ARGS(S, T, W, N) o, S##0, S##1, T##0, T##1, ATT_BC(W##0), ATT_BC(W##1), ATT_BC(W##2), ATT_BC(W##3), N##0, N##1, N##2, N##3, qr, \
                    (lds_cptr)shm + vsm1 + vofs, (lds_cptr)shm + ks1, kb, (lds_cptr)shm + vs0 + vofs, f0l, f0h, f1l, f1h, f2l, f2h, k0, k1, k2, l_reg, sg_, cb_
#define D4_STEP(t, S, T, W, N) do { D4_BAR(t); \
        { const int T1_ = t_lo + (t) + 1; float sg_ = T1_ <= t_d ? sl2 : -sl2; asm volatile("" : "+v"(sg_)); const float cb_ = sg_ * (float)(T1_ * 64 + 4 * hi - qpos); \
          diff_step_a(D4_ARGS(S, T, W, N)); \
          if ((t) + 3 < NT) D4_DMA(t_lo + (t) + 3, kd, vd); \
          diff_step_b(D4_ARGS(S, T, W, N)); \
          D4_DIAG(T1_, S##0, S##1); } \
        vsm1 = vs0; vs0 = ATT_NXT(vs0, D4_NV, D4_VB); ks1 = ATT_NXT(ks1, D4_NK, D4_KB); kd = ATT_NXT(kd, D4_NK, D4_KB); vd = ATT_NXT(vd, D4_NV, D4_VB); } while (0)
    D4_DMA(t_lo, 0, 0); D4_DMA(t_lo + 1, D4_KB, D4_VB); D4_DMA(t_lo + 2, 2 * D4_KB, 2 * D4_VB);
    ATT_WAIT_BARN(8);
    { f32x16 c0_, c1_; const float sg_ = t_lo <= t_d ? sl2 : -sl2; const float cb_ = sg_ * (float)(t_lo * 64 + 4 * hi - qpos);
#pragma unroll
      for (int r = 0; r < 16; ++r) { c0_[r] = fmaf(sg_, (float)((r & 3) + 8 * (r >> 2)), cb_); c1_[r] = c0_[r] + 32.f * sg_; }
      SA0 = c0_; SA1 = c1_;
#pragma unroll
      for (int d0 = 0; d0 < 4; ++d0) { const lds_cptr kp_ = (lds_cptr)shm + kb[d0];
          SA0 = __builtin_amdgcn_mfma_f32_32x32x16_bf16(*(const LAS bf16x8*)kp_, qr[d0], SA0, 0, 0, 0); SA1 = __builtin_amdgcn_mfma_f32_32x32x16_bf16(*(const LAS bf16x8*)(kp_ + 32 * 256), qr[d0], SA1, 0, 0, 0); }
      D4_DIAG(t_lo, SA0, SA1); }
    { const lds_cptr vp_ = (lds_cptr)shm + vofs; f0l = vtr(vp_); f0h = vtr(vp_ + 512); f1l = vtr(vp_ + 1024); f1h = vtr(vp_ + 1024 + 512); }
    int ks1 = D4_KB, vsm1 = 0, vs0 = 0, kd = 0, vd = 3 * D4_VB;
    for (int t = 0; t < NT; t += 2) {
        D4_STEP(t, SB, SA, wB, wA);
        D4_STEP(t + 1, SA, SB, wA, wB);
    }
    ATT_LBAR();
    pv<4>(o, (lds_cptr)shm + vsm1 + vofs, ATT_BC(wB0), ATT_BC(wB1), ATT_BC(wB2), ATT_BC(wB3));
#undef D4_DMA
#undef D4_DIAG
#undef D4_BAR
#undef D4_STEP
#undef D4_ARGS
    int lane_e = lane; asm volatile("" : "+v"(lane_e)); const int r32e = lane_e & 31, hie = lane_e >> 5;
    { auto rr = __builtin_amdgcn_permlane32_swap(__float_as_uint(l_reg), __float_as_uint(l_reg), false, false); l_reg = __uint_as_float(rr[0]) + __uint_as_float(rr[1]); }
    if (hie == 0) wsf[32 + r32e] = l_reg;
    asm volatile("s_waitcnt lgkmcnt(0)" ::: "memory");
#pragma unroll
    for (int r = 0; r < 16; ++r) { const float rl_ = __builtin_amdgcn_rcpf((wsf + 32 + 4 * hie)[(r & 3) + 8 * (r >> 2)]) * (mp == 1 ? lam : 1.f);
#pragma unroll
        for (int d0 = 0; d0 < 4; ++d0) o[d0][r] *= rl_; }
    ATT_LBAR();
    LAS float* X = (LAS float*)(shm + D4_X);
    if (mp == 1) {
#pragma unroll
        for (int r = 0; r < 16; ++r) { LAS float* xr = X + (w4 * 32 + 4 * hie) * 128 + r32e;
#pragma unroll
            for (int d0 = 0; d0 < 4; ++d0) xr[((r & 3) + 8 * (r >> 2)) * 128 + d0 * 32] = o[d0][r]; }
    }
    ATT_LBAR();
    if (mp == 0) {
        float gs[4];
#pragma unroll
        for (int d0 = 0; d0 < 4; ++d0) gs[d0] = gsub[d0 * 32 + r32e] * 0.8f;
        LAS bf16* stg = (LAS bf16*)(shm + D4_OST) + w4 * 4096 + 4 * hie * 128 + r32e;
        const LAS float* xr = X + (w4 * 32 + 4 * hie) * 128 + r32e;
#pragma unroll
        for (int r = 0; r < 16; ++r) { const int c0r = (r & 3) + 8 * (r >> 2); float v[4]; float ss = 0.f;
#pragma unroll
            for (int d0 = 0; d0 < 4; ++d0) { v[d0] = o[d0][r] - xr[c0r * 128 + d0 * 32]; ss += v[d0] * v[d0]; }
            ss += __int_as_float(__builtin_amdgcn_ds_swizzle(__float_as_int(ss), 0x041F)); ss += __int_as_float(__builtin_amdgcn_ds_swizzle(__float_as_int(ss), 0x081F));
            ss += __int_as_float(__builtin_amdgcn_ds_swizzle(__float_as_int(ss), 0x101F)); ss += __int_as_float(__builtin_amdgcn_ds_swizzle(__float_as_int(ss), 0x201F));
            ss += __int_as_float(__builtin_amdgcn_ds_swizzle(__float_as_int(ss), 0x401F));
            const float rr = __builtin_amdgcn_rsqf(ss * (1.f / 128.f) + EPS);
#pragma unroll
            for (int d0 = 0; d0 < 4; ++d0) stg[c0r * 128 + d0 * 32] = (bf16)(cvtpk_s(v[d0] * rr * gs[d0], 0.f) & 0xffffu); }
        asm volatile("s_waitcnt lgkmcnt(0)" ::: "memory");
        bf16* Ow = OCAT + (rowbase + q0 + w4 * 32) * 1024 + 512 + h * 128;
        const LAS bf16* stg0 = (const LAS bf16*)(shm + D4_OST) + w4 * 4096;
#pragma unroll
        for (int i = 0; i < 8; ++i) { const int row = i * 4 + (lane_e >> 4), ch = lane_e & 15; const v4u v = *(const LAS v4u*)(stg0 + row * 128 + ch * 8); *(v4u*)(Ow + (long)row * 1024 + ch * 8) = v; }
    }
    ATT_LBAR();
}
#undef ATT_NXT
#undef ATT_BC
}
}
namespace mk {
namespace pg8 {
__device__ __forceinline__ v4u pack8(const f32x4 a, const f32x4 b, float s) { v4u w; w.x = cvt_pk_bf16(a[0] * s, a[1] * s); w.y = cvt_pk_bf16(a[2] * s, a[3] * s); w.z = cvt_pk_bf16(b[0] * s, b[1] * s); w.w = cvt_pk_bf16(b[2] * s, b[3] * s); return w; }
__device__ __forceinline__ float sq4(const f32x4 a) { return (a[0] * a[0] + a[1] * a[1]) + (a[2] * a[2] + a[3] * a[3]); }
__device__ __forceinline__ float fq_sum(float s) { s += __shfl_xor(s, 16); s += __shfl_xor(s, 32); return s; }
__device__ __forceinline__ void rope32(f32x4& x0, f32x4& x1, const float* g32, const float2* tabrow, int fq, float osc) {
    const float ms = fq_sum(sq4(x0) + sq4(x1)) * (1.f / 32.f);
    const float r = __builtin_amdgcn_rsqf(ms + EPS);
    const f32x4 g0 = *(const f32x4*)(g32 + 4 * fq), g1 = *(const f32x4*)(g32 + 16 + 4 * fq);
    const f32x4 t0 = *(const f32x4*)(tabrow + 4 * fq), t1 = *(const f32x4*)(tabrow + 4 * fq + 2);
    const float cs[4] = {t0[0], t0[2], t1[0], t1[2]}, sn[4] = {t0[1], t0[3], t1[1], t1[3]};
#pragma unroll
    for (int i = 0; i < 4; ++i) { const float a = x0[i] * r * g0[i], b = x1[i] * r * g1[i]; x0[i] = (a * cs[i] - b * sn[i]) * osc; x1[i] = (b * cs[i] + a * sn[i]) * osc; }
}
__device__ __forceinline__ void store_rope(bf16* dst, const f32x4 x0, const f32x4 x1, int fq) {
    v2u a; a.x = cvt_pk_bf16(x0[0], x0[1]); a.y = cvt_pk_bf16(x0[2], x0[3]); *(v2u*)(dst + 4 * fq) = a;
    v2u b; b.x = cvt_pk_bf16(x1[0], x1[1]); b.y = cvt_pk_bf16(x1[2], x1[3]); *(v2u*)(dst + 16 + 4 * fq) = b;
}

struct EpiWin {
    static constexpr bool PERM = true, AFTER_DRAIN = false, PRE = false;
    unsigned char* ws;
    __device__ __forceinline__ void operator()(const Acc& acc, const Unit& u, int wr, int wc, int fr, int fq) const {
        asm volatile("" : "+v"(fr), "+v"(fq));
        const float* ssq = (const float*)(ws + WS_S1); bf16* LATP = (bf16*)(ws + WS_LATP); float* QSS = (float*)(ws + WS_QSS); float* KSS = (float*)(ws + WS_KSS); bf16* KROT = (bf16*)(ws + WS_KROT);
        bf16* QD = (bf16*)(ws + WS_QD); bf16* KD = (bf16*)(ws + WS_KD); bf16* VD = (bf16*)(ws + WS_VD); const float2* tab = (const float2*)(ws + WS_TAB);
        const float* gdq = kin(I_GDQ); const float* gdk = kin(I_GDK); const float* gkr = kin(I_GMLAK) + 64;
        const int row0 = u.pm * BM + wr * 64 + fr, pn = u.pn;
        f32x4 g00 = {1.f, 1.f, 1.f, 1.f}, g01 = g00, g10 = g00, g11 = g00;
        if (pn >= 2 && pn < 6) { const float* g = (pn < 4 ? gdq : gdk) + 8 * fq; g00 = *(const f32x4*)g; g01 = *(const f32x4*)(g + 4); g10 = *(const f32x4*)(g + 32); g11 = *(const f32x4*)(g + 36); }
#pragma unroll
        for (int ai = 0; ai < 2; ++ai)
#pragma unroll
            for (int m = 0; m < 4; ++m) { const int row = row0 + ai * HALF + m * 16; const float r1 = rstd4(ssq, row, 1.f / DM);
                const f32x4 a00 = acc[ai][0][m][0] * r1, a01 = acc[ai][0][m][1] * r1, a10 = acc[ai][1][m][0] * r1, a11 = acc[ai][1][m][1] * r1;
                if (pn == 0) {
                    const float s = fq_sum((sq4(a00) + sq4(a01)) + (sq4(a10) + sq4(a11)));
                    if (fq == 0) QSS[(size_t)row * 4 + wc] = s;
                    bf16* d = LATP + (size_t)row * 768 + wc * 32 + 8 * fq;
                    *(v4u*)d = pack8(a00, a01, 1.f); *(v4u*)(d + HALF) = pack8(a10, a11, 1.f);
                } else if (pn == 1) {
                    const float s = fq_sum(sq4(a00) + sq4(a01));
                    if (fq == 0) KSS[(size_t)row * 4 + wc] = s;
                    bf16* d = LATP + (size_t)row * 768 + 256 + wc * 32 + 8 * fq;
                    *(v4u*)d = pack8(a00, a01, 1.f); *(v4u*)(d + HALF) = (v4u){0u, 0u, 0u, 0u};
                    if (wc == 0) { f32x4 x0 = a10, x1 = a11; rope32(x0, x1, gkr, tab + (size_t)(row % SEQ) * 16, fq, 1.f); store_rope(KROT + (size_t)row * 32, x0, x1, fq); }
                } else if (pn < 6) {
                    const bool isq = pn < 4; const int ch = 4 * ((pn - 2) & 1) + wc;
                    const float ms = fq_sum((sq4(a00) + sq4(a01)) + (sq4(a10) + sq4(a11))) * (1.f / 64.f);
                    const float r = __builtin_amdgcn_rsqf(ms + EPS) * (isq ? QSC_DIFF : 1.f);
                    bf16* d = (isq ? QD : KD) + (size_t)row * 512 + 64 * ch + 8 * fq;
                    *(v4u*)d = pack8(a00 * g00, a01 * g01, r); *(v4u*)(d + 32) = pack8(a10 * g10, a11 * g11, r);
                } else {
                    bf16* d = VD + (size_t)row * 512 + 256 * (pn - 6) + wc * 32 + 8 * fq;
                    *(v4u*)d = pack8(a00, a01, 1.f); *(v4u*)(d + HALF) = pack8(a10, a11, 1.f);
                }
            }
    }
};

struct EpiUp {
    static constexpr bool PERM = true, AFTER_DRAIN = false, PRE = false;
    unsigned char* ws;
    __device__ __forceinline__ void operator()(const Acc& acc, const Unit& u, int wr, int wc, int fr, int fq) const {
        asm volatile("" : "+v"(fr), "+v"(fq));
        const float* QSS = (const float*)(ws + WS_QSS); const float* KSS = (const float*)(ws + WS_KSS); bf16* QM = (bf16*)(ws + WS_QM); bf16* KVM = (bf16*)(ws + WS_KVM); const float2* tab = (const float2*)(ws + WS_TAB);
        const float* gq = kin(I_GMLAQ); const float* gk = kin(I_GMLAK);
        const int row0 = u.pm * BM + wr * 64 + fr, pn = u.pn;
        f32x4 g00 = {1.f, 1.f, 1.f, 1.f}, g01 = g00, g10 = g00, g11 = g00;
        if (pn < 2 || (pn >= 3 && (wc & 1) == 0)) { const float* g = (pn < 2 ? gq : gk) + 8 * fq; g00 = *(const f32x4*)g; g01 = *(const f32x4*)(g + 4); g10 = *(const f32x4*)(g + 32); g11 = *(const f32x4*)(g + 36); }
#pragma unroll
        for (int ai = 0; ai < 2; ++ai) {
#pragma unroll
            for (int m = 0; m < 4; ++m) { const int row = row0 + ai * HALF + m * 16;
                const float r2 = pn < 3 ? rstd4(QSS, row, 1.f / 256.f) : rstd4(KSS, row, 1.f / 128.f);
                const f32x4 a00 = acc[ai][0][m][0] * r2, a01 = acc[ai][0][m][1] * r2, a10 = acc[ai][1][m][0] * r2, a11 = acc[ai][1][m][1] * r2;
                if (pn < 2) {
                    const int h = 4 * pn + wc;
                    const float ms = fq_sum((sq4(a00) + sq4(a01)) + (sq4(a10) + sq4(a11))) * (1.f / 64.f);
                    const float r = __builtin_amdgcn_rsqf(ms + EPS) * QSC_MLA;
                    bf16* d = QM + (size_t)row * 768 + 96 * h + 8 * fq;
                    *(v4u*)d = pack8(a00 * g00, a01 * g01, r); *(v4u*)(d + 32) = pack8(a10 * g10, a11 * g11, r);
                } else if (pn == 2) {
                    const float2* tr = tab + (size_t)(row % SEQ) * 16;
                    { f32x4 x0 = a00, x1 = a01; rope32(x0, x1, gq + 64, tr, fq, QSC_MLA); store_rope(QM + (size_t)row * 768 + 96 * (2 * wc) + 64, x0, x1, fq); }
                    { f32x4 x0 = a10, x1 = a11; rope32(x0, x1, gq + 64, tr, fq, QSC_MLA); store_rope(QM + (size_t)row * 768 + 96 * (2 * wc + 1) + 64, x0, x1, fq); }
                } else {
                    const int cid = 4 * (pn - 3) + wc, head = cid >> 1, kind = cid & 1;
                    bf16* d = KVM + (size_t)row * 1024 + 128 * head + 64 * kind + 8 * fq;
                    if (kind == 0) {
                        const float ms = fq_sum((sq4(a00) + sq4(a01)) + (sq4(a10) + sq4(a11))) * (1.f / 64.f);
                        const float r = __builtin_amdgcn_rsqf(ms + EPS);
                        *(v4u*)d = pack8(a00 * g00, a01 * g01, r); *(v4u*)(d + 32) = pack8(a10 * g10, a11 * g11, r);
                    } else { *(v4u*)d = pack8(a00, a01, 1.f); *(v4u*)(d + 32) = pack8(a10, a11, 1.f); }
                }
            }
        }
    }
};
struct EpiPP {
    static constexpr bool PERM = true, AFTER_DRAIN = false, PRE = false;
    bf16* PP; float* SPP;
    __device__ __forceinline__ void operator()(const Acc& acc, const Unit& u, int wr, int wc, int fr, int fq) const {
        asm volatile("" : "+v"(fr), "+v"(fq));
        const int row0 = u.pm * BM + wr * 64 + fr, pn = u.pn;
#pragma unroll
        for (int ai = 0; ai < 2; ++ai)
#pragma unroll
            for (int m = 0; m < 4; ++m) { const int row = row0 + ai * HALF + m * 16;
                const f32x4 a00 = acc[ai][0][m][0], a01 = acc[ai][0][m][1], a10 = acc[ai][1][m][0], a11 = acc[ai][1][m][1];
                const float s = fq_sum((sq4(a00) + sq4(a01)) + (sq4(a10) + sq4(a11)));
                if (fq == 0) SPP[(size_t)row * 16 + pn * 4 + wc] = s;
                bf16* d = PP + (size_t)row * DM + 256 * pn + wc * 32 + 8 * fq;
                *(v4u*)d = pack8(a00, a01, 1.f); *(v4u*)(d + HALF) = pack8(a10, a11, 1.f); }
    }
};
}

__device__ __forceinline__ void pp_gemm(Frame& F, int G2, int c2) {
    pg8::Gemm g2{(const bf16*)F.ws, (const bf16*)(F.ws + WS_WUP) + (size_t)1792 * 256, M, DM, 256, 256, 1 << 30, 0, 1 << 30, 0, 1}; pg8::StaticOrder S2; S2.init(M, DM, G2, c2);
    pg8::EpiPP E2{(bf16*)(F.ws + WS_PP), (float*)(F.ws + WS_SPP)};
    pg8::gemm_phase<pg8::EpiPP, true>(F.lds + RING_OFF, g2, S2, E2);
}

struct Args;
template <class BarT>
__device__ __forceinline__ void mix_phases(Frame& F, const BarT& bar, int lo, int hi) {
#define IN(k) (lo <= (k) && (k) < hi)
#define BOTH(k) (IN(k) && IN((k) + 1))
    unsigned char* ws = F.ws;
    bf16* HB = (bf16*)(ws + WS_HB); bf16* LATP = (bf16*)(ws + WS_LATP); bf16* KROT = (bf16*)(ws + WS_KROT); bf16* QD = (bf16*)(ws + WS_QD); bf16* KD = (bf16*)(ws + WS_KD); bf16* VD = (bf16*)(ws + WS_VD);
    bf16* QM = (bf16*)(ws + WS_QM); bf16* KVM = (bf16*)(ws + WS_KVM); bf16* OCAT = (bf16*)(ws + WS_OCAT); bf16* PP = (bf16*)(ws + WS_PP);
    float* S1 = (float*)(ws + WS_S1); float* S2 = (float*)(ws + WS_S2); float* QSS = (float*)(ws + WS_QSS); float* KSS = (float*)(ws + WS_KSS); float* SPP = (float*)(ws + WS_SPP);
    const float2* tab = (const float2*)(ws + WS_TAB);
    const int NOPN = 1 << 30;
    if (IN(3)) {
        pg8::Gemm g{HB, (const bf16*)(ws + WS_WIN), M, 2048, DM, DM, NOPN, 0, NOPN, 0}; pg8::StaticOrder S; S.init(M, 2048, F.G, (int)blockIdx.x);
        pg8::EpiWin E{ws};
        pg8::gemm_phase<pg8::EpiWin, true>(F.lds + RING_OFF, g, S, E);
        if (BOTH(3)) PANEL_BAR();
    }
    if (IN(4)) {
        pg8::Gemm g{LATP, (const bf16*)(ws + WS_WUP), M, 1792, 256, 768, 3, 256, 7, 512}; pg8::StaticOrder S; S.init(M, 1792, F.G, (int)blockIdx.x);
        pg8::EpiUp E{ws};
        pg8::gemm_phase<pg8::EpiUp, true>(F.lds + RING_OFF, g, S, E);
        if (BOTH(4)) xcd_barrier(bar);
    }
    if (IN(5)) {
        float gq = fmaxf(fabsf(kin(I_GMLAQ)[F.lane]), F.lane < 32 ? fabsf(kin(I_GMLAQ)[64 + F.lane]) : 0.f), gk = fmaxf(fabsf(kin(I_GMLAK)[F.lane]), F.lane < 32 ? fabsf(kin(I_GMLAK)[64 + F.lane]) : 0.f);
#pragma unroll
        for (int o_ = 1; o_ < 64; o_ <<= 1) { gq = fmaxf(gq, __shfl_xor(gq, o_)); gk = fmaxf(gk, __shfl_xor(gk, o_)); }
        const bool fast = __builtin_amdgcn_readfirstlane((int)(9.7979590f * gq * gk * LOG2E * 1.02f + 1.f <= 40.f)) != 0;
        for (int i = 0; i < 2; ++i) { const int bh = 2 * (F.vcu >> 5) + i, qb = F.vcu & 31;
            if (fast) att::mla_unit4(bh >> 3, bh & 7, qb, QM, KVM, KROT, OCAT, (LAS char*)(F.lds + RING_OFF));
            else att::mla_unit(bh >> 3, bh & 7, qb, QM, KVM, KROT, OCAT, (LAS char*)(F.lds + RING_OFF)); }
    }
    if (IN(6)) {
        const float s1 = wave_sum(kin(I_LQ1)[F.lane] * kin(I_LK1)[F.lane]), s2 = wave_sum(kin(I_LQ2)[F.lane] * kin(I_LK2)[F.lane]);
        const float lam = __expf(s1) - __expf(s2) + 0.2f;
        float gq = fabsf(kin(I_GDQ)[F.lane]), gk = fabsf(kin(I_GDK)[F.lane]);
#pragma unroll
        for (int o_ = 1; o_ < 64; o_ <<= 1) { gq = fmaxf(gq, __shfl_xor(gq, o_)); gk = fmaxf(gk, __shfl_xor(gk, o_)); }
        const float B2 = 8.f * gq * gk * LOG2E * 1.02f + 1.f;
        const bool fastd = __builtin_amdgcn_readfirstlane((int)(B2 <= 40.f)) != 0;
        const int xj = F.vcu >> 5, bb = xj >> 2, pair = (xj >> 1) & 1, qb = 32 * (xj & 1) + (F.vcu & 31);
        for (int i = 0; i < 2; ++i) {
            const int h = pair == 0 ? (i == 0 ? 3 : 0) : (i == 0 ? 2 : 1);
            const float sl2 = exp2f(-2.f * (float)(h + 1)) * LOG2E;
            const float wdf = ceilf((B2 + 150.f) / sl2);
            const int Wd = __builtin_amdgcn_readfirstlane(wdf > 16384.f ? 16384 : (int)wdf);
            const int q0 = qb * 128;
            int t_lo = q0 - 63 - Wd; t_lo = t_lo < 0 ? 0 : (t_lo >> 6) + 1;
            int t_hi = (q0 + 127 + Wd + 63) / 64 - 1; t_hi = t_hi > SEQ / 64 - 1 ? SEQ / 64 - 1 : t_hi;
            if (t_hi - t_lo < 3) { if (t_lo >= 4) t_lo = t_hi - 3; else t_hi = t_lo + 3; }
            if (((t_hi - t_lo + 1) & 1) != 0) { if (t_lo > 0) --t_lo; else ++t_hi; }
            if (fastd) att::diff_unit4(bb, h, qb, t_lo, t_hi - t_lo + 1, QD, KD, VD, OCAT, lam, kin(I_GSUB), (LAS char*)(F.lds + RING_OFF));
            else att::diff_unit(bb, h, qb, t_lo, t_hi - t_lo + 1, QD, KD, VD, OCAT, lam, kin(I_GSUB), (LAS char*)(F.lds + RING_OFF));
        }
        if (F.G == 256 && pair == 0) { const int wrank = (xj >> 2) * 64 + (xj & 1) * 32 + (F.vcu & 31), rank = wrank * NWAVES + F.wave; p0_convert(F, 2, 4, rank, 128 * NWAVES); p0_convert(F, 6, 8, rank, 128 * NWAVES); __syncthreads(); pp_gemm(F, 128, wrank); }
        if (BOTH(6)) xcd_barrier(bar);
    }
    if (IN(7)) {
        pg8::Gemm g{OCAT, (const bf16*)(ws + WS_WOUT), M, DM, DM, DM, NOPN, 0, NOPN, 0}; pg8::StaticOrder S; S.init(M, DM, F.G, (int)blockIdx.x);
        pg8::EpiResid<true> E{HB, HB, S2, 1.0f, 0};
        pg8::gemm_phase<pg8::EpiResid<true>, false>(F.lds + RING_OFF, g, S, E);
        if (BOTH(7)) PANEL_BAR();
    }
#undef IN
#undef BOTH
}
}
namespace mk {
template <class BarT>
__device__ __forceinline__ void tail_phases(Frame& F, const BarT& bar, int lo, int hi) {
#define IN(k) (lo <= (k) && (k) < hi)
#define BOTH(k) (IN(k) && IN((k) + 1))
    unsigned char* ws = F.ws;
    bf16* HB = (bf16*)(ws + WS_HB); bf16* ACT = (bf16*)(ws + WS_ACT); bf16* PP = (bf16*)(ws + WS_PP);
    float* S2 = (float*)(ws + WS_S2); float* S3 = (float*)(ws + WS_S3); float* SPP = (float*)(ws + WS_SPP);
    const int NOPN = 1 << 30;
    if (IN(8)) {
        pg8::Gemm g{HB, (const bf16*)(ws + WS_WGU2), M, 2 * DFF, DM, DM, NOPN, 0, NOPN, 0}; pg8::StaticOrder S; S.init(M, 2 * DFF, F.G, (int)blockIdx.x);
        pg8::EpiSwiglu E{ACT, S2};
        pg8::gemm_phase<pg8::EpiSwiglu, true>(F.lds + RING_OFF, g, S, E);
        if (BOTH(8)) PANEL_BAR();
    }
    if (IN(9)) {
        pg8::Gemm g{ACT, (const bf16*)(ws + WS_WD2), M, DM, DFF, DFF, NOPN, 0, NOPN, 0}; pg8::StaticOrder S; S.init(M, DM, F.G, (int)blockIdx.x);
        pg8::EpiResid<true> E{HB, HB, S3, 0.5f, 0};
        pg8::gemm_phase<pg8::EpiResid<true>, false>(F.lds + RING_OFF, g, S, E);
        if (BOTH(9)) PANEL_BAR();
    }
    if (IN(10)) {
        pg8::Gemm g{HB, (const bf16*)(ws + WS_WPG), M, DM, DM, DM, NOPN, 0, NOPN, 0}; pg8::StaticOrder S; S.init(M, DM, F.G, (int)blockIdx.x);
        pg8::EpiPle E{HB, F.out, S3, SPP, PP, kin(I_BPG), kin(I_GPLEOUT)};
        pg8::gemm_phase<pg8::EpiPle, false>(F.lds + RING_OFF, g, S, E);
    }
#undef IN
#undef BOTH
}
}
namespace mk {
constexpr int NPHASE = 11;
struct Args { const float* in[31]; float* out; unsigned char* ws; int ph_lo, ph_hi, li, pad; };

__global__ void __launch_bounds__(NWAVES * 64, 2) mega_fwd(Args args) {
    extern __shared__ __attribute__((aligned(16))) unsigned char lds[];
    Frame F;
    F.lds = (LAS unsigned char*)lds;
    F.MISC = (volatile LAS unsigned*)(F.lds + MISC_OFF);
    F.tid = threadIdx.x; F.lane = F.tid & 63; F.wave = __builtin_amdgcn_readfirstlane(F.tid >> 6);
    F.G = gridDim.x; { const int bx = blockIdx.x; F.vcu = (F.G % 8 == 0) ? (bx % 8) * (F.G / 8) + bx / 8 : bx; }
    unsigned char* ws = args.ws; F.ws = ws; F.out = args.out;
    F.ctl = (gu32*)(ws + WS_CTL);
    for (int u = F.tid; u < (LDS_BYTES - LDSCTL_OFF) / 4; u += NWAVES * 64) ((LAS unsigned*)(F.lds + LDSCTL_OFF))[u] = 0u;
    __syncthreads();
    XcdBarrier bar = xcd_barrier_post((unsigned*)(F.ctl + CW_BAR) + args.li * XCD_BAR_STRIDE, F.MISC + 8);
#define GRID_BAR() xcd_barrier(bar)
    (void)grp_barrier_post(bar.bar, bar.bar, bar.x, F.MISC + 12);
    const int lo = args.ph_lo, hi = args.ph_hi;
#define IN(k) (lo <= (k) && (k) < hi)
#define BOTH(k) (IN(k) && IN((k) + 1))
    bf16* HB = (bf16*)(ws + WS_HB); bf16* ACT = (bf16*)(ws + WS_ACT);
    float* S0 = (float*)(ws + WS_S0); float* S1 = (float*)(ws + WS_S1); float* S2 = (float*)(ws + WS_S2); float* S3 = (float*)(ws + WS_S3);
    const int NOPN = 1 << 30;

    if (IN(0)) { p0_prologue(F); if (BOTH(0)) GRID_BAR(); }
    if (IN(1)) {
        pg8::Gemm g{HB, (const bf16*)(ws + WS_WGU1), M, 2 * DFF, DM, DM, NOPN, 0, NOPN, 0}; pg8::StaticOrder S; S.init(M, 2 * DFF, F.G, (int)blockIdx.x);
        pg8::EpiSwiglu E{ACT, S0};
        pg8::gemm_phase<pg8::EpiSwiglu, true>(F.lds + RING_OFF, g, S, E);
        if (F.G != 256) pp_gemm(F, F.G, (int)blockIdx.x);
        else if (blockIdx.x >= 128) { const int rank = ((int)blockIdx.x - 128) * NWAVES + F.wave; p0_convert(F, 4, 6, rank, 128 * NWAVES); }
        if (BOTH(1)) PANEL_BAR();
    }
    if (IN(2)) {
        pg8::Gemm g{ACT, (const bf16*)(ws + WS_WD1), M, DM, DFF, DFF, NOPN, 0, NOPN, 0}; pg8::StaticOrder S; S.init(M, DM, F.G, (int)blockIdx.x);
        pg8::EpiResid<true> E{HB, HB, S1, 0.5f, 0};
        pg8::gemm_phase<pg8::EpiResid<true>, false>(F.lds + RING_OFF, g, S, E);
        if (BOTH(2)) GRID_BAR();
    }
#ifdef MK_HAVE_MIX
    mix_phases(F, bar, lo, hi);
#endif
#ifdef MK_HAVE_TAIL
    tail_phases(F, bar, lo, hi);
#endif
#undef IN
#undef BOTH
}

static int mk_grid = 0;
static bool launch(void* const* d_in, float* out, unsigned char* ws, hipStream_t stream, int lo, int hi, int li) {
    if (mk_grid == 0) {
        int dev = 0, cus = 0, per_cu = 0;
        if (hipGetDevice(&dev) != hipSuccess || hipDeviceGetAttribute(&cus, hipDeviceAttributeMultiprocessorCount, dev) != hipSuccess) { fprintf(stderr, "kernel_launch: device query failed\n"); mk_grid = -1; return false; }
        if (hipFuncSetAttribute((const void*)mega_fwd, hipFuncAttributeMaxDynamicSharedMemorySize, LDS_BYTES) != hipSuccess) { fprintf(stderr, "kernel_launch: hipFuncSetAttribute failed\n"); mk_grid = -1; return false; }
        if (hipOccupancyMaxActiveBlocksPerMultiprocessor(&per_cu, (const void*)mega_fwd, NWAVES * 64, LDS_BYTES) != hipSuccess || per_cu < 1) { fprintf(stderr, "kernel_launch: occupancy query reports %d blocks per CU\n", per_cu); (void)hipGetLastError(); mk_grid = -1; return false; }
        if (cus != 256) { fprintf(stderr, "kernel_launch: built for 256 CUs, found %d\n", cus); mk_grid = -1; return false; }
        mk_grid = cus;
    }
    if (mk_grid < 0) return false;
    Args a; memset(&a, 0, sizeof(a));
    for (int i = 0; i < 31; ++i) a.in[i] = (const float*)d_in[i];
    a.out = out; a.ws = ws; a.ph_lo = lo; a.ph_hi = hi; a.li = li;
    hipLaunchKernelGGL(mega_fwd, dim3(mk_grid), dim3(NWAVES * 64), LDS_BYTES, stream, a);
    const hipError_t le = hipPeekAtLastError();
    if (le != hipSuccess) { fprintf(stderr, "kernel_launch: launch failed: %s\n", hipGetErrorName(le)); return false; }
    return true;
}
}
extern "C" void kernel_launch(void* const* d_in, const int* in_sizes, int n_in, void* d_out, int out_size, void* d_ws, size_t ws_size, hipStream_t stream) {
    if (n_in != 31 || out_size != mk::M * mk::DM || ws_size < (size_t)256 * mk::MiB) { fprintf(stderr, "kernel_launch: unexpected shapes n_in %d out %d ws %zu\n", n_in, out_size, ws_size); return; }
    if (hipMemsetAsync((char*)d_ws + mk::WS_CTL, 0, mk::CTL_ZERO_BYTES, stream) != hipSuccess) return;
    (void)mk::launch(d_in, (float*)d_out, (unsigned char*)d_ws, stream, 0, mk::NPHASE, 0);
}
```

```cpp
#define MK_HAVE_MIX
#define MK_HAVE_TAIL
#include <hip/hip_runtime.h>
#include <hip/hip_bf16.h>
#include <cstdio>
#include <cstdint>
#include <cstring>

namespace mk {
constexpr int BATCH = 2, SEQ = 8192, DM = 1024, M = BATCH * SEQ, DFF = 2816, PLE = 256, NIN = 1952;
constexpr float EPS = 1e-6f;
constexpr float LOG2E = 1.4426950408889634f;
constexpr float QSC_MLA = 0.10206207261596577f * LOG2E;
constexpr float QSC_DIFF = 0.125f * LOG2E;
constexpr int NWAVES = 8;

constexpr size_t MiB = 1u << 20;
constexpr size_t WS_CTL = 0, CTL_ZERO_BYTES = 128 * 1024;
constexpr size_t WS_TAB = 1 * MiB;
constexpr size_t WS_S0 = 2 * MiB;
constexpr size_t WS_S1 = WS_S0 + 256 * 1024, WS_S2 = WS_S1 + 256 * 1024, WS_S3 = WS_S2 + 256 * 1024;
constexpr size_t WS_QSS = WS_S3 + 256 * 1024, WS_KSS = WS_QSS + 256 * 1024;
constexpr size_t WS_SPP = WS_KSS + 256 * 1024;
constexpr size_t WS_WGU1 = 5 * MiB;
constexpr size_t WS_WD1 = 16 * MiB;
constexpr size_t WS_WGU2 = 22 * MiB;
constexpr size_t WS_WD2 = 33 * MiB;
constexpr size_t WS_WIN = 39 * MiB;
constexpr size_t WS_WUP = 43 * MiB;
constexpr size_t WS_WOUT = 45 * MiB;
constexpr size_t WS_WPG = 47 * MiB;
constexpr size_t WS_RA = 49 * MiB;
constexpr size_t WS_ACT = WS_RA;
constexpr size_t WS_KROT = WS_RA;
constexpr size_t WS_QD = WS_RA + 1 * MiB, WS_KD = WS_QD + 16 * MiB, WS_VD = WS_KD + 16 * MiB;
constexpr size_t WS_QM = WS_VD + 16 * MiB;
constexpr size_t WS_KVM = WS_QM + 24 * MiB;
constexpr size_t WS_LATP = WS_KVM + 32 * MiB;
constexpr size_t WS_OCAT = WS_LATP;
constexpr size_t WS_HB = WS_OCAT + 32 * MiB;
constexpr size_t WS_PP = WS_HB + 32 * MiB;
constexpr size_t WS_END = WS_PP + 32 * MiB;
constexpr size_t WS_PB0 = WS_END;
__host__ __device__ __forceinline__ size_t pb_panel_off(int pm) {
    if (pm < 48) return WS_PB0 + (size_t)pm * 131072;
    const int h = (pm - 48) >> 2; const size_t hb = h == 0 ? WS_SPP + 1 * MiB : (h == 1 ? WS_WD1 + 5632 * 1024 : (h == 2 ? WS_WD2 + 5632 * 1024 : WS_WUP + 1408 * 1024));
    return hb + (size_t)((pm - 48) & 3) * 131072;
}
static_assert(WS_PB0 + 48 * 131072 <= 256 * MiB && WS_SPP + 1 * MiB + 4 * 131072 <= WS_WGU1 && WS_WD1 + 5632 * 1024 + 4 * 131072 <= WS_WGU2 && WS_WD2 + 5632 * 1024 + 4 * 131072 <= WS_WIN && WS_WUP + 1408 * 1024 + 4 * 131072 <= WS_WOUT, "p-bf16 panels");
static_assert(WS_LATP >= WS_RA + 88 * MiB, "LATP must be clear of ACT");
static_assert(WS_END <= 256 * MiB, "d_ws map");
constexpr int CW_TMO = 0, CW_CODE = 1;
constexpr int CW_BAR = 4096;

constexpr int RING_OFF = 0, RING_BYTES = 131072;
constexpr int LDSCTL_OFF = RING_BYTES, MISC_OFF = LDSCTL_OFF + 320;
constexpr int LDS_BYTES = 147456;
constexpr int ROWSC_OFF = RING_BYTES + 4096;

#define GAS __attribute__((address_space(1)))
#define LAS __attribute__((address_space(3)))
typedef unsigned short bf16;
typedef unsigned v4u __attribute__((ext_vector_type(4)));
typedef unsigned v2u __attribute__((ext_vector_type(2)));
typedef float f32x4 __attribute__((ext_vector_type(4)));
typedef float f32x2 __attribute__((ext_vector_type(2)));
typedef short bf16x8 __attribute__((ext_vector_type(8)));
typedef GAS unsigned gu32;
#define RLX_AGENT __ATOMIC_RELAXED, __HIP_MEMORY_SCOPE_AGENT
#define LDS_WAIT() asm volatile("s_waitcnt lgkmcnt(0)" ::: "memory")
#define VM_WAIT() asm volatile("s_waitcnt vmcnt(0)" ::: "memory")
__device__ __forceinline__ unsigned cvt_pk_bf16(float lo, float hi) { unsigned r; asm volatile("v_cvt_pk_bf16_f32 %0, %1, %2" : "=v"(r) : "v"(lo), "v"(hi)); return r; }
__device__ __forceinline__ void st16_wt(void* p, v4u v) { asm volatile("global_store_dwordx4 %0, %1, off sc1\n\ts_nop 1" :: "v"(p), "v"(v) : "memory"); }
__device__ __forceinline__ void st8_wt(void* p, v2u v) { asm volatile("global_store_dwordx2 %0, %1, off sc1\n\ts_nop 1" :: "v"(p), "v"(v) : "memory"); }
__device__ __forceinline__ float bf_lo(unsigned w) { return __uint_as_float(w << 16); }
__device__ __forceinline__ float bf_hi(unsigned w) { return __uint_as_float(w & 0xffff0000u); }
__device__ __forceinline__ float wave_sum(float v) {
#pragma unroll
    for (int o = 1; o < 64; o <<= 1) v += __shfl_xor(v, o);
    return v;
}
__device__ __forceinline__ float xor_sum_16_32(float s) {
    { auto r = __builtin_amdgcn_permlane16_swap(__float_as_uint(s), __float_as_uint(s), false, false); s = __uint_as_float(r[0]) + __uint_as_float(r[1]); }
    { auto r = __builtin_amdgcn_permlane32_swap(__float_as_uint(s), __float_as_uint(s), false, false); s = __uint_as_float(r[0]) + __uint_as_float(r[1]); }
    return s;
}
__device__ __forceinline__ float fast_sigmoid(float x) { return __builtin_amdgcn_rcpf(1.f + __builtin_amdgcn_exp2f(-x * LOG2E)); }

#define XB_TMO      128
#define XB_XCNT(j)  (256  + 64 * (j))
#define XB_XSUB(j)  (1280 + 64 * (j))
#define XB_XGEN(j)  (2304 + 64 * (j))
#define XB_TOP      3328
#define XB_TOPGEN   3392
#define XCD_BAR_WORDS 3456
#define XB_SPIN_CAP (1u << 18)
__device__ __forceinline__ unsigned xb_ld(unsigned* p)              { return __hip_atomic_load(p, __ATOMIC_RELAXED, __HIP_MEMORY_SCOPE_AGENT); }
__device__ __forceinline__ unsigned xb_add(unsigned* p, unsigned v) { return __hip_atomic_fetch_add(p, v, __ATOMIC_RELAXED, __HIP_MEMORY_SCOPE_AGENT); }
__device__ __forceinline__ unsigned xb_xcc_id() { return (unsigned)__builtin_amdgcn_s_getreg((3 << 11) | 20) & 0xFu; }
#define XB_SPIN(cond, bar) do { unsigned _sp = 0; while (cond) { __builtin_amdgcn_s_sleep(1); \
    if ((++_sp & 255u) == 0u) { if (xb_ld(&(bar)[XB_TMO])) break; if (_sp > XB_SPIN_CAP) { atomicAdd(&(bar)[XB_TMO], 1u); break; } } } } while (0)
struct XcdBarrier { unsigned* bar; unsigned x; volatile LAS unsigned* st; };
__device__ __forceinline__ XcdBarrier xcd_barrier_post(unsigned* bar, volatile LAS unsigned* st) {
    XcdBarrier b; b.bar = bar; b.x = xb_xcc_id(); b.st = st;
    if (threadIdx.x == 0) (void)xb_add(&bar[XB_XCNT(b.x)], 1u);
    return b;
}
__device__ __forceinline__ void xcd_barrier_complete(unsigned* bar, unsigned x, unsigned& nloc, unsigned& nx) {
    const unsigned G = gridDim.x * gridDim.y * gridDim.z;
    unsigned sum, cnt, mine, sp = 0u;
    for (;;) {
        sum = 0u; cnt = 0u; mine = 0u;
#pragma unroll
        for (unsigned j = 0; j < 16; ++j) { const unsigned c = xb_ld(&bar[XB_XCNT(j)]); sum += c; cnt += (c > 0u) ? 1u : 0u; mine = (j == x) ? c : mine; }
        if (sum == G) break;
        __builtin_amdgcn_s_sleep(1);
        if ((++sp & 255u) == 0u) { if (xb_ld(&bar[XB_TMO])) break; if (sp > XB_SPIN_CAP) { atomicAdd(&bar[XB_TMO], 1u); break; } }
    }
    nloc = mine > 0u ? mine : 1u; nx = cnt > 0u ? cnt : 1u;
}
__device__ __forceinline__ void xcd_barrier(const XcdBarrier& b) {
    asm volatile("s_waitcnt vmcnt(0)" ::: "memory");
    __syncthreads();
    if (threadIdx.x == 0) {
        unsigned* bar = b.bar;
        __builtin_amdgcn_s_waitcnt(0);
        unsigned nloc = b.st[0], nx = b.st[1];
        if (nloc == 0u) { xcd_barrier_complete(bar, b.x, nloc, nx); b.st[0] = nloc; b.st[1] = nx; }
        const unsigned old = xb_add(&bar[XB_XSUB(b.x)], 1u);
        const unsigned gen = old / nloc;
        if (old + 1u == (gen + 1u) * nloc) {
            __builtin_amdgcn_fence(__ATOMIC_RELEASE, "agent");
            asm volatile("s_waitcnt vmcnt(0)" ::: "memory");
            const unsigned og = xb_add(&bar[XB_TOP], 1u);
            const unsigned tg = og / nx;
            if (og + 1u == (tg + 1u) * nx) xb_add(&bar[XB_TOPGEN], 1u);
            else XB_SPIN(xb_ld(&bar[XB_TOPGEN]) == tg, bar);
            __builtin_amdgcn_fence(__ATOMIC_ACQUIRE, "agent");
            xb_add(&bar[XB_XGEN(b.x)], 1u);
            asm volatile("s_waitcnt vmcnt(0)" ::: "memory");
        } else {
            XB_SPIN(xb_ld(&bar[XB_XGEN(b.x)]) == gen, bar);
            __builtin_amdgcn_fence(__ATOMIC_ACQUIRE, "agent");
            asm volatile("s_waitcnt vmcnt(0)" ::: "memory");
        }
    }
    __syncthreads();
}

#define GB_X(g)   (4096 + 16 * (g))
#define GB_CNT(g) (4352 + 64 * (g))
#define GB_GEN(g) (4864 + 64 * (g))
#define XCD_BAR_STRIDE 8192
struct GrpBarrier { unsigned* ctl; unsigned* tmo; unsigned g, x; volatile LAS unsigned* st; };
__device__ __forceinline__ GrpBarrier grp_barrier_post(unsigned* ctl, unsigned* tmo, unsigned x, volatile LAS unsigned* st) {
    GrpBarrier b; b.ctl = ctl; b.tmo = tmo; b.g = blockIdx.x & 7u; b.x = x; b.st = st;
    if (threadIdx.x == 0) (void)xb_add(&ctl[GB_X(b.g) + x], 1u);
    return b;
}
__device__ __forceinline__ void grp_barrier(const GrpBarrier& b, bool wait_all = false, bool l1_clean = false) {
    asm volatile("s_waitcnt vmcnt(0)" ::: "memory");
    __syncthreads();
    if (threadIdx.x == 0) {
        unsigned* ctl = b.ctl;
        __builtin_amdgcn_s_waitcnt(0);
        unsigned mode = b.st[0];
        if (mode == 0u) {
            unsigned sp = 0u, sum, mine;
            for (;;) {
                sum = 0u; mine = 0u;
#pragma unroll
                for (unsigned j = 0; j < 16; ++j) { const unsigned c_ = xb_ld(&ctl[GB_X(b.g) + j]); sum += c_; mine = (j == b.x) ? c_ : mine; }
                if (sum == 32u) break;
                __builtin_amdgcn_s_sleep(1);
                if ((++sp & 255u) == 0u) { if (xb_ld(&b.tmo[XB_TMO])) break; if (sp > XB_SPIN_CAP) { atomicAdd(&b.tmo[XB_TMO], 1u); break; } }
            }
            mode = (sum == 32u && mine == 32u) ? 1u : 2u; b.st[0] = mode;
        }
        if (mode != 1u) __builtin_amdgcn_fence(__ATOMIC_RELEASE, "agent");
        asm volatile("s_waitcnt vmcnt(0)" ::: "memory");
        const unsigned old = xb_add(&ctl[GB_CNT(b.g)], 1u), gen = old / 32u;
        if (old + 1u == (gen + 1u) * 32u) xb_add(&ctl[GB_GEN(b.g)], 1u);
        else XB_SPIN(xb_ld(&ctl[GB_GEN(b.g)]) == gen, b.tmo);
        const unsigned done = b.st[1] + 1u; b.st[1] = done;
        if (wait_all) {
            unsigned sp = 0u;
            for (;;) {
                unsigned v_[8];
#pragma unroll
                for (unsigned g = 0; g < 8u; ++g) v_[g] = xb_ld(&ctl[GB_GEN(g)]);
                bool ok = true;
#pragma unroll
                for (unsigned g = 0; g < 8u; ++g) ok = ok && (v_[g] >= done);
                if (ok) break;
                __builtin_amdgcn_s_sleep(1);
                if ((++sp & 255u) == 0u) { if (xb_ld(&b.tmo[XB_TMO])) break; if (sp > XB_SPIN_CAP) { atomicAdd(&b.tmo[XB_TMO], 1u); break; } }
            }
        }
        if (!(l1_clean && mode == 1u)) __builtin_amdgcn_fence(__ATOMIC_ACQUIRE, "agent");
        asm volatile("s_waitcnt vmcnt(0)" ::: "memory");
    }
    __syncthreads();
}
namespace pg8 {
constexpr int BM = 256, BK = 64, HALF = 128, HTB = HALF * BK * 2, STAGE_BYTES = 8 * HTB, NXCD = 8, WGM = 8;
__host__ __device__ __forceinline__ int lds_byte(int r, int c) { const int st = (r >> 4) * 2 + (c >> 5), rr = r & 15, cc = c & 31, ob = rr * 64 + cc * 2; return st * 1024 + (ob ^ (((ob >> 9) & 1) << 5)); }
__host__ __device__ __forceinline__ void stage_rc(int b, int& R, int& C) { const int st = b / 1024, sb = b % 1024, swz = sb ^ (((sb >> 9) & 1) << 5); R = (st >> 1) * 16 + swz / 64; C = (st & 1) * 32 + (swz % 64) / 2; }
__host__ __device__ __forceinline__ int perm32(int rho) { const int n = rho >> 4, i = rho & 15; return 8 * (i >> 2) + 4 * n + (i & 3); }
struct Unit { int pm, pn; };
struct Gemm { const bf16* A; const bf16* Bt; int M, N, K, lda; int pnA, acolA, pnB, acolB; int pmap; int pnHalfK;
    __device__ __forceinline__ int acol(int pn) const { return pn < pnA ? 0 : (pn < pnB ? acolA : acolB); }
    __device__ __forceinline__ const char* apanel(int pm, size_t tstepA) const { return pmap ? (const char*)A + pb_panel_off(pm) : (const char*)A + (size_t)pm * tstepA; } };
struct StaticOrder {
    int nM, nN, nwg, G, c;
    __host__ __device__ void init(int M, int N, int G_, int c_) { nM = M / BM; nN = N / BM; nwg = nM * nN; G = G_; c = c_; }
    __host__ __device__ bool next(int i, Unit& u) const {
        const long L = (long)i * G + c; if (L >= nwg) return false;
        int wgid = (int)L; { const int q = nwg / NXCD, r = nwg % NXCD, xcd = wgid % NXCD, off = wgid / NXCD; wgid = (xcd < r ? xcd * (q + 1) : r * (q + 1) + (xcd - r) * q) + off; }
        const int nig = WGM * nN, gid = wgid / nig, fm = gid * WGM, gsz = (nM - fm) < WGM ? (nM - fm) : WGM;
        u.pm = fm + ((wgid % nig) % gsz); u.pn = (wgid % nig) / gsz; return true;
    }
};
typedef f32x4 Acc[2][2][4][2];

template <class Epi, bool ALIGN_EPI>
__device__ __forceinline__ void gemm_phase(LAS unsigned char* lds, const Gemm g, const StaticOrder& S, const Epi& E) {
    const int tid = threadIdx.x, wid = __builtin_amdgcn_readfirstlane(tid >> 6), lane = tid & 63, wr = wid >> 2, wc = wid & 3, fr = lane & 15, fq = lane >> 4;
    const int K = g.K, ntf = K / BK, lda = g.lda;
#define PG8_NT(u) ((g.pnHalfK > 0 && (u).pn >= g.pnHalfK) ? ntf / 2 : ntf)
    unsigned voffA[2], voffB[2];
#pragma unroll
    for (int i = 0; i < 2; ++i) { int R, C; stage_rc(tid * 16 + i * 8192, R, C); const int Rb = Epi::PERM ? ((R & ~31) + perm32(R & 31)) : R;
        voffA[i] = (unsigned)(R * lda + C) * 2u; voffB[i] = (unsigned)(Rb * K + C) * 2u; }
    const size_t kstep = (size_t)(BK * 2);
    const size_t hstepA = (size_t)HALF * lda * 2, hstepB = (size_t)HALF * K * 2;
    const size_t tstepA = 2 * hstepA, tstepB = 2 * hstepB;
    const unsigned ldsw = (unsigned)wid * 1024u;
    const int aoff = lds_byte(wr * 64 + fr, fq * 8), boff = lds_byte(wc * 32 + fr, fq * 8);
#define PG8_SA(b, h) (((b) * 2 + (h)) * HTB)
#define PG8_SB(b, h) ((4 + (b) * 2 + (h)) * HTB)
#define PG8_STAGE(bufoff, gbase, voff) do { _Pragma("unroll") for (int _i = 0; _i < 2; ++_i) \
        __builtin_amdgcn_global_load_lds((const unsigned*)((const char*)(gbase) + (voff)[_i]), (LAS unsigned*)(lds + (bufoff) + ldsw + _i * 8192), 16, 0, 0); } while (0)
#define PG8_LDA(dst, b, h) do { _Pragma("unroll") for (int m = 0; m < 4; ++m) _Pragma("unroll") for (int k = 0; k < 2; ++k) dst[m][k] = *(const LAS bf16x8*)(lds + PG8_SA(b, h) + aoff + m * 2048 + k * 1024); } while (0)
#define PG8_LDB(dst, b, h) do { _Pragma("unroll") for (int n = 0; n < 2; ++n) _Pragma("unroll") for (int k = 0; k < 2; ++k) dst[n][k] = *(const LAS bf16x8*)(lds + PG8_SB(b, h) + boff + n * 2048 + k * 1024); } while (0)
#define PG8_MMA(ai, bj, At, Bt) do { __builtin_amdgcn_s_setprio(1); _Pragma("unroll") for (int m = 0; m < 4; ++m) _Pragma("unroll") for (int n = 0; n < 2; ++n) _Pragma("unroll") for (int k = 0; k < 2; ++k) \
        acc[ai][bj][m][n] = __builtin_amdgcn_mfma_f32_16x16x32_bf16(Bt[n][k], At[m][k], acc[ai][bj][m][n], 0, 0, 0); __builtin_amdgcn_s_setprio(0); } while (0)
#define PG8_WAIT_V(n) asm volatile("s_waitcnt vmcnt(" #n ")" ::: "memory")
#define PG8_WAIT_L(n) asm volatile("s_waitcnt lgkmcnt(" #n ")" ::: "memory")
#define PG8_BAR __builtin_amdgcn_s_barrier()
#define PG8_SCHED __builtin_amdgcn_sched_barrier(0)
    Unit cur, nxt; int ui = 0;
    if (!S.next(0, cur)) return;
    f32x4 acc[2][2][4][2];
#pragma unroll
    for (int a = 0; a < 2; ++a)
#pragma unroll
        for (int b = 0; b < 2; ++b)
#pragma unroll
            for (int m = 0; m < 4; ++m)
#pragma unroll
                for (int n = 0; n < 2; ++n) acc[a][b][m][n] = (f32x4){0.f, 0.f, 0.f, 0.f};
    bf16x8 At[4][2], B0[2][2], B1[2][2];
    const char* cA = g.apanel(cur.pm, tstepA) + (size_t)g.acol(cur.pn) * 2; const char* cB = (const char*)g.Bt + (size_t)cur.pn * tstepB;
    PG8_STAGE(PG8_SB(0, 0), cB, voffB); PG8_STAGE(PG8_SB(0, 1), cB + hstepB, voffB); PG8_STAGE(PG8_SA(0, 0), cA, voffA); PG8_STAGE(PG8_SA(0, 1), cA + hstepA, voffA);
    if (wr == 1) PG8_BAR;
    PG8_WAIT_V(2); PG8_BAR;
    PG8_STAGE(PG8_SB(1, 0), cB + kstep, voffB); PG8_STAGE(PG8_SA(1, 0), cA + kstep, voffA); PG8_STAGE(PG8_SB(1, 1), cB + hstepB + kstep, voffB);
    PG8_WAIT_V(6); PG8_BAR;
    for (;;) {
        const bool has_next = S.next(ui + 1, nxt);
        const char* nA = has_next ? g.apanel(nxt.pm, tstepA) + (size_t)g.acol(nxt.pn) * 2 : cA; const char* nB = has_next ? (const char*)g.Bt + (size_t)nxt.pn * tstepB : cB;
        const int nt = PG8_NT(cur);
        for (int t = 0; t < nt; t += 2) {
            const bool last = (t == nt - 2);
            const char* a1 = cA + (size_t)(t + 1) * kstep;
            const char* a2 = last ? nA : cA + (size_t)(t + 2) * kstep; const char* b2 = last ? nB : cB + (size_t)(t + 2) * kstep;
            const char* a3 = a2 + kstep; const char* b3 = b2 + kstep;
            f32x4 praw;
            if constexpr (Epi::PRE) { if (last) { const float* pp_ = E.pre_addr(cur, wid, lane); asm volatile("global_load_dwordx4 %0, %1, off" : "=v"(praw) : "v"(pp_) : "memory"); } }
            PG8_LDB(B0, 0, 0); PG8_LDB(B1, 0, 1); PG8_SCHED; PG8_LDA(At, 0, 0); PG8_STAGE(PG8_SA(1, 1), a1 + hstepA, voffA);
            PG8_WAIT_V(8); PG8_WAIT_L(0); PG8_BAR; PG8_MMA(0, 0, At, B0); PG8_MMA(0, 1, At, B1); PG8_BAR; PG8_SCHED;
            PG8_LDA(At, 0, 1); PG8_STAGE(PG8_SB(0, 0), b2, voffB); PG8_STAGE(PG8_SB(0, 1), b2 + hstepB, voffB); PG8_STAGE(PG8_SA(0, 0), a2, voffA);
            PG8_WAIT_V(8); PG8_WAIT_L(0); PG8_BAR; PG8_MMA(1, 0, At, B0); PG8_MMA(1, 1, At, B1); PG8_BAR; PG8_SCHED;
            PG8_LDB(B0, 1, 0); PG8_LDB(B1, 1, 1); PG8_SCHED; PG8_LDA(At, 1, 0); PG8_STAGE(PG8_SA(0, 1), a2 + hstepA, voffA);
            PG8_WAIT_V(8); PG8_WAIT_L(0); PG8_BAR; PG8_MMA(0, 0, At, B0); PG8_MMA(0, 1, At, B1); PG8_BAR; PG8_SCHED;
            PG8_LDA(At, 1, 1); PG8_STAGE(PG8_SB(1, 0), b3, voffB); PG8_STAGE(PG8_SB(1, 1), b3 + hstepB, voffB); PG8_STAGE(PG8_SA(1, 0), a3, voffA);
            PG8_WAIT_V(8);
            if constexpr (Epi::PRE) { if (last) { asm volatile("" : "+v"(praw)); E.pre_store(praw, (LAS float*)(lds + ROWSC_OFF), wid, lane); } }
            PG8_WAIT_L(0); PG8_BAR; PG8_MMA(1, 0, At, B0); PG8_MMA(1, 1, At, B1); PG8_BAR; PG8_SCHED;
        }
        if constexpr (ALIGN_EPI) { if (wr == 0) PG8_BAR; }
        if constexpr (Epi::PRE) { static_assert(ALIGN_EPI, "PRE needs the aligned epilogue"); E(acc, cur, wr, wc, fr, fq, (const LAS float*)(lds + ROWSC_OFF)); }
        else if constexpr (!Epi::AFTER_DRAIN) { E(acc, cur, wr, wc, fr, fq); }
        if (!has_next) break;
#pragma unroll
        for (int a = 0; a < 2; ++a)
#pragma unroll
            for (int b = 0; b < 2; ++b)
#pragma unroll
                for (int m = 0; m < 4; ++m)
#pragma unroll
                    for (int n = 0; n < 2; ++n) acc[a][b][m][n] = (f32x4){0.f, 0.f, 0.f, 0.f};
        cur = nxt; cA = nA; cB = nB; ++ui;
        if constexpr (ALIGN_EPI) { if (wr == 1) PG8_BAR; }
    }
    PG8_WAIT_V(0);
    if constexpr (!ALIGN_EPI) { if (wr == 0) PG8_BAR; }
    PG8_BAR;
    if constexpr (Epi::AFTER_DRAIN) { E.fused(acc, cur, wr, wc, fr, fq, lds, wid, lane); }
#undef PG8_SA
#undef PG8_NT
#undef PG8_SB
#undef PG8_STAGE
#undef PG8_LDA
#undef PG8_LDB
#undef PG8_MMA
#undef PG8_WAIT_V
#undef PG8_WAIT_L
#undef PG8_BAR
#undef PG8_SCHED
}
}
}
namespace mk {
namespace pg8 {
__device__ __forceinline__ float rstd4(const float* ssq, int row, float inv_n) { const f32x4 s = *(const f32x4*)(ssq + (size_t)row * 4); return __builtin_amdgcn_rsqf(((s.x + s.y) + (s.z + s.w)) * inv_n + EPS); }

struct EpiSwiglu {
    static constexpr bool PERM = true, AFTER_DRAIN = false, PRE = true;
    bf16* O; const float* ssq;
    __device__ __forceinline__ const float* pre_addr(const Unit& u, int wid, int lane) const { return ssq + (size_t)(u.pm * BM + wid * 32 + (lane & 31)) * 4; }
    __device__ __forceinline__ void pre_store(const f32x4 s, LAS float* rowsc, int wid, int lane) const { if (lane < 32) rowsc[wid * 32 + lane] = ((s.x + s.y) + (s.z + s.w)) * (1.f / DM) + EPS; }
    __device__ __forceinline__ void operator()(const Acc& acc, const Unit& u, int wr, int wc, int fr, int fq, const LAS float* rowsc) const {
        asm volatile("" : "+v"(fr), "+v"(fq));
        const int row0 = u.pm * BM + wr * 64 + fr, col0 = u.pn * HALF + wc * 32 + 8 * fq;
        const LAS float* rsc = rowsc + wr * 64 + fr;
        float ms[2][4];
#pragma unroll
        for (int ai = 0; ai < 2; ++ai)
#pragma unroll
            for (int m = 0; m < 4; ++m) ms[ai][m] = rsc[ai * HALF + m * 16];
#pragma unroll
        for (int ai = 0; ai < 2; ++ai)
#pragma unroll
            for (int m = 0; m < 4; ++m) { const int row = row0 + ai * HALF + m * 16; const float msq = ms[ai][m], nr = __builtin_amdgcn_rsqf(msq) * -LOG2E;
                const f32x2 ms2 = {msq, msq}, nr2 = {nr, nr};
                unsigned w[4];
#pragma unroll
                for (int n = 0; n < 2; ++n)
#pragma unroll
                    for (int h = 0; h < 2; ++h) { const f32x4 ga = acc[ai][0][m][n], ua = acc[ai][1][m][n];
                        const f32x2 gt = h ? (f32x2){ga.z, ga.w} : (f32x2){ga.x, ga.y}, up = h ? (f32x2){ua.z, ua.w} : (f32x2){ua.x, ua.y};
                        const f32x2 t = gt * nr2;
                        const f32x2 ex = {__builtin_amdgcn_exp2f(t.x), __builtin_amdgcn_exp2f(t.y)};
                        const f32x2 d = __builtin_elementwise_fma(ex, ms2, ms2);
                        const f32x2 rc = {__builtin_amdgcn_rcpf(d.x), __builtin_amdgcn_rcpf(d.y)};
                        const f32x2 o = (gt * up) * rc;
                        w[n * 2 + h] = cvt_pk_bf16(o.x, o.y); }
                v4u wv; wv.x = w[0]; wv.y = w[1]; wv.z = w[2]; wv.w = w[3];
                *(v4u*)(O + (size_t)row * DFF + col0) = wv; }
    }
};

template <bool BASE_BF16> struct EpiResid {
    static constexpr bool PERM = true, AFTER_DRAIN = true, PRE = false;
    const void* base; bf16* hb; float* ssq_out; float sc; int pad;
    __device__ __forceinline__ void fused(const Acc& acc, const Unit& u, int wr, int wc, int fr, int fq, LAS unsigned char* lds, int wid, int lane) const {
        LAS float* P = (LAS float*)lds;
        const int col0 = u.pn * BM + wc * 32 + 8 * fq;
#pragma unroll
        for (int ai = 0; ai < 2; ++ai)
#pragma unroll
            for (int m = 0; m < 4; ++m) { const int rl = ai * HALF + wr * 64 + m * 16 + fr; const size_t off = (size_t)(u.pm * BM + rl) * DM + col0; float s = 0.f;
#pragma unroll
                for (int bj = 0; bj < 2; ++bj) { const size_t o2 = off + bj * HALF; f32x4 b0, b1;
                    if (BASE_BF16) { const v4u pw = *(const v4u*)((const bf16*)base + o2); b0 = (f32x4){bf_lo(pw.x), bf_hi(pw.x), bf_lo(pw.y), bf_hi(pw.y)}; b1 = (f32x4){bf_lo(pw.z), bf_hi(pw.z), bf_lo(pw.w), bf_hi(pw.w)}; }
                    else { b0 = *(const f32x4*)((const float*)base + o2); b1 = *(const f32x4*)((const float*)base + o2 + 4); }
                    const f32x4 p0 = b0 + acc[ai][bj][m][0] * sc, p1 = b1 + acc[ai][bj][m][1] * sc;
                    v4u w; w.x = cvt_pk_bf16(p0[0], p0[1]); w.y = cvt_pk_bf16(p0[2], p0[3]); w.z = cvt_pk_bf16(p1[0], p1[1]); w.w = cvt_pk_bf16(p1[2], p1[3]); *(v4u*)(hb + o2) = w;
                    s += ((p0[0] * p0[0] + p0[1] * p0[1]) + (p0[2] * p0[2] + p0[3] * p0[3])) + ((p1[0] * p1[0] + p1[1] * p1[1]) + (p1[2] * p1[2] + p1[3] * p1[3])); }
                s = xor_sum_16_32(s);
                if (fq == 0) P[rl * 4 + wc] = s;
                if (m == 3) asm volatile("" ::: "memory"); }
        asm volatile("s_waitcnt lgkmcnt(0)" ::: "memory"); __builtin_amdgcn_s_barrier(); asm volatile("" ::: "memory");
        const int t = wid * 64 + lane;
        if (t < 256) { const f32x4 p = *(const LAS f32x4*)(P + t * 4); ssq_out[(size_t)(u.pm * BM + t) * 4 + u.pn] = (p.x + p.y) + (p.z + p.w); }
    }
};

struct EpiPle {
    static constexpr bool PERM = true, AFTER_DRAIN = false, PRE = false;
    const bf16* base; float* out; const float* ssq3; const float* spp; const bf16* pp; const float* bias; const float* gout;
    __device__ __forceinline__ void operator()(const Acc& acc, const Unit& u, int wr, int wc, int fr, int fq) const {
        asm volatile("" : "+v"(fr), "+v"(fq));
        const int col0 = u.pn * BM + wc * 32 + 8 * fq;
        f32x4 nb[2][2], gv[2][2];
#pragma unroll
        for (int bj = 0; bj < 2; ++bj)
#pragma unroll
            for (int n = 0; n < 2; ++n) { nb[bj][n] = *(const f32x4*)(bias + col0 + bj * HALF + n * 4) * -LOG2E; gv[bj][n] = *(const f32x4*)(gout + col0 + bj * HALF + n * 4); }
        float nr3s[2][4], rpps[2][4];
#pragma unroll
        for (int ai = 0; ai < 2; ++ai) { f32x4 s3v[4], spv[4];
#pragma unroll
            for (int m = 0; m < 4; ++m) { const int row = u.pm * BM + ai * HALF + wr * 64 + m * 16 + fr; s3v[m] = *(const f32x4*)(ssq3 + (size_t)row * 4); spv[m] = *(const f32x4*)(spp + (size_t)row * 16 + 4 * fq); }
#pragma unroll
            for (int m = 0; m < 4; ++m) { const f32x4 s = s3v[m], p = spv[m];
                nr3s[ai][m] = __builtin_amdgcn_rsqf(((s.x + s.y) + (s.z + s.w)) * (1.f / DM) + EPS) * -LOG2E;
                const float sp = xor_sum_16_32((p.x + p.y) + (p.z + p.w));
                rpps[ai][m] = __builtin_amdgcn_rsqf(sp * (1.f / DM) + EPS); } }
        const size_t offb = (size_t)(u.pm * BM + wr * 64 + fr) * DM + col0;
        v4u hwn = *(const v4u*)(base + offb), pwn = *(const v4u*)(pp + offb);
#pragma unroll
        for (int ai = 0; ai < 2; ++ai)
#pragma unroll
            for (int m = 0; m < 4; ++m) { const int row = u.pm * BM + ai * HALF + wr * 64 + m * 16 + fr; const size_t off = (size_t)row * DM + col0;
                const f32x2 nr3 = {nr3s[ai][m], nr3s[ai][m]}, rpp = {rpps[ai][m], rpps[ai][m]}, one = {1.f, 1.f};
#pragma unroll
                for (int bj = 0; bj < 2; ++bj) { const size_t o2 = off + bj * HALF; const v4u hw = hwn, pw = pwn;
                    { const int idx = ai * 8 + m * 2 + bj + 1;
                      if (idx < 16) { const size_t on = offb + (size_t)(((idx >> 3) * HALF + ((idx >> 1) & 3) * 16) * DM + (idx & 1) * HALF); hwn = *(const v4u*)(base + on); pwn = *(const v4u*)(pp + on); asm volatile("" ::: "memory"); } }
#pragma unroll
                    for (int n = 0; n < 2; ++n) { const f32x4 a4 = acc[ai][bj][m][n], b4 = nb[bj][n], g4 = gv[bj][n]; f32x4 o;
#pragma unroll
                        for (int h = 0; h < 2; ++h) {
                            const f32x2 a = h ? (f32x2){a4.z, a4.w} : (f32x2){a4.x, a4.y}, b = h ? (f32x2){b4.z, b4.w} : (f32x2){b4.x, b4.y}, g = h ? (f32x2){g4.z, g4.w} : (f32x2){g4.x, g4.y};
                            const unsigned hx = n ? (h ? hw.w : hw.z) : (h ? hw.y : hw.x), px = n ? (h ? pw.w : pw.z) : (h ? pw.y : pw.x);
                            const f32x2 hv = {bf_lo(hx), bf_hi(hx)}, pv = {bf_lo(px), bf_hi(px)};
                            const f32x2 t = __builtin_elementwise_fma(a, nr3, b);
                            const f32x2 d = (f32x2){__builtin_amdgcn_exp2f(t.x), __builtin_amdgcn_exp2f(t.y)} + one;
                            const f32x2 rc = {__builtin_amdgcn_rcpf(d.x), __builtin_amdgcn_rcpf(d.y)};
                            const f32x2 r = __builtin_elementwise_fma(rc, (pv * rpp) * g, hv);
                            if (h) { o.z = r.x; o.w = r.y; } else { o.x = r.x; o.y = r.y; } }
                        __builtin_nontemporal_store(o, (f32x4*)(out + o2 + n * 4)); } }
            }
    }
};
}
}
namespace mk {
struct Frame {
    LAS unsigned char* lds;
    volatile LAS unsigned* MISC;
    gu32* ctl;
    int tid, lane, wave;
    int vcu, G;
    float* out; unsigned char* ws;
};
#define PANEL_BAR_ALL() do { if (F.G == 256) { GrpBarrier gb_; gb_.ctl = bar.bar; gb_.tmo = bar.bar; gb_.g = blockIdx.x & 7u; gb_.x = bar.x; gb_.st = F.MISC + 12; grp_barrier(gb_, true); } else xcd_barrier(bar); } while (0)
#define PANEL_BAR_L1CLEAN() do { if (F.G == 256) { GrpBarrier gb_; gb_.ctl = bar.bar; gb_.tmo = bar.bar; gb_.g = blockIdx.x & 7u; gb_.x = bar.x; gb_.st = F.MISC + 12; grp_barrier(gb_, false, true); } else xcd_barrier(bar); } while (0)
#define PANEL_BAR() do { if (F.G == 256) { GrpBarrier gb_; gb_.ctl = bar.bar; gb_.tmo = bar.bar; gb_.g = blockIdx.x & 7u; gb_.x = bar.x; gb_.st = F.MISC + 12; grp_barrier(gb_); } else xcd_barrier(bar); } while (0)
__device__ __forceinline__ const float* kin(int i) { return ((const float* const __attribute__((address_space(4)))*)__builtin_amdgcn_kernarg_segment_ptr())[i]; }
__device__ __forceinline__ int karg_pad() { return ((const int __attribute__((address_space(4)))*)__builtin_amdgcn_kernarg_segment_ptr())[69]; }
enum { I_X = 0, I_P, I_GFFN1, I_W1G, I_W1U, I_W1D, I_GMIX, I_WIN, I_GQLAT, I_WQUP, I_GKVLAT, I_WKVUP, I_GMLAQ, I_GMLAK, I_GDQ, I_GDK, I_LQ1, I_LK1, I_LQ2, I_LK2, I_GSUB, I_WOUT,
       I_GFFN2, I_W2G, I_W2U, I_W2D, I_GPLEIN, I_WPG, I_BPG, I_WPP, I_GPLEOUT };

struct ColSrc { const float* p; int ld; int krows; const float* gain; };
__device__ __forceinline__ int erope(int j) { return 4 * (j >> 3) + (j & 3) + 16 * ((j >> 2) & 1); }
__device__ __forceinline__ ColSrc colsrc(const Frame& F, int id, int np) {
    ColSrc c; c.p = nullptr; c.ld = 0; c.krows = 0; c.gain = nullptr;
    const int t = np >> 8, tc = np & 255, bj = tc >> 7, wc = (tc >> 5) & 3, j = tc & 31, e = 32 * bj + j;
    if (id == 0 || id == 2) { const float* wg = kin(id == 0 ? I_W1G : I_W2G); const float* wu = kin(id == 0 ? I_W1U : I_W2U);
        c.p = (bj ? wu : wg) + 128 * t + (tc & 127); c.ld = DFF; c.krows = DM; c.gain = kin(id == 0 ? I_GFFN1 : I_GFFN2); }
    else if (id == 1 || id == 3) { c.p = kin(id == 1 ? I_W1D : I_W2D) + np; c.ld = DM; c.krows = DFF; }
    else if (id == 4) { int lg = -1;
        if (t == 0) lg = tc;
        else if (t == 1) { if (bj == 0) lg = 256 + tc; else if (wc == 0) lg = 384 + erope(j); }
        else if (t < 4) lg = 416 + 64 * (4 * (t - 2) + wc) + e;
        else if (t < 6) lg = 928 + 64 * (4 * (t - 4) + wc) + e;
        else lg = 1440 + 256 * (t - 6) + tc;
        if (lg >= 0) { c.p = kin(I_WIN) + lg; c.ld = NIN; c.krows = DM; c.gain = kin(I_GMIX); } }
    else if (id == 5) {
        if (t < 2) { c.p = kin(I_WQUP) + 96 * (4 * t + wc) + e; c.ld = 768; c.krows = 256; c.gain = kin(I_GQLAT); }
        else if (t == 2) { c.p = kin(I_WQUP) + 96 * (2 * wc + bj) + 64 + erope(j); c.ld = 768; c.krows = 256; c.gain = kin(I_GQLAT); }
        else if (t < 7) { const int cid = 4 * (t - 3) + wc; c.p = kin(I_WKVUP) + 128 * (cid >> 1) + 64 * (cid & 1) + e; c.ld = 1024; c.krows = 128; c.gain = kin(I_GKVLAT); }
        else { c.p = kin(I_WPP) + 256 * (t - 7) + tc; c.ld = DM; c.krows = 256; } }
    else if (id == 6) { c.p = kin(I_WOUT) + np; c.ld = DM; c.krows = DM; }
    else { c.p = kin(I_WPG) + np; c.ld = DM; c.krows = DM; c.gain = kin(I_GPLEIN); }
    return c;
}
template <bool WTHRU = false>
__device__ __forceinline__ void p0_transpose_item(const Frame& F, int id, int K, bf16* WT, LAS float* scr, int kb, int nb, int lane) {
    const int k0 = 64 * kb, n0 = 32 * nb;
    const int cg = lane & 7, kr = lane >> 3;
    const ColSrc cs = colsrc(F, id, n0 + 4 * cg);
#pragma unroll
    for (int i = 0; i < 8; ++i) { const int kk = 8 * i + kr; const int k = k0 + kk; f32x4 v = {0.f, 0.f, 0.f, 0.f};
        if (cs.p != nullptr && k < cs.krows) { v = __builtin_nontemporal_load((const f32x4*)(cs.p + (size_t)k * cs.ld)); if (cs.gain != nullptr) v = v * cs.gain[k]; }
        *(LAS f32x4*)(scr + kk * 36 + 4 * cg) = v; }
    LDS_WAIT(); asm volatile("" ::: "memory");
    const int c = lane & 7;
#pragma unroll
    for (int jj = 0; jj < 4; ++jj) { const int n = (lane >> 3) + 8 * jj; const LAS float* s = scr + (8 * c) * 36 + n;
        v4u o; o.x = cvt_pk_bf16(s[0 * 36], s[1 * 36]); o.y = cvt_pk_bf16(s[2 * 36], s[3 * 36]); o.z = cvt_pk_bf16(s[4 * 36], s[5 * 36]); o.w = cvt_pk_bf16(s[6 * 36], s[7 * 36]);
        if constexpr (WTHRU) st16_wt(WT + (size_t)(n0 + n) * K + k0 + 8 * c, o); else *(GAS v4u*)(WT + (size_t)(n0 + n) * K + k0 + 8 * c) = o; }
    LDS_WAIT(); asm volatile("" ::: "memory");
}
__device__ __forceinline__ void sincos_acc(float ang, float& s, float& c) {
    const double a = (double)ang;
    const double k = rint(a * 0.15915494309189535);
    const double r = a - k * 6.283185307179586;
    const double r2 = r * r;
    double ps = 1.0, pc = 1.0;
#pragma unroll
    for (int i = 12; i >= 1; --i) {
        ps = 1.0 - ps * r2 * (1.0 / (double)((2 * i) * (2 * i + 1)));
        pc = 1.0 - pc * r2 * (1.0 / (double)((2 * i - 1) * (2 * i)));
    }
    s = (float)(r * ps); c = (float)pc;
}
template <bool WTHRU = false>
__device__ __forceinline__ void p0_convert(Frame& F, int id_lo, int id_hi, int gw, int NGW) {
    LAS float* scr = (LAS float*)(F.lds + RING_OFF + F.wave * 16384);
    constexpr int NMAT = 8;
    const int Ks[NMAT] = {DM, DFF, DM, DFF, DM, 256, DM, DM};
    const int Ns[NMAT] = {2 * DFF, DM, 2 * DFF, DM, 2048, 2816, DM, DM};
    const size_t Ds[NMAT] = {WS_WGU1, WS_WD1, WS_WGU2, WS_WD2, WS_WIN, WS_WUP, WS_WOUT, WS_WPG};
    int base = 0;
#pragma unroll
    for (int id = 0; id < NMAT; ++id) {
        if (id < id_lo || id >= id_hi) continue;
        const int nkb = Ks[id] / 64, nnb = Ns[id] / 32, nit = nkb * nnb;
        int first = base + ((gw - base % NGW) + NGW) % NGW;
        for (int it = first; it < base + nit; it += NGW) { const int r = it - base; p0_transpose_item<WTHRU>(F, id, Ks[id], (bf16*)(F.ws + Ds[id]), scr, r / nnb, r % nnb, F.lane); }
        base += nit;
    }
}
__device__ __forceinline__ void p0_prologue(Frame& F) {
    const int gw = F.vcu * NWAVES + F.wave, NGW = F.G * NWAVES;
    p0_convert(F, 0, 2, gw, NGW);
    if (F.G != 256) { p0_convert(F, 2, 8, gw, NGW); }
    const float* x = kin(I_X); const float* p = kin(I_P);
    bf16* HB = (bf16*)(F.ws + WS_HB); float* S0 = (float*)(F.ws + WS_S0);
    for (int m = gw; m < M; m += 2 * NGW) {
        const int m2 = m + NGW;
        const GAS f32x4* xr = (const GAS f32x4*)(x + (size_t)m * DM) + F.lane; const GAS f32x4* xr2 = (const GAS f32x4*)(x + (size_t)m2 * DM) + F.lane;
        f32x4 v[4], w2[4];
#pragma unroll
        for (int j = 0; j < 4; ++j) { v[j] = __builtin_nontemporal_load(xr + 64 * j); w2[j] = __builtin_nontemporal_load(xr2 + 64 * j); }
        const f32x4 pv = __builtin_nontemporal_load((const GAS f32x4*)(p + (size_t)m * PLE) + F.lane), pv2 = __builtin_nontemporal_load((const GAS f32x4*)(p + (size_t)m2 * PLE) + F.lane);
        GAS v2u* o8 = (GAS v2u*)(HB + (size_t)m * DM) + F.lane; GAS v2u* o82 = (GAS v2u*)(HB + (size_t)m2 * DM) + F.lane; float s = 0.f, s2 = 0.f;
#pragma unroll
        for (int j = 0; j < 4; ++j) { s += (v[j].x * v[j].x + v[j].y * v[j].y) + (v[j].z * v[j].z + v[j].w * v[j].w); v2u w; w.x = cvt_pk_bf16(v[j].x, v[j].y); w.y = cvt_pk_bf16(v[j].z, v[j].w); o8[64 * j] = w;
            s2 += (w2[j].x * w2[j].x + w2[j].y * w2[j].y) + (w2[j].z * w2[j].z + w2[j].w * w2[j].w); v2u u; u.x = cvt_pk_bf16(w2[j].x, w2[j].y); u.y = cvt_pk_bf16(w2[j].z, w2[j].w); o82[64 * j] = u; }
        s = wave_sum(s); s2 = wave_sum(s2);
        if (F.lane == 0) { *(GAS f32x4*)(S0 + (size_t)m * 4) = (f32x4){s, 0.f, 0.f, 0.f}; *(GAS f32x4*)(S0 + (size_t)m2 * 4) = (f32x4){s2, 0.f, 0.f, 0.f}; }
        v2u w; w.x = cvt_pk_bf16(pv.x, pv.y); w.y = cvt_pk_bf16(pv.z, pv.w); *((GAS v2u*)(F.ws + pb_panel_off(m >> 8) + (size_t)(m & 255) * 512) + F.lane) = w;
        v2u u; u.x = cvt_pk_bf16(pv2.x, pv2.y); u.y = cvt_pk_bf16(pv2.z, pv2.w); *((GAS v2u*)(F.ws + pb_panel_off(m2 >> 8) + (size_t)(m2 & 255) * 512) + F.lane) = u;
    }
    float2* tab = (float2*)(F.ws + WS_TAB);
    for (int idx = gw * 64 + F.lane; idx < SEQ * 16; idx += NGW * 64) {
        const int s = idx >> 4, i = idx & 15;
        const float inv = (float)exp2(-(double)(2 * i) / 32.0 * 13.287712379549449);
        const float ang = (float)s * inv; float sn, cs; sincos_acc(ang, sn, cs);
        tab[idx] = make_float2(cs, sn);
    }
}
}
namespace mk {
namespace att {
using s16x4 = __attribute__((ext_vector_type(4))) short;
using f32x16 = __attribute__((ext_vector_type(16))) float;
typedef LAS const char* lds_cptr;
typedef short v4i16_t __attribute__((ext_vector_type(4)));
typedef __bf16 bf16x2_t __attribute__((ext_vector_type(2)));
constexpr float THRL = 8.f;
__device__ __forceinline__ int crow(int r, int hi) { return (r & 3) + 8 * (r >> 2) + 4 * hi; }
__device__ __forceinline__ void glds16(const void* gsrc, unsigned lds_dst) { unsigned keep;
    asm volatile("s_mov_b32 %0, m0\n\ts_mov_b32 m0, %2\n\ts_nop 0\n\tglobal_load_lds_dwordx4 %1, off\n\ts_mov_b32 m0, %0" : "=&s"(keep) : "v"(gsrc), "s"(lds_dst) : "memory"); }
__device__ __forceinline__ void glds16s(const void* sbase, unsigned voff, unsigned lds_dst) { unsigned keep;
    asm volatile("s_nop 4\n\ts_mov_b32 %0, m0\n\ts_mov_b32 m0, %3\n\ts_nop 0\n\tglobal_load_lds_dwordx4 %1, %2\n\ts_mov_b32 m0, %0" : "=&s"(keep) : "v"(voff), "s"(sbase), "s"(lds_dst) : "memory"); }
__device__ __forceinline__ void glds16s_x2(const void* b0, unsigned v0, unsigned d0, const void* b1, unsigned v1, unsigned d1) { unsigned keep;
    asm volatile("s_nop 4\n\ts_mov_b32 %0, m0\n\ts_mov_b32 m0, %3\n\ts_nop 0\n\tglobal_load_lds_dwordx4 %1, %2\n\ts_mov_b32 m0, %6\n\ts_nop 0\n\tglobal_load_lds_dwordx4 %4, %5\n\ts_mov_b32 m0, %0"
                 : "=&s"(keep) : "v"(v0), "s"(b0), "s"(d0), "v"(v1), "s"(b1), "s"(d1) : "memory"); }
__device__ __forceinline__ void glds16s_x3(const void* b0, unsigned v0, unsigned d0, const void* b1, unsigned v1, unsigned d1, const void* b2, unsigned v2, unsigned d2) { unsigned keep;
    asm volatile("s_nop 4\n\ts_mov_b32 %0, m0\n\ts_mov_b32 m0, %3\n\ts_nop 0\n\tglobal_load_lds_dwordx4 %1, %2\n\ts_mov_b32 m0, %6\n\ts_nop 0\n\tglobal_load_lds_dwordx4 %4, %5\n\ts_mov_b32 m0, %9\n\ts_nop 0\n\tglobal_load_lds_dwordx4 %7, %8\n\ts_mov_b32 m0, %0"
                 : "=&s"(keep) : "v"(v0), "s"(b0), "s"(d0), "v"(v1), "s"(b1), "s"(d1), "v"(v2), "s"(b2), "s"(d2) : "memory"); }
__device__ __forceinline__ const char* uptr(const void* p) { const unsigned long long v = (unsigned long long)p; const unsigned lo = __builtin_amdgcn_readfirstlane((unsigned)v), hi = __builtin_amdgcn_readfirstlane((unsigned)(v >> 32)); return (const char*)(((unsigned long long)hi << 32) | lo); }
__device__ __forceinline__ unsigned cvtpk_s(float lo, float hi) { f32x2 v = {lo, hi}; bf16x2_t b = __builtin_convertvector(v, bf16x2_t); return __builtin_bit_cast(unsigned, b); }
#define ATT_WAIT_BAR0() asm volatile("s_waitcnt vmcnt(0) lgkmcnt(0)\n\ts_barrier" ::: "memory")
#define ATT_LBAR() asm volatile("s_waitcnt lgkmcnt(0)\n\ts_barrier" ::: "memory")
#define ATT_WAIT_BARN(N) asm volatile("s_waitcnt vmcnt(" #N ") lgkmcnt(0)\n\ts_barrier" ::: "memory")
constexpr int ATT_WS_OFF = 131072 + 1024;
__device__ __forceinline__ s16x4 vtr(lds_cptr p) { return __builtin_bit_cast(s16x4, __builtin_amdgcn_ds_read_tr16_b64_v4i16((LAS v4i16_t*)p)); }

template <int ND0> __device__ __forceinline__ void qkt(f32x16& p0, f32x16& p1, lds_cptr kslot, const bf16x8* qr, int r32, int hi) {
    const lds_cptr kb = kslot + hi * 1024 + r32 * 16;
    p0 = f32x16{}; p1 = f32x16{};
#pragma unroll
    for (int d0 = 0; d0 < ND0; ++d0) {
        const bf16x8 b0 = *(const LAS bf16x8*)(kb + d0 * 2048);
        const bf16x8 b1 = *(const LAS bf16x8*)(kb + d0 * 2048 + 512);
        p0 = __builtin_amdgcn_mfma_f32_32x32x16_bf16(b0, qr[d0], p0, 0, 0, 0);
        p1 = __builtin_amdgcn_mfma_f32_32x32x16_bf16(b1, qr[d0], p1, 0, 0, 0);
    }
}
template <int NVB> __device__ __forceinline__ void pv(f32x16* o, lds_cptr vp, bf16x8 pa0, bf16x8 pa1, bf16x8 pa2, bf16x8 pa3) {
#pragma unroll
    for (int d0 = 0; d0 < NVB; ++d0) { s16x4 lo[4], hh[4];
#pragma unroll
        for (int ks = 0; ks < 4; ++ks) { lo[ks] = vtr(vp + d0 * 4096 + ks * 1024); hh[ks] = vtr(vp + d0 * 4096 + ks * 1024 + 512); }
#define ATT_PK(k) (bf16x8){lo[k][0], lo[k][1], lo[k][2], lo[k][3], hh[k][0], hh[k][1], hh[k][2], hh[k][3]}
        o[d0] = __builtin_amdgcn_mfma_f32_32x32x16_bf16(pa0, ATT_PK(0), o[d0], 0, 0, 0);
        o[d0] = __builtin_amdgcn_mfma_f32_32x32x16_bf16(pa1, ATT_PK(1), o[d0], 0, 0, 0);
        o[d0] = __builtin_amdgcn_mfma_f32_32x32x16_bf16(pa2, ATT_PK(2), o[d0], 0, 0, 0);
        o[d0] = __builtin_amdgcn_mfma_f32_32x32x16_bf16(pa3, ATT_PK(3), o[d0], 0, 0, 0);
#undef ATT_PK
    }
}
__device__ __forceinline__ float rowmax(const f32x16& p0, const f32x16& p1) {
    float a = fmaxf(p0[0], p1[0]);
#pragma unroll
    for (int r = 1; r < 16; ++r) a = fmaxf(a, fmaxf(p0[r], p1[r]));
    auto rr = __builtin_amdgcn_permlane32_swap(__float_as_uint(a), __float_as_uint(a), false, false);
    return fmaxf(__uint_as_float(rr[0]), __uint_as_float(rr[1]));
}
template <int NVB> __device__ __forceinline__ void softmax_step(f32x16& p0, f32x16& p1, float& m_reg, float& l_reg, f32x16* o, LAS float* wsf, int r32, int hi,
                                                                 bf16x8& pa0, bf16x8& pa1, bf16x8& pa2, bf16x8& pa3) {
    const float rm = rowmax(p0, p1);
    if (!__all(rm - m_reg <= THRL)) {
        const float mn = fmaxf(m_reg, rm), f = __builtin_amdgcn_exp2f(m_reg - mn);
        m_reg = mn; l_reg *= f;
        if (hi == 0) wsf[r32] = f;
        asm volatile("s_waitcnt lgkmcnt(0)" ::: "memory");
#pragma unroll
        for (int d = 0; d < NVB; ++d)
#pragma unroll
            for (int r = 0; r < 16; ++r) o[d][r] *= wsf[crow(r, hi)];
    }
    float s = 0.f;
#pragma unroll
    for (int r = 0; r < 16; ++r) { p0[r] = __builtin_amdgcn_exp2f(p0[r] - m_reg); p1[r] = __builtin_amdgcn_exp2f(p1[r] - m_reg); s += p0[r] + p1[r]; }
    l_reg += s;
    v4u w0 = {cvtpk_s(p0[0], p0[1]), cvtpk_s(p0[2], p0[3]), cvtpk_s(p0[4], p0[5]), cvtpk_s(p0[6], p0[7])};
    v4u w1 = {cvtpk_s(p0[8], p0[9]), cvtpk_s(p0[10], p0[11]), cvtpk_s(p0[12], p0[13]), cvtpk_s(p0[14], p0[15])};
    v4u w2 = {cvtpk_s(p1[0], p1[1]), cvtpk_s(p1[2], p1[3]), cvtpk_s(p1[4], p1[5]), cvtpk_s(p1[6], p1[7])};
    v4u w3 = {cvtpk_s(p1[8], p1[9]), cvtpk_s(p1[10], p1[11]), cvtpk_s(p1[12], p1[13]), cvtpk_s(p1[14], p1[15])};
    pa0 = __builtin_bit_cast(bf16x8, w0); pa1 = __builtin_bit_cast(bf16x8, w1); pa2 = __builtin_bit_cast(bf16x8, w2); pa3 = __builtin_bit_cast(bf16x8, w3);
}

template <int NVB> __device__ __forceinline__ void softmax_rel(f32x16& p0, f32x16& p1, float& mhat, float& l_reg, f32x16* o, LAS float* wsf, int r32, int hi,
                                                                bf16x8& pa0, bf16x8& pa1, bf16x8& pa2, bf16x8& pa3) {
    float a = fmaxf(fmaxf(p0[0], p0[1]), p1[0]), b = fmaxf(fmaxf(p0[2], p0[3]), p1[1]); a = fmaxf(fmaxf(a, p1[2]), p1[3]);
#pragma unroll
    for (int r = 4; r < 16; r += 4) { a = fmaxf(fmaxf(a, p0[r]), p0[r + 1]); b = fmaxf(fmaxf(b, p0[r + 2]), p0[r + 3]); a = fmaxf(fmaxf(a, p1[r]), p1[r + 1]); b = fmaxf(fmaxf(b, p1[r + 2]), p1[r + 3]); }
    float rm = fmaxf(a, b);
    { auto rr = __builtin_amdgcn_permlane32_swap(__float_as_uint(rm), __float_as_uint(rm), false, false); rm = fmaxf(__uint_as_float(rr[0]), __uint_as_float(rr[1])); }
    if (__builtin_expect(__any(rm > THRL), 0)) {
        const float dl = fmaxf(rm, 0.f), f = __builtin_amdgcn_exp2f(-dl);
        mhat += dl; l_reg *= f;
#pragma unroll
        for (int r = 0; r < 16; ++r) { p0[r] -= dl; p1[r] -= dl; }
        if (hi == 0) wsf[r32] = f;
        asm volatile("s_waitcnt lgkmcnt(0)" ::: "memory");
#pragma unroll
        for (int d = 0; d < NVB; ++d)
#pragma unroll
            for (int r = 0; r < 16; ++r) o[d][r] *= (wsf + 4 * hi)[(r & 3) + 8 * (r >> 2)];
    }
    float s = 0.f;
#pragma unroll
    for (int r = 0; r < 16; ++r) { p0[r] = __builtin_amdgcn_exp2f(p0[r]); p1[r] = __builtin_amdgcn_exp2f(p1[r]); s += p0[r] + p1[r]; }
    l_reg += s;
    v4u w0 = {cvtpk_s(p0[0], p0[1]), cvtpk_s(p0[2], p0[3]), cvtpk_s(p0[4], p0[5]), cvtpk_s(p0[6], p0[7])};
    v4u w1 = {cvtpk_s(p0[8], p0[9]), cvtpk_s(p0[10], p0[11]), cvtpk_s(p0[12], p0[13]), cvtpk_s(p0[14], p0[15])};
    v4u w2 = {cvtpk_s(p1[0], p1[1]), cvtpk_s(p1[2], p1[3]), cvtpk_s(p1[4], p1[5]), cvtpk_s(p1[6], p1[7])};
    v4u w3 = {cvtpk_s(p1[8], p1[9]), cvtpk_s(p1[10], p1[11]), cvtpk_s(p1[12], p1[13]), cvtpk_s(p1[14], p1[15])};
    pa0 = __builtin_bit_cast(bf16x8, w0); pa1 = __builtin_bit_cast(bf16x8, w1); pa2 = __builtin_bit_cast(bf16x8, w2); pa3 = __builtin_bit_cast(bf16x8, w3);
}
template <int ND0> __device__ __forceinline__ void qkt_c(f32x16& p0, f32x16& p1, lds_cptr kslot, const bf16x8* qr, const f32x16& c0, const f32x16& c1, int r32, int hi) {
    const lds_cptr kb = kslot + hi * 1024 + r32 * 16;
#pragma unroll
    for (int d0 = 0; d0 < ND0; ++d0) {
        const bf16x8 b0 = *(const LAS bf16x8*)(kb + d0 * 2048);
        const bf16x8 b1 = *(const LAS bf16x8*)(kb + d0 * 2048 + 512);
        if (d0 == 0) { p0 = __builtin_amdgcn_mfma_f32_32x32x16_bf16(b0, qr[0], c0, 0, 0, 0); p1 = __builtin_amdgcn_mfma_f32_32x32x16_bf16(b1, qr[0], c1, 0, 0, 0); }
        else { p0 = __builtin_amdgcn_mfma_f32_32x32x16_bf16(b0, qr[d0], p0, 0, 0, 0); p1 = __builtin_amdgcn_mfma_f32_32x32x16_bf16(b1, qr[d0], p1, 0, 0, 0); }
    }
}
#define ATT_NEXT(x) (((x) == (NSLOT - 1) * BUF) ? 0 : (x) + BUF)
#define ATT_SBAR() __builtin_amdgcn_sched_barrier(0)
#define ATT_PK2(L, H) (bf16x8){L[0], L[1], L[2], L[3], H[0], H[1], H[2], H[3]}


constexpr int MLA_KB = 12 * 1024, MLA_VB = 8 * 1024, MLA_BUF = MLA_KB + MLA_VB, MLA_NSLOT = 5, MLA_D = 3, MLA_WS = ATT_WS_OFF, MLA_OST = 0;
__device__ __forceinline__ void mla_unit(int b, int h, int qb, const bf16* QM, const bf16* KVM, const bf16* KROT, bf16* OCAT, LAS char* shm) {
    constexpr int BUF = MLA_BUF, NSLOT = MLA_NSLOT, D = MLA_D;
    const int tid = threadIdx.x, lane = tid & 63, r32 = lane & 31, hi = lane >> 5; const int wid = __builtin_amdgcn_readfirstlane(tid >> 6);
    const bool lead = wid < 4;
    const long rowbase = (long)b * SEQ; const int q0 = qb * 256;
    const unsigned lds0 = (unsigned)(uintptr_t)shm;
    LAS float* wsf = (LAS float*)(shm + MLA_WS) + wid * 64;
    bf16x8 qr[6];
    { const bf16* Qw = QM + (rowbase + q0 + wid * 32 + r32) * 768 + h * 96 + hi * 8;
#pragma unroll
      for (int d0 = 0; d0 < 6; ++d0) qr[d0] = *(const bf16x8*)(Qw + d0 * 16); }
    const char* kvbase = (const char*)(KVM + rowbase * 1024 + h * 128); const char* krbase = (const char*)(KROT + rowbase * 32);
    const unsigned koffA = (unsigned)(lane * 1024 + wid * 8) * 2u;
    const unsigned koffB = (unsigned)(lane * 32 + (wid & 3) * 8) * 2u;
    const unsigned voffs = (unsigned)((16 * (wid & 3) + (lane >> 2)) * 1024 + 64 + (wid >> 2) * 32 + (lane & 3) * 8) * 2u;
#define MLA_DMA(t, sl) do { const unsigned base_ = lds0 + (sl); const char* kvt_ = uptr(kvbase + (size_t)(t) * (64 * 1024 * 2)); \
        glds16s(kvt_, koffA, (unsigned)__builtin_amdgcn_readfirstlane(base_ + wid * 1024)); \
        if (wid < 4) glds16s(uptr(krbase + (size_t)(t) * (64 * 32 * 2)), koffB, (unsigned)__builtin_amdgcn_readfirstlane(base_ + (8 + wid) * 1024)); \
        glds16s(kvt_, voffs, (unsigned)__builtin_amdgcn_readfirstlane(base_ + MLA_KB + wid * 1024)); } while (0)
    const int vofs = ((lane >> 4) & 1) * 32 + (lane & 3) * 8 + (4 * hi + ((lane & 15) >> 2)) * 64;
    const int kofs = hi * 1024 + r32 * 16;
    float mhat = 0.f, l_reg = 0.f; f32x16 o[2]; o[0] = f32x16{}; o[1] = f32x16{};
    f32x16 p0, p1; bf16x8 pa0, pa1, pa2, pa3; bf16x8 kf[12]; s16x4 vlo[8], vhh[8];
    constexpr int NT = SEQ / 64;
#define MLA_KLOAD(sl) do { const lds_cptr kb_ = (lds_cptr)shm + (sl) + kofs; _Pragma("unroll") for (int d0 = 0; d0 < 6; ++d0) { \
        kf[2 * d0] = *(const LAS bf16x8*)(kb_ + d0 * 2048); kf[2 * d0 + 1] = *(const LAS bf16x8*)(kb_ + d0 * 2048 + 512); } } while (0)
#define MLA_QK() do { f32x16 c_; _Pragma("unroll") for (int r = 0; r < 16; ++r) c_[r] = -mhat; \
        p0 = __builtin_amdgcn_mfma_f32_32x32x16_bf16(kf[0], qr[0], c_, 0, 0, 0); p1 = __builtin_amdgcn_mfma_f32_32x32x16_bf16(kf[1], qr[0], c_, 0, 0, 0); \
        _Pragma("unroll") for (int d0 = 1; d0 < 6; ++d0) { p0 = __builtin_amdgcn_mfma_f32_32x32x16_bf16(kf[2 * d0], qr[d0], p0, 0, 0, 0); p1 = __builtin_amdgcn_mfma_f32_32x32x16_bf16(kf[2 * d0 + 1], qr[d0], p1, 0, 0, 0); } } while (0)
#define MLA_VLOAD(sl) do { const lds_cptr vp_ = (lds_cptr)shm + (sl) + MLA_KB + vofs; _Pragma("unroll") for (int i = 0; i < 8; ++i) { \
        vlo[i] = vtr(vp_ + (i >> 2) * 4096 + (i & 3) * 1024); vhh[i] = vtr(vp_ + (i >> 2) * 4096 + (i & 3) * 1024 + 512); } } while (0)
#define MLA_PV() do { _Pragma("unroll") for (int d0 = 0; d0 < 2; ++d0) { \
        o[d0] = __builtin_amdgcn_mfma_f32_32x32x16_bf16(pa0, ATT_PK2(vlo[d0 * 4 + 0], vhh[d0 * 4 + 0]), o[d0], 0, 0, 0); o[d0] = __builtin_amdgcn_mfma_f32_32x32x16_bf16(pa1, ATT_PK2(vlo[d0 * 4 + 1], vhh[d0 * 4 + 1]), o[d0], 0, 0, 0); \
        o[d0] = __builtin_amdgcn_mfma_f32_32x32x16_bf16(pa2, ATT_PK2(vlo[d0 * 4 + 2], vhh[d0 * 4 + 2]), o[d0], 0, 0, 0); o[d0] = __builtin_amdgcn_mfma_f32_32x32x16_bf16(pa3, ATT_PK2(vlo[d0 * 4 + 3], vhh[d0 * 4 + 3]), o[d0], 0, 0, 0); } } while (0)
#define MLA_BAR(t) do { if ((t) + D < NT) { if (lead) ATT_WAIT_BARN(6); else ATT_WAIT_BARN(4); } else ATT_WAIT_BAR0(); } while (0)
    MLA_DMA(0, 0); MLA_DMA(1, BUF); MLA_DMA(2, 2 * BUF); MLA_DMA(3, 3 * BUF);
    if (lead) { ATT_WAIT_BARN(9); } else { ATT_WAIT_BARN(6); ATT_WAIT_BARN(6); }
    int s_v = 0, s_k = BUF, s_d = 4 * BUF;
    MLA_KLOAD(0); MLA_QK();
    for (int t = 0; t < NT; ++t) {
        MLA_BAR(t);
        if (t + 1 + D < NT) MLA_DMA(t + 1 + D, s_d);
        MLA_VLOAD(s_v); ATT_SBAR();
        softmax_rel<2>(p0, p1, mhat, l_reg, o, wsf, r32, hi, pa0, pa1, pa2, pa3);
        MLA_BAR(t);
        __builtin_amdgcn_s_setprio(2);
        if (t + 1 < NT) { MLA_KLOAD(s_k); } ATT_SBAR();
        MLA_PV();
        if (t + 1 < NT) { MLA_QK(); }
        __builtin_amdgcn_s_setprio(0);
        s_v = s_k; s_k = ATT_NEXT(s_k); s_d = ATT_NEXT(s_d);
    }
    if (lead) ATT_LBAR();
    ATT_LBAR();
#undef MLA_DMA
#undef MLA_KLOAD
#undef MLA_QK
#undef MLA_VLOAD
#undef MLA_PV
#undef MLA_BAR
    int lane_e = lane; asm volatile("" : "+v"(lane_e)); const int r32e = lane_e & 31, hie = lane_e >> 5;
    { auto rr = __builtin_amdgcn_permlane32_swap(__float_as_uint(l_reg), __float_as_uint(l_reg), false, false); l_reg = __uint_as_float(rr[0]) + __uint_as_float(rr[1]); }
    if (hie == 0) wsf[32 + r32e] = l_reg;
    asm volatile("s_waitcnt lgkmcnt(0)" ::: "memory");
    float rli[16];
#pragma unroll
    for (int r = 0; r < 16; ++r) rli[r] = __builtin_amdgcn_rcpf((wsf + 32 + 4 * hie)[(r & 3) + 8 * (r >> 2)]);
    bf16* Ow = OCAT + (rowbase + q0 + wid * 32) * 1024 + h * 64;
    { LAS bf16* stg = (LAS bf16*)(shm + MLA_OST) + wid * 2048;
#pragma unroll
      for (int r = 0; r < 16; ++r) { const int orow = crow(r, hie);
#pragma unroll
          for (int d0 = 0; d0 < 2; ++d0) stg[orow * 64 + d0 * 32 + r32e] = (bf16)(cvtpk_s(o[d0][r] * rli[r], 0.f) & 0xffffu); }
      asm volatile("s_waitcnt lgkmcnt(0)" ::: "memory");
#pragma unroll
      for (int i = 0; i < 4; ++i) { const int row = i * 8 + (lane_e >> 3), ch = lane_e & 7; const v4u v = *(const LAS v4u*)(stg + row * 64 + ch * 8); *(v4u*)(Ow + (long)row * 1024 + ch * 8) = v; } }
    ATT_LBAR();
}

constexpr int DF_KB = 16 * 1024, DF_VB = 16 * 1024, DF_BUF = DF_KB + DF_VB, DF_NSLOT = 4, DF_D = 2, DF_WS = ATT_WS_OFF, DF_X = 0, DF_OST = 65536;
__device__ __forceinline__ void diff_unit(int b, int h, int qb, int t_lo, int NT, const bf16* QD, const bf16* KD, const bf16* VD, bf16* OCAT, float lam, const float* gsub, LAS char* shm) {
    constexpr int BUF = DF_BUF, NSLOT = DF_NSLOT, D = DF_D;
    const int tid = threadIdx.x, lane = tid & 63, r32 = lane & 31, hi = lane >> 5; const int wid = __builtin_amdgcn_readfirstlane(tid >> 6);
    const int w4 = wid & 3, mp = wid >> 2; const bool lead = mp == 0;
    const long rowbase = (long)b * SEQ; const int q0 = qb * 128;
    const unsigned lds0 = (unsigned)(uintptr_t)shm;
    LAS float* wsf = (LAS float*)(shm + DF_WS) + wid * 64;
    bf16x8 qr[4];
    { const bf16* Qw = QD + (rowbase + q0 + w4 * 32 + r32) * 512 + h * 128 + mp * 64 + hi * 8;
#pragma unroll
      for (int d0 = 0; d0 < 4; ++d0) qr[d0] = *(const bf16x8*)(Qw + d0 * 16); }
    const char* kbase = (const char*)(KD + rowbase * 512 + h * 128); const char* vbase = (const char*)(VD + rowbase * 512 + h * 128);
    const unsigned koffs = (unsigned)(lane * 512 + wid * 8) * 2u;
    const unsigned voffs = (unsigned)((16 * (wid & 3) + (lane >> 2)) * 512 + (wid >> 2) * 32 + (lane & 3) * 8) * 2u;
#define DF_DMA(t, sl) do { const unsigned base_ = lds0 + (sl); const char* kt_ = uptr(kbase + (size_t)(t) * (64 * 512 * 2)); const char* vt_ = uptr(vbase + (size_t)(t) * (64 * 512 * 2)); \
        glds16s(kt_, koffs, (unsigned)__builtin_amdgcn_readfirstlane(base_ + wid * 1024)); \
        glds16s(kt_ + 128, koffs, (unsigned)__builtin_amdgcn_readfirstlane(base_ + (8 + wid) * 1024)); \
        glds16s(vt_, voffs, (unsigned)__builtin_amdgcn_readfirstlane(base_ + DF_KB + wid * 1024)); \
        glds16s(vt_ + 128, voffs, (unsigned)__builtin_amdgcn_readfirstlane(base_ + DF_KB + (8 + wid) * 1024)); } while (0)
    const int vofs = ((lane >> 4) & 1) * 32 + (lane & 3) * 8 + (4 * hi + ((lane & 15) >> 2)) * 64;
    const int kofs = mp * 8192 + hi * 1024 + r32 * 16;
    const float sl2 = __builtin_amdgcn_exp2f(-2.f * (float)(h + 1)) * LOG2E;
    const int qpos = q0 + w4 * 32 + r32;
    const int t_d = (q0 + w4 * 32) >> 6;
    float mhat = 0.f, l_reg = 0.f; f32x16 o[4]; o[0] = f32x16{}; o[1] = f32x16{}; o[2] = f32x16{}; o[3] = f32x16{};
    f32x16 p0, p1; bf16x8 pa0, pa1, pa2, pa3; bf16x8 kf[8]; s16x4 vlo[8], vhh[8], vl2[8], vh2[8];
#define DF_KLOAD(sl) do { const lds_cptr kb_ = (lds_cptr)shm + (sl) + kofs; _Pragma("unroll") for (int d0 = 0; d0 < 4; ++d0) { \
        kf[2 * d0] = *(const LAS bf16x8*)(kb_ + d0 * 2048); kf[2 * d0 + 1] = *(const LAS bf16x8*)(kb_ + d0 * 2048 + 512); } } while (0)
#define DF_QK(t) do { f32x16 c0_, c1_; \
        if ((t) != t_d) { float sg_ = (t) < t_d ? sl2 : -sl2; asm volatile("" : "+v"(sg_)); const float base_ = sg_ * (float)((t) * 64 + 4 * hi - qpos) - mhat; \
            _Pragma("unroll") for (int r = 0; r < 16; ++r) { c0_[r] = fmaf(sg_, (float)((r & 3) + 8 * (r >> 2)), base_); c1_[r] = c0_[r] + 32.f * sg_; } } \
        else { _Pragma("unroll") for (int r = 0; r < 16; ++r) { c0_[r] = -mhat; c1_[r] = -mhat; } } \
        p0 = __builtin_amdgcn_mfma_f32_32x32x16_bf16(kf[0], qr[0], c0_, 0, 0, 0); p1 = __builtin_amdgcn_mfma_f32_32x32x16_bf16(kf[1], qr[0], c1_, 0, 0, 0); \
        _Pragma("unroll") for (int d0 = 1; d0 < 4; ++d0) { p0 = __builtin_amdgcn_mfma_f32_32x32x16_bf16(kf[2 * d0], qr[d0], p0, 0, 0, 0); p1 = __builtin_amdgcn_mfma_f32_32x32x16_bf16(kf[2 * d0 + 1], qr[d0], p1, 0, 0, 0); } \
        if ((t) == t_d) { int d0_ = qpos - ((t) * 64 + 4 * hi); asm volatile("" : "+v"(d0_)); \
            _Pragma("unroll") for (int r = 0; r < 16; ++r) { const int d = d0_ - ((r & 3) + 8 * (r >> 2)); p0[r] -= sl2 * fabsf((float)d); p1[r] -= sl2 * fabsf((float)(d - 32)); } } } while (0)
#define DF_VLOAD(sl) do { const lds_cptr vp_ = (lds_cptr)shm + (sl) + DF_KB + vofs; _Pragma("unroll") for (int i = 0; i < 8; ++i) { \
        vlo[i] = vtr(vp_ + (i >> 2) * 4096 + (i & 3) * 1024); vhh[i] = vtr(vp_ + (i >> 2) * 4096 + (i & 3) * 1024 + 512); } } while (0)
#define DF_VLOAD2(sl) do { const lds_cptr vp_ = (lds_cptr)shm + (sl) + DF_KB + vofs + 8192; _Pragma("unroll") for (int i = 0; i < 8; ++i) { \
        vl2[i] = vtr(vp_ + (i >> 2) * 4096 + (i & 3) * 1024); vh2[i] = vtr(vp_ + (i >> 2) * 4096 + (i & 3) * 1024 + 512); } } while (0)
#define DF_PV4(OB, VL, VH) do { _Pragma("unroll") for (int d0 = 0; d0 < 2; ++d0) { \
        o[OB + d0] = __builtin_amdgcn_mfma_f32_32x32x16_bf16(pa0, ATT_PK2(VL[d0 * 4 + 0], VH[d0 * 4 + 0]), o[OB + d0], 0, 0, 0); o[OB + d0] = __builtin_amdgcn_mfma_f32_32x32x16_bf16(pa1, ATT_PK2(VL[d0 * 4 + 1], VH[d0 * 4 + 1]), o[OB + d0], 0, 0, 0); \
        o[OB + d0] = __builtin_amdgcn_mfma_f32_32x32x16_bf16(pa2, ATT_PK2(VL[d0 * 4 + 2], VH[d0 * 4 + 2]), o[OB + d0], 0, 0, 0); o[OB + d0] = __builtin_amdgcn_mfma_f32_32x32x16_bf16(pa3, ATT_PK2(VL[d0 * 4 + 3], VH[d0 * 4 + 3]), o[OB + d0], 0, 0, 0); } } while (0)
#define DF_BAR(t) do { if ((t) + D < NT) ATT_WAIT_BARN(4); else ATT_WAIT_BAR0(); } while (0)
    DF_DMA(t_lo, 0); DF_DMA(t_lo + 1, BUF); DF_DMA(t_lo + 2, 2 * BUF);
    if (lead) { ATT_WAIT_BARN(8); } else { ATT_WAIT_BARN(8); ATT_WAIT_BARN(8); }
    int s_v = 0, s_k = BUF, s_d = 3 * BUF;
    DF_KLOAD(0); DF_QK(t_lo);
    for (int t = 0; t < NT; ++t) {
        DF_BAR(t);
        DF_VLOAD(s_v); ATT_SBAR();
        softmax_rel<4>(p0, p1, mhat, l_reg, o, wsf, r32, hi, pa0, pa1, pa2, pa3);
        DF_BAR(t);
        __builtin_amdgcn_s_setprio(2);
        if (t + 1 + D < NT) DF_DMA(t_lo + t + 1 + D, s_d);
        DF_VLOAD2(s_v); ATT_SBAR();
        DF_PV4(0, vlo, vhh); ATT_SBAR();
        if (t + 1 < NT) { DF_KLOAD(s_k); } ATT_SBAR();
        DF_PV4(2, vl2, vh2);
        if (t + 1 < NT) { DF_QK(t_lo + t + 1); }
        __builtin_amdgcn_s_setprio(0);
        s_v = s_k; s_k = ATT_NEXT(s_k); s_d = ATT_NEXT(s_d);
    }
    if (lead) ATT_LBAR();
#undef DF_DMA
#undef DF_KLOAD
#undef DF_QK
#undef DF_VLOAD
#undef DF_VLOAD2
#undef DF_PV4
#undef DF_BAR
    int lane_e = lane; asm volatile("" : "+v"(lane_e)); const int r32e = lane_e & 31, hie = lane_e >> 5;
    { auto rr = __builtin_amdgcn_permlane32_swap(__float_as_uint(l_reg), __float_as_uint(l_reg), false, false); l_reg = __uint_as_float(rr[0]) + __uint_as_float(rr[1]); }
    if (hie == 0) wsf[32 + r32e] = l_reg;
    asm volatile("s_waitcnt lgkmcnt(0)" ::: "memory");
#pragma unroll
    for (int r = 0; r < 16; ++r) { const float rl_ = __builtin_amdgcn_rcpf((wsf + 32 + 4 * hie)[(r & 3) + 8 * (r >> 2)]) * (mp == 1 ? lam : 1.f);
#pragma unroll
        for (int d0 = 0; d0 < 4; ++d0) o[d0][r] *= rl_; }
    ATT_LBAR();
    LAS float* X = (LAS float*)(shm + DF_X);
    if (mp == 1) {
#pragma unroll
        for (int r = 0; r < 16; ++r) { LAS float* xr = X + (w4 * 32 + 4 * hie) * 128 + r32e;
#pragma unroll
            for (int d0 = 0; d0 < 4; ++d0) xr[((r & 3) + 8 * (r >> 2)) * 128 + d0 * 32] = o[d0][r]; }
    }
    ATT_LBAR();
    if (mp == 0) {
        float gs[4];
#pragma unroll
        for (int d0 = 0; d0 < 4; ++d0) gs[d0] = gsub[d0 * 32 + r32e] * 0.8f;
        LAS bf16* stg = (LAS bf16*)(shm + DF_OST) + w4 * 4096 + 4 * hie * 128 + r32e;
        const LAS float* xr = X + (w4 * 32 + 4 * hie) * 128 + r32e;
#pragma unroll
        for (int r = 0; r < 16; ++r) { const int c0r = (r & 3) + 8 * (r >> 2); float v[4]; float ss = 0.f;
#pragma unroll
            for (int d0 = 0; d0 < 4; ++d0) { v[d0] = o[d0][r] - xr[c0r * 128 + d0 * 32]; ss += v[d0] * v[d0]; }
            ss += __int_as_float(__builtin_amdgcn_ds_swizzle(__float_as_int(ss), 0x041F)); ss += __int_as_float(__builtin_amdgcn_ds_swizzle(__float_as_int(ss), 0x081F));
            ss += __int_as_float(__builtin_amdgcn_ds_swizzle(__float_as_int(ss), 0x101F)); ss += __int_as_float(__builtin_amdgcn_ds_swizzle(__float_as_int(ss), 0x201F));
            ss += __int_as_float(__builtin_amdgcn_ds_swizzle(__float_as_int(ss), 0x401F));
            const float rr = __builtin_amdgcn_rsqf(ss * (1.f / 128.f) + EPS);
#pragma unroll
            for (int d0 = 0; d0 < 4; ++d0) stg[c0r * 128 + d0 * 32] = (bf16)(cvtpk_s(v[d0] * rr * gs[d0], 0.f) & 0xffffu); }
        asm volatile("s_waitcnt lgkmcnt(0)" ::: "memory");
        bf16* Ow = OCAT + (rowbase + q0 + w4 * 32) * 1024 + 512 + h * 128;
        const LAS bf16* stg0 = (const LAS bf16*)(shm + DF_OST) + w4 * 4096;
#pragma unroll
        for (int i = 0; i < 8; ++i) { const int row = i * 4 + (lane_e >> 4), ch = lane_e & 15; const v4u v = *(const LAS v4u*)(stg0 + row * 128 + ch * 8); *(v4u*)(Ow + (long)row * 1024 + ch * 8) = v; }
    }
    ATT_LBAR();
}
}
}
namespace mk {
namespace att {
constexpr int MKH0 = 32 * 128, MKH1 = 32 * 64;
__device__ __forceinline__ void mla_step_a(f32x16* o, f32x16& S0, f32x16& S1, f32x16& T0, f32x16& T1, const bf16x8 pw0, const bf16x8 pw1, const bf16x8 pw2, const bf16x8 pw3, v4u& n0, v4u& n1, v4u& n2, v4u& n3, const bf16x8* qr, lds_cptr vp, lds_cptr ks, const int* kb, lds_cptr vpn, s16x4& f0l, s16x4& f0h, s16x4& f1l, s16x4& f1h, s16x4& f2l, s16x4& f2h, s16x4& f3l, s16x4& f3h, s16x4& f4l, s16x4& f4h, bf16x8& k0, bf16x8& k1, bf16x8& k2, bf16x8& k3, bf16x8& k4, float& sacc) {
    f4l = vtr(vp + 4096); f4h = vtr(vp + 4096 + 512);
    o[0] = __builtin_amdgcn_mfma_f32_32x32x16_bf16(pw0, ATT_PK2(f0l, f0h), o[0], 0, 0, 0);
    T0[0] = __builtin_amdgcn_exp2f(T0[0]);
    T0[1] = __builtin_amdgcn_exp2f(T0[1]);
    T0[2] = __builtin_amdgcn_exp2f(T0[2]);
    asm volatile("" : "+v"(T0), "+v"(T1), "+v"(n0), "+v"(n1), "+v"(n2), "+v"(n3), "+v"(sacc)); ATT_SBAR();
    f0l = vtr(vp + 5120); f0h = vtr(vp + 5120 + 512);
    o[0] = __builtin_amdgcn_mfma_f32_32x32x16_bf16(pw1, ATT_PK2(f1l, f1h), o[0], 0, 0, 0);
    T0[3] = __builtin_amdgcn_exp2f(T0[3]);
    sacc += T0[0];
    n0[0] = cvtpk_s(T0[0], T0[1]);
    sacc += T0[1];
    asm volatile("" : "+v"(T0), "+v"(T1), "+v"(n0), "+v"(n1), "+v"(n2), "+v"(n3), "+v"(sacc)); ATT_SBAR();
    f1l = vtr(vp + 6144); f1h = vtr(vp + 6144 + 512);
    o[0] = __builtin_amdgcn_mfma_f32_32x32x16_bf16(pw2, ATT_PK2(f2l, f2h), o[0], 0, 0, 0);
    T0[4] = __builtin_amdgcn_exp2f(T0[4]);
    T0[5] = __builtin_amdgcn_exp2f(T0[5]);
    sacc += T0[2];
    n0[1] = cvtpk_s(T0[2], T0[3]);
    asm volatile("" : "+v"(T0), "+v"(T1), "+v"(n0), "+v"(n1), "+v"(n2), "+v"(n3), "+v"(sacc)); ATT_SBAR();
    f2l = vtr(vp + 7168); f2h = vtr(vp + 7168 + 512);
    o[0] = __builtin_amdgcn_mfma_f32_32x32x16_bf16(pw3, ATT_PK2(f3l, f3h), o[0], 0, 0, 0);
    sacc += T0[3];
    T0[6] = __builtin_amdgcn_exp2f(T0[6]);
    T0[7] = __builtin_amdgcn_exp2f(T0[7]);
    sacc += T0[4];
    asm volatile("" : "+v"(T0), "+v"(T1), "+v"(n0), "+v"(n1), "+v"(n2), "+v"(n3), "+v"(sacc)); ATT_SBAR();
    k0 = *(const LAS bf16x8*)(ks + kb[0] + 0 * MKH0);
    o[1] = __builtin_amdgcn_mfma_f32_32x32x16_bf16(pw0, ATT_PK2(f4l, f4h), o[1], 0, 0, 0);
    n0[2] = cvtpk_s(T0[4], T0[5]);
    sacc += T0[5];
    T0[8] = __builtin_amdgcn_exp2f(T0[8]);
    T0[9] = __builtin_amdgcn_exp2f(T0[9]);
    asm volatile("" : "+v"(T0), "+v"(T1), "+v"(n0), "+v"(n1), "+v"(n2), "+v"(n3), "+v"(sacc)); ATT_SBAR();
    k1 = *(const LAS bf16x8*)(ks + kb[0] + 1 * MKH0);
    o[1] = __builtin_amdgcn_mfma_f32_32x32x16_bf16(pw1, ATT_PK2(f0l, f0h), o[1], 0, 0, 0);
    sacc += T0[6];
    n0[3] = cvtpk_s(T0[6], T0[7]);
    sacc += T0[7];
    T0[10] = __builtin_amdgcn_exp2f(T0[10]);
    asm volatile("" : "+v"(T0), "+v"(T1), "+v"(n0), "+v"(n1), "+v"(n2), "+v"(n3), "+v"(sacc)); ATT_SBAR();
    k2 = *(const LAS bf16x8*)(ks + kb[1] + 0 * MKH0);
    o[1] = __builtin_amdgcn_mfma_f32_32x32x16_bf16(pw2, ATT_PK2(f1l, f1h), o[1], 0, 0, 0);
    T0[11] = __builtin_amdgcn_exp2f(T0[11]);
    sacc += T0[8];
    n1[0] = cvtpk_s(T0[8], T0[9]);
    sacc += T0[9];
    asm volatile("" : "+v"(T0), "+v"(T1), "+v"(n0), "+v"(n1), "+v"(n2), "+v"(n3), "+v"(sacc)); ATT_SBAR();
    k3 = *(const LAS bf16x8*)(ks + kb[1] + 1 * MKH0);
    o[1] = __builtin_amdgcn_mfma_f32_32x32x16_bf16(pw3, ATT_PK2(f2l, f2h), o[1], 0, 0, 0);
    T0[12] = __builtin_amdgcn_exp2f(T0[12]);
    T0[13] = __builtin_amdgcn_exp2f(T0[13]);
    sacc += T0[10];
    n1[1] = cvtpk_s(T0[10], T0[11]);
    asm volatile("" : "+v"(T0), "+v"(T1), "+v"(n0), "+v"(n1), "+v"(n2), "+v"(n3), "+v"(sacc)); ATT_SBAR();
    k4 = *(const LAS bf16x8*)(ks + kb[2] + 0 * MKH0);
    S0 = __builtin_amdgcn_mfma_f32_32x32x16_bf16(k0, qr[0], f32x16{}, 0, 0, 0);
    sacc += T0[11];
    T0[14] = __builtin_amdgcn_exp2f(T0[14]);
    T0[15] = __builtin_amdgcn_exp2f(T0[15]);
    sacc += T0[12];
    asm volatile("" : "+v"(T0), "+v"(T1), "+v"(n0), "+v"(n1), "+v"(n2), "+v"(n3), "+v"(sacc)); ATT_SBAR();
    k0 = *(const LAS bf16x8*)(ks + kb[2] + 1 * MKH0);
    S1 = __builtin_amdgcn_mfma_f32_32x32x16_bf16(k1, qr[0], f32x16{}, 0, 0, 0);
    n1[2] = cvtpk_s(T0[12], T0[13]);
    sacc += T0[13];
    T1[0] = __builtin_amdgcn_exp2f(T1[0]);
    T1[1] = __builtin_amdgcn_exp2f(T1[1]);
    asm volatile("" : "+v"(T0), "+v"(T1), "+v"(n0), "+v"(n1), "+v"(n2), "+v"(n3), "+v"(sacc)); ATT_SBAR();
}
__device__ __forceinline__ void mla_step_b(f32x16* o, f32x16& S0, f32x16& S1, f32x16& T0, f32x16& T1, const bf16x8 pw0, const bf16x8 pw1, const bf16x8 pw2, const bf16x8 pw3, v4u& n0, v4u& n1, v4u& n2, v4u& n3, const bf16x8* qr, lds_cptr vp, lds_cptr ks, const int* kb, lds_cptr vpn, s16x4& f0l, s16x4& f0h, s16x4& f1l, s16x4& f1h, s16x4& f2l, s16x4& f2h, s16x4& f3l, s16x4& f3h, s16x4& f4l, s16x4& f4h, bf16x8& k0, bf16x8& k1, bf16x8& k2, bf16x8& k3, bf16x8& k4, float& sacc) {
    k1 = *(const LAS bf16x8*)(ks + kb[3] + 0 * MKH0);
    S0 = __builtin_amdgcn_mfma_f32_32x32x16_bf16(k2, qr[1], S0, 0, 0, 0);
    sacc += T0[14];
    n1[3] = cvtpk_s(T0[14], T0[15]);
    sacc += T0[15];
    T1[2] = __builtin_amdgcn_exp2f(T1[2]);
    asm volatile("" : "+v"(T0), "+v"(T1), "+v"(n0), "+v"(n1), "+v"(n2), "+v"(n3), "+v"(sacc)); ATT_SBAR();
    k2 = *(const LAS bf16x8*)(ks + kb[3] + 1 * MKH0);
    S1 = __builtin_amdgcn_mfma_f32_32x32x16_bf16(k3, qr[1], S1, 0, 0, 0);
    T1[3] = __builtin_amdgcn_exp2f(T1[3]);
    sacc += T1[0];
    n2[0] = cvtpk_s(T1[0], T1[1]);
    sacc += T1[1];
    asm volatile("" : "+v"(T0), "+v"(T1), "+v"(n0), "+v"(n1), "+v"(n2), "+v"(n3), "+v"(sacc)); ATT_SBAR();
    k3 = *(const LAS bf16x8*)(ks + kb[4] + 0 * MKH1);
    S0 = __builtin_amdgcn_mfma_f32_32x32x16_bf16(k4, qr[2], S0, 0, 0, 0);
    T1[4] = __builtin_amdgcn_exp2f(T1[4]);
    T1[5] = __builtin_amdgcn_exp2f(T1[5]);
    sacc += T1[2];
    n2[1] = cvtpk_s(T1[2], T1[3]);
    asm volatile("" : "+v"(T0), "+v"(T1), "+v"(n0), "+v"(n1), "+v"(n2), "+v"(n3), "+v"(sacc)); ATT_SBAR();
    k4 = *(const LAS bf16x8*)(ks + kb[4] + 1 * MKH1);
    S1 = __builtin_amdgcn_mfma_f32_32x32x16_bf16(k0, qr[2], S1, 0, 0, 0);
    sacc += T1[3];
    T1[6] = __builtin_amdgcn_exp2f(T1[6]);
    T1[7] = __builtin_amdgcn_exp2f(T1[7]);
    sacc += T1[4];
    asm volatile("" : "+v"(T0), "+v"(T1), "+v"(n0), "+v"(n1), "+v"(n2), "+v"(n3), "+v"(sacc)); ATT_SBAR();
    k0 = *(const LAS bf16x8*)(ks + kb[5] + 0 * MKH1);
    S0 = __builtin_amdgcn_mfma_f32_32x32x16_bf16(k1, qr[3], S0, 0, 0, 0);
    n2[2] = cvtpk_s(T1[4], T1[5]);
    sacc += T1[5];
    T1[8] = __builtin_amdgcn_exp2f(T1[8]);
    T1[9] = __builtin_amdgcn_exp2f(T1[9]);
    asm volatile("" : "+v"(T0), "+v"(T1), "+v"(n0), "+v"(n1), "+v"(n2), "+v"(n3), "+v"(sacc)); ATT_SBAR();
    k1 = *(const LAS bf16x8*)(ks + kb[5] + 1 * MKH1);
    S1 = __builtin_amdgcn_mfma_f32_32x32x16_bf16(k2, qr[3], S1, 0, 0, 0);
    sacc += T1[6];
    n2[3] = cvtpk_s(T1[6], T1[7]);
    sacc += T1[7];
    T1[10] = __builtin_amdgcn_exp2f(T1[10]);
    asm volatile("" : "+v"(T0), "+v"(T1), "+v"(n0), "+v"(n1), "+v"(n2), "+v"(n3), "+v"(sacc)); ATT_SBAR();
    f0l = vtr(vpn + 0); f0h = vtr(vpn + 0 + 512);
    S0 = __builtin_amdgcn_mfma_f32_32x32x16_bf16(k3, qr[4], S0, 0, 0, 0);
    T1[11] = __builtin_amdgcn_exp2f(T1[11]);
    sacc += T1[8];
    n3[0] = cvtpk_s(T1[8], T1[9]);
    sacc += T1[9];
    asm volatile("" : "+v"(T0), "+v"(T1), "+v"(n0), "+v"(n1), "+v"(n2), "+v"(n3), "+v"(sacc)); ATT_SBAR();
    f1l = vtr(vpn + 1024); f1h = vtr(vpn + 1024 + 512);
    S1 = __builtin_amdgcn_mfma_f32_32x32x16_bf16(k4, qr[4], S1, 0, 0, 0);
    T1[12] = __builtin_amdgcn_exp2f(T1[12]);
    T1[13] = __builtin_amdgcn_exp2f(T1[13]);
    sacc += T1[10];
    n3[1] = cvtpk_s(T1[10], T1[11]);
    asm volatile("" : "+v"(T0), "+v"(T1), "+v"(n0), "+v"(n1), "+v"(n2), "+v"(n3), "+v"(sacc)); ATT_SBAR();
    f2l = vtr(vpn + 2048); f2h = vtr(vpn + 2048 + 512);
    S0 = __builtin_amdgcn_mfma_f32_32x32x16_bf16(k0, qr[5], S0, 0, 0, 0);
    sacc += T1[11];
    T1[14] = __builtin_amdgcn_exp2f(T1[14]);
    T1[15] = __builtin_amdgcn_exp2f(T1[15]);
    sacc += T1[12];
    asm volatile("" : "+v"(T0), "+v"(T1), "+v"(n0), "+v"(n1), "+v"(n2), "+v"(n3), "+v"(sacc)); ATT_SBAR();
    f3l = vtr(vpn + 3072); f3h = vtr(vpn + 3072 + 512);
    S1 = __builtin_amdgcn_mfma_f32_32x32x16_bf16(k1, qr[5], S1, 0, 0, 0);
    n3[2] = cvtpk_s(T1[12], T1[13]);
    sacc += T1[13];
    sacc += T1[14];
    n3[3] = cvtpk_s(T1[14], T1[15]);
    sacc += T1[15];
    asm volatile("" : "+v"(T0), "+v"(T1), "+v"(n0), "+v"(n1), "+v"(n2), "+v"(n3), "+v"(sacc)); ATT_SBAR();
}

constexpr int DKH0 = 32 * 256;
__device__ __forceinline__ void diff_step_a(f32x16* o, f32x16& S0, f32x16& S1, f32x16& T0, f32x16& T1, const bf16x8 pw0, const bf16x8 pw1, const bf16x8 pw2, const bf16x8 pw3, v4u& n0, v4u& n1, v4u& n2, v4u& n3, const bf16x8* qr, lds_cptr vp, lds_cptr ks, const int* kb, lds_cptr vpn, s16x4& f0l, s16x4& f0h, s16x4& f1l, s16x4& f1h, s16x4& f2l, s16x4& f2h, bf16x8& k0, bf16x8& k1, bf16x8& k2, float& sacc, float sg, float cbase) {
    f2l = vtr(vp + 2048); f2h = vtr(vp + 2048 + 512);
    o[0] = __builtin_amdgcn_mfma_f32_32x32x16_bf16(pw0, ATT_PK2(f0l, f0h), o[0], 0, 0, 0);
    S0[0] = fmaf(sg, 0.0f, cbase);
    S1[0] = fmaf(sg, 32.0f, cbase);
    S0[1] = fmaf(sg, 1.0f, cbase);
    T0[0] = __builtin_amdgcn_exp2f(T0[0]);
    T0[1] = __builtin_amdgcn_exp2f(T0[1]);
    asm volatile("" : "+v"(T0), "+v"(T1), "+v"(n0), "+v"(n1), "+v"(n2), "+v"(n3), "+v"(sacc), "+v"(S0), "+v"(S1)); ATT_SBAR();
    f0l = vtr(vp + 3072); f0h = vtr(vp + 3072 + 512);
    o[0] = __builtin_amdgcn_mfma_f32_32x32x16_bf16(pw1, ATT_PK2(f1l, f1h), o[0], 0, 0, 0);
    S1[1] = fmaf(sg, 33.0f, cbase);
    S0[2] = fmaf(sg, 2.0f, cbase);
    T0[2] = __builtin_amdgcn_exp2f(T0[2]);
    T0[3] = __builtin_amdgcn_exp2f(T0[3]);
    asm volatile("" : "+v"(T0), "+v"(T1), "+v"(n0), "+v"(n1), "+v"(n2), "+v"(n3), "+v"(sacc), "+v"(S0), "+v"(S1)); ATT_SBAR();
    f1l = vtr(vp + 4096); f1h = vtr(vp + 4096 + 512);
    o[0] = __builtin_amdgcn_mfma_f32_32x32x16_bf16(pw2, ATT_PK2(f2l, f2h), o[0], 0, 0, 0);
    S1[2] = fmaf(sg, 34.0f, cbase);
    S0[3] = fmaf(sg, 3.0f, cbase);
    sacc += T0[0];
    n0[0] = cvtpk_s(T0[0], T0[1]);
    sacc += T0[1];
    T0[4] = __builtin_amdgcn_exp2f(T0[4]);
    asm volatile("" : "+v"(T0), "+v"(T1), "+v"(n0), "+v"(n1), "+v"(n2), "+v"(n3), "+v"(sacc), "+v"(S0), "+v"(S1)); ATT_SBAR();
    f2l = vtr(vp + 5120); f2h = vtr(vp + 5120 + 512);
    o[0] = __builtin_amdgcn_mfma_f32_32x32x16_bf16(pw3, ATT_PK2(f0l, f0h), o[0], 0, 0, 0);
    S1[3] = fmaf(sg, 35.0f, cbase);
    S0[4] = fmaf(sg, 8.0f, cbase);
    S1[4] = fmaf(sg, 40.0f, cbase);
    T0[5] = __builtin_amdgcn_exp2f(T0[5]);
    sacc += T0[2];
    asm volatile("" : "+v"(T0), "+v"(T1), "+v"(n0), "+v"(n1), "+v"(n2), "+v"(n3), "+v"(sacc), "+v"(S0), "+v"(S1)); ATT_SBAR();
    f0l = vtr(vp + 6144); f0h = vtr(vp + 6144 + 512);
    o[1] = __builtin_amdgcn_mfma_f32_32x32x16_bf16(pw0, ATT_PK2(f1l, f1h), o[1], 0, 0, 0);
    S0[5] = fmaf(sg, 9.0f, cbase);
    S1[5] = fmaf(sg, 41.0f, cbase);
    n0[1] = cvtpk_s(T0[2], T0[3]);
    sacc += T0[3];
    T0[6] = __builtin_amdgcn_exp2f(T0[6]);
    asm volatile("" : "+v"(T0), "+v"(T1), "+v"(n0), "+v"(n1), "+v"(n2), "+v"(n3), "+v"(sacc), "+v"(S0), "+v"(S1)); ATT_SBAR();
    f1l = vtr(vp + 7168); f1h = vtr(vp + 7168 + 512);
    o[1] = __builtin_amdgcn_mfma_f32_32x32x16_bf16(pw1, ATT_PK2(f2l, f2h), o[1], 0, 0, 0);
    S0[6] = fmaf(sg, 10.0f, cbase);
    S1[6] = fmaf(sg, 42.0f, cbase);
    T0[7] = __builtin_amdgcn_exp2f(T0[7]);
    sacc += T0[4];
    n0[2] = cvtpk_s(T0[4], T0[5]);
    asm volatile("" : "+v"(T0), "+v"(T1), "+v"(n0), "+v"(n1), "+v"(n2), "+v"(n3), "+v"(sacc), "+v"(S0), "+v"(S1)); ATT_SBAR();
    f2l = vtr(vp + 8192); f2h = vtr(vp + 8192 + 512);
    o[1] = __builtin_amdgcn_mfma_f32_32x32x16_bf16(pw2, ATT_PK2(f0l, f0h), o[1], 0, 0, 0);
    S0[7] = fmaf(sg, 11.0f, cbase);
    S1[7] = fmaf(sg, 43.0f, cbase);
    sacc += T0[5];
    T0[8] = __builtin_amdgcn_exp2f(T0[8]);
    T0[9] = __builtin_amdgcn_exp2f(T0[9]);
    asm volatile("" : "+v"(T0), "+v"(T1), "+v"(n0), "+v"(n1), "+v"(n2), "+v"(n3), "+v"(sacc), "+v"(S0), "+v"(S1)); ATT_SBAR();
    f0l = vtr(vp + 9216); f0h = vtr(vp + 9216 + 512);
    o[1] = __builtin_amdgcn_mfma_f32_32x32x16_bf16(pw3, ATT_PK2(f1l, f1h), o[1], 0, 0, 0);
    S0[8] = fmaf(sg, 16.0f, cbase);
    S1[8] = fmaf(sg, 48.0f, cbase);
    S0[9] = fmaf(sg, 17.0f, cbase);
    sacc += T0[6];
    n0[3] = cvtpk_s(T0[6], T0[7]);
    sacc += T0[7];
    asm volatile("" : "+v"(T0), "+v"(T1), "+v"(n0), "+v"(n1), "+v"(n2), "+v"(n3), "+v"(sacc), "+v"(S0), "+v"(S1)); ATT_SBAR();
    f1l = vtr(vp + 10240); f1h = vtr(vp + 10240 + 512);
    o[2] = __builtin_amdgcn_mfma_f32_32x32x16_bf16(pw0, ATT_PK2(f2l, f2h), o[2], 0, 0, 0);
    S1[9] = fmaf(sg, 49.0f, cbase);
    S0[10] = fmaf(sg, 18.0f, cbase);
    T0[10] = __builtin_amdgcn_exp2f(T0[10]);
    T0[11] = __builtin_amdgcn_exp2f(T0[11]);
    asm volatile("" : "+v"(T0), "+v"(T1), "+v"(n0), "+v"(n1), "+v"(n2), "+v"(n3), "+v"(sacc), "+v"(S0), "+v"(S1)); ATT_SBAR();
    f2l = vtr(vp + 11264); f2h = vtr(vp + 11264 + 512);
    o[2] = __builtin_amdgcn_mfma_f32_32x32x16_bf16(pw1, ATT_PK2(f0l, f0h), o[2], 0, 0, 0);
    S1[10] = fmaf(sg, 50.0f, cbase);
    S0[11] = fmaf(sg, 19.0f, cbase);
    sacc += T0[8];
    n1[0] = cvtpk_s(T0[8], T0[9]);
    sacc += T0[9];
    T0[12] = __builtin_amdgcn_exp2f(T0[12]);
    asm volatile("" : "+v"(T0), "+v"(T1), "+v"(n0), "+v"(n1), "+v"(n2), "+v"(n3), "+v"(sacc), "+v"(S0), "+v"(S1)); ATT_SBAR();
}
__device__ __forceinline__ void diff_step_b(f32x16* o, f32x16& S0, f32x16& S1, f32x16& T0, f32x16& T1, const bf16x8 pw0, const bf16x8 pw1, const bf16x8 pw2, const bf16x8 pw3, v4u& n0, v4u& n1, v4u& n2, v4u& n3, const bf16x8* qr, lds_cptr vp, lds_cptr ks, const int* kb, lds_cptr vpn, s16x4& f0l, s16x4& f0h, s16x4& f1l, s16x4& f1h, s16x4& f2l, s16x4& f2h, bf16x8& k0, bf16x8& k1, bf16x8& k2, float& sacc, float sg, float cbase) {
    f0l = vtr(vp + 12288); f0h = vtr(vp + 12288 + 512);
    o[2] = __builtin_amdgcn_mfma_f32_32x32x16_bf16(pw2, ATT_PK2(f1l, f1h), o[2], 0, 0, 0);
    S1[11] = fmaf(sg, 51.0f, cbase);
    S0[12] = fmaf(sg, 24.0f, cbase);
    S1[12] = fmaf(sg, 56.0f, cbase);
    T0[13] = __builtin_amdgcn_exp2f(T0[13]);
    sacc += T0[10];
    asm volatile("" : "+v"(T0), "+v"(T1), "+v"(n0), "+v"(n1), "+v"(n2), "+v"(n3), "+v"(sacc), "+v"(S0), "+v"(S1)); ATT_SBAR();
    f1l = vtr(vp + 13312); f1h = vtr(vp + 13312 + 512);
    o[2] = __builtin_amdgcn_mfma_f32_32x32x16_bf16(pw3, ATT_PK2(f2l, f2h), o[2], 0, 0, 0);
    S0[13] = fmaf(sg, 25.0f, cbase);
    S1[13] = fmaf(sg, 57.0f, cbase);
    n1[1] = cvtpk_s(T0[10], T0[11]);
    sacc += T0[11];
    T0[14] = __builtin_amdgcn_exp2f(T0[14]);
    asm volatile("" : "+v"(T0), "+v"(T1), "+v"(n0), "+v"(n1), "+v"(n2), "+v"(n3), "+v"(sacc), "+v"(S0), "+v"(S1)); ATT_SBAR();
    f2l = vtr(vp + 14336); f2h = vtr(vp + 14336 + 512);
    o[3] = __builtin_amdgcn_mfma_f32_32x32x16_bf16(pw0, ATT_PK2(f0l, f0h), o[3], 0, 0, 0);
    S0[14] = fmaf(sg, 26.0f, cbase);
    S1[14] = fmaf(sg, 58.0f, cbase);
    T0[15] = __builtin_amdgcn_exp2f(T0[15]);
    sacc += T0[12];
    n1[2] = cvtpk_s(T0[12], T0[13]);
    asm volatile("" : "+v"(T0), "+v"(T1), "+v"(n0), "+v"(n1), "+v"(n2), "+v"(n3), "+v"(sacc), "+v"(S0), "+v"(S1)); ATT_SBAR();
    f0l = vtr(vp + 15360); f0h = vtr(vp + 15360 + 512);
    o[3] = __builtin_amdgcn_mfma_f32_32x32x16_bf16(pw1, ATT_PK2(f1l, f1h), o[3], 0, 0, 0);
    S0[15] = fmaf(sg, 27.0f, cbase);
    S1[15] = fmaf(sg, 59.0f, cbase);
    sacc += T0[13];
    T1[0] = __builtin_amdgcn_exp2f(T1[0]);
    T1[1] = __builtin_amdgcn_exp2f(T1[1]);
    asm volatile("" : "+v"(T0), "+v"(T1), "+v"(n0), "+v"(n1), "+v"(n2), "+v"(n3), "+v"(sacc), "+v"(S0), "+v"(S1)); ATT_SBAR();
    k0 = *(const LAS bf16x8*)(ks + kb[0] + 0 * DKH0);
    o[3] = __builtin_amdgcn_mfma_f32_32x32x16_bf16(pw2, ATT_PK2(f2l, f2h), o[3], 0, 0, 0);
    sacc += T0[14];
    n1[3] = cvtpk_s(T0[14], T0[15]);
    sacc += T0[15];
    T1[2] = __builtin_amdgcn_exp2f(T1[2]);
    T1[3] = __builtin_amdgcn_exp2f(T1[3]);
    asm volatile("" : "+v"(T0), "+v"(T1), "+v"(n0), "+v"(n1), "+v"(n2), "+v"(n3), "+v"(sacc), "+v"(S0), "+v"(S1)); ATT_SBAR();
    k1 = *(const LAS bf16x8*)(ks + kb[0] + 1 * DKH0);
    o[3] = __builtin_amdgcn_mfma_f32_32x32x16_bf16(pw3, ATT_PK2(f0l, f0h), o[3], 0, 0, 0);
    sacc += T1[0];
    n2[0] = cvtpk_s(T1[0], T1[1]);
    sacc += T1[1];
    T1[4] = __builtin_amdgcn_exp2f(T1[4]);
    T1[5] = __builtin_amdgcn_exp2f(T1[5]);
    asm volatile("" : "+v"(T0), "+v"(T1), "+v"(n0), "+v"(n1), "+v"(n2), "+v"(n3), "+v"(sacc)); ATT_SBAR();
    k2 = *(const LAS bf16x8*)(ks + kb[1] + 0 * DKH0);
    S0 = __builtin_amdgcn_mfma_f32_32x32x16_bf16(k0, qr[0], S0, 0, 0, 0);
    sacc += T1[2];
    n2[1] = cvtpk_s(T1[2], T1[3]);
    sacc += T1[3];
    T1[6] = __builtin_amdgcn_exp2f(T1[6]);
    T1[7] = __builtin_amdgcn_exp2f(T1[7]);
    asm volatile("" : "+v"(T0), "+v"(T1), "+v"(n0), "+v"(n1), "+v"(n2), "+v"(n3), "+v"(sacc)); ATT_SBAR();
    k0 = *(const LAS bf16x8*)(ks + kb[1] + 1 * DKH0);
    S1 = __builtin_amdgcn_mfma_f32_32x32x16_bf16(k1, qr[0], S1, 0, 0, 0);
    sacc += T1[4];
    n2[2] = cvtpk_s(T1[4], T1[5]);
    sacc += T1[5];
    T1[8] = __builtin_amdgcn_exp2f(T1[8]);
    T1[9] = __builtin_amdgcn_exp2f(T1[9]);
    asm volatile("" : "+v"(T0), "+v"(T1), "+v"(n0), "+v"(n1), "+v"(n2), "+v"(n3), "+v"(sacc)); ATT_SBAR();
    k1 = *(const LAS bf16x8*)(ks + kb[2] + 0 * DKH0);
    S0 = __builtin_amdgcn_mfma_f32_32x32x16_bf16(k2, qr[1], S0, 0, 0, 0);
    sacc += T1[6];
    n2[3] = cvtpk_s(T1[6], T1[7]);
    sacc += T1[7];
    T1[10] = __builtin_amdgcn_exp2f(T1[10]);
    T1[11] = __builtin_amdgcn_exp2f(T1[11]);
    asm volatile("" : "+v"(T0), "+v"(T1), "+v"(n0), "+v"(n1), "+v"(n2), "+v"(n3), "+v"(sacc)); ATT_SBAR();
    k2 = *(const LAS bf16x8*)(ks + kb[2] + 1 * DKH0);
    S1 = __builtin_amdgcn_mfma_f32_32x32x16_bf16(k0, qr[1], S1, 0, 0, 0);
    sacc += T1[8];
    n3[0] = cvtpk_s(T1[8], T1[9]);
    sacc += T1[9];
    T1[12] = __builtin_amdgcn_exp2f(T1[12]);
    T1[13] = __builtin_amdgcn_exp2f(T1[13]);
    asm volatile("" : "+v"(T0), "+v"(T1), "+v"(n0), "+v"(n1), "+v"(n2), "+v"(n3), "+v"(sacc)); ATT_SBAR();
    k0 = *(const LAS bf16x8*)(ks + kb[3] + 0 * DKH0);
    S0 = __builtin_amdgcn_mfma_f32_32x32x16_bf16(k1, qr[2], S0, 0, 0, 0);
    sacc += T1[10];
    n3[1] = cvtpk_s(T1[10], T1[11]);
    sacc += T1[11];
    T1[14] = __builtin_amdgcn_exp2f(T1[14]);
    T1[15] = __builtin_amdgcn_exp2f(T1[15]);
    asm volatile("" : "+v"(T0), "+v"(T1), "+v"(n0), "+v"(n1), "+v"(n2), "+v"(n3), "+v"(sacc)); ATT_SBAR();
    k1 = *(const LAS bf16x8*)(ks + kb[3] + 1 * DKH0);
    S1 = __builtin_amdgcn_mfma_f32_32x32x16_bf16(k2, qr[2], S1, 0, 0, 0);
    sacc += T1[12];
    n3[2] = cvtpk_s(T1[12], T1[13]);
    sacc += T1[13];
    sacc += T1[14];
    n3[3] = cvtpk_s(T1[14], T1[15]);
    sacc += T1[15];
    asm volatile("" : "+v"(T0), "+v"(T1), "+v"(n0), "+v"(n1), "+v"(n2), "+v"(n3), "+v"(sacc)); ATT_SBAR();
    f0l = vtr(vpn + 0); f0h = vtr(vpn + 0 + 512);
    S0 = __builtin_amdgcn_mfma_f32_32x32x16_bf16(k0, qr[3], S0, 0, 0, 0);
    asm volatile("" : "+v"(T0), "+v"(T1), "+v"(n0), "+v"(n1), "+v"(n2), "+v"(n3), "+v"(sacc)); ATT_SBAR();
    f1l = vtr(vpn + 1024); f1h = vtr(vpn + 1024 + 512);
    S1 = __builtin_amdgcn_mfma_f32_32x32x16_bf16(k1, qr[3], S1, 0, 0, 0);
    asm volatile("" : "+v"(T0), "+v"(T1), "+v"(n0), "+v"(n1), "+v"(n2), "+v"(n3), "+v"(sacc)); ATT_SBAR();
}
}
}
namespace mk {
namespace att {
#define ATT_NXT(x, n, sz) (((x) == ((n) - 1) * (sz)) ? 0 : (x) + (sz))
#define ATT_BC(x) __builtin_bit_cast(bf16x8, x)

constexpr int M4_KB = 12 * 1024, M4_VB = 8 * 1024, M4_NK = 4, M4_NV = 6, M4_VOFF = M4_NK * M4_KB, M4_OST = 0;
template <int VAR = 0>
__device__ __forceinline__ void mla_unit4(int b, int h, int qb, const bf16* QM, const bf16* KVM, const bf16* KROT, bf16* OCAT, LAS char* shm) {
    const int tid = threadIdx.x, lane = tid & 63, r32 = lane & 31, hi = lane >> 5; const int wid = __builtin_amdgcn_readfirstlane(tid >> 6);
    const bool w03 = wid < 4;
    const long rowbase = (long)b * SEQ; const int q0 = qb * 256;
    const unsigned lds0 = (unsigned)(uintptr_t)shm;
    LAS float* wsf = (LAS float*)(shm + ATT_WS_OFF) + wid * 64;
    bf16x8 qr[6];
    { const bf16* Qw = QM + (rowbase + q0 + wid * 32 + r32) * 768 + h * 96 + hi * 8;
#pragma unroll
      for (int d0 = 0; d0 < 6; ++d0) qr[d0] = *(const bf16x8*)(Qw + d0 * 16); }
    const char* kvbase = (const char*)(KVM + rowbase * 1024 + h * 128); const char* krbase = (const char*)(KROT + rowbase * 32);
    const int kr8 = 8 * wid + (lane >> 3), kr16 = 16 * (wid & 3) + (lane >> 2);
    const unsigned koffA = (unsigned)(kr8 * 2048 + (((lane & 7) ^ ((kr8 >> 1) & 7)) << 4));
    const unsigned koffB = (unsigned)(kr16 * 64 + (((lane & 3) ^ ((kr16 >> 2) & 3)) << 4));
    const unsigned voffs = (unsigned)((16 * (wid & 3) + (lane >> 2)) * 1024 + 64 + (wid >> 2) * 32 + (lane & 3) * 8) * 2u;
#define M4_DMA(t, kd_, vd_) do { const char* kvt_ = uptr(kvbase + (size_t)(t) * (64 * 1024 * 2)); \
        const unsigned dk_ = (unsigned)__builtin_amdgcn_readfirstlane(lds0 + (kd_) + wid * 1024), dv_ = (unsigned)__builtin_amdgcn_readfirstlane(lds0 + M4_VOFF + (vd_) + wid * 1024); \
        if (w03) glds16s_x3(kvt_, koffA, dk_, uptr(krbase + (size_t)(t) * (64 * 32 * 2)), koffB, dk_ + 8192u, kvt_, voffs, dv_); \
        else glds16s_x2(kvt_, koffA, dk_, kvt_, voffs, dv_); } while (0)
    const int vofs = M4_VOFF + ((lane >> 4) & 1) * 32 + (lane & 3) * 8 + (4 * hi + ((lane & 15) >> 2)) * 64;
    int kb[6];
#pragma unroll
    for (int d0 = 0; d0 < 4; ++d0) kb[d0] = r32 * 128 + (((2 * d0 + hi) ^ ((r32 >> 1) & 7)) << 4);
#pragma unroll
    for (int d0 = 4; d0 < 6; ++d0) kb[d0] = 8192 + r32 * 64 + (((2 * (d0 - 4) + hi) ^ ((r32 >> 2) & 3)) << 4);
    float l_reg = 0.f; f32x16 o[2]; o[0] = f32x16{}; o[1] = f32x16{};
    f32x16 SA0, SA1, SB0, SB1; v4u wA0 = {0u, 0u, 0u, 0u}, wA1 = wA0, wA2 = wA0, wA3 = wA0, wB0 = wA0, wB1 = wA0, wB2 = wA0, wB3 = wA0;
    s16x4 f0l, f0h, f1l, f1h, f2l, f2h, f3l, f3h, f4l, f4h; bf16x8 k0, k1, k2, k3, k4;
    constexpr int NT = SEQ / 64;
#define M4_BAR(t) do { if constexpr (VAR == 1) { if ((t) + 3 < NT) { if (w03) asm volatile("s_waitcnt vmcnt(6) lgkmcnt(0)" ::: "memory"); else asm volatile("s_waitcnt vmcnt(4) lgkmcnt(0)" ::: "memory"); } else asm volatile("s_waitcnt vmcnt(0) lgkmcnt(0)" ::: "memory"); } \
        else if ((t) + 3 < NT) { if (w03) ATT_WAIT_BARN(6); else ATT_WAIT_BARN(4); } else ATT_WAIT_BAR0(); } while (0)
#define M4_ARGS(S, T, W, N) o, S##0, S##1, T##0, T##1, ATT_BC(W##0), ATT_BC(W##1), ATT_BC(W##2), ATT_BC(W##3), N##0, N##1, N##2, N##3, qr, \
                 (lds_cptr)shm + vsm1 + vofs, (lds_cptr)shm + ks1, kb, (lds_cptr)shm + vs0 + vofs, f0l, f0h, f1l, f1h, f2l, f2h, f3l, f3h, f4l, f4h, k0, k1, k2, k3, k4, l_reg
#ifdef MK_PROBE_VAR
#define M4_SA(...) do { if constexpr (VAR == 3) mla_stepn_a(__VA_ARGS__); else if constexpr (VAR == 4) mla_stepx_a(__VA_ARGS__); else mla_step_a(__VA_ARGS__); } while (0)
#define M4_SB(...) do { if constexpr (VAR == 3) mla_stepn_b(__VA_ARGS__); else if constexpr (VAR == 4) mla_stepx_b(__VA_ARGS__); else mla_step_b(__VA_ARGS__); } while (0)
#else
#define M4_SA(...) mla_step_a(__VA_ARGS__)
#define M4_SB(...) mla_step_b(__VA_ARGS__)
#endif
#define M4_STEP(t, S, T, W, N) do { M4_BAR(t); \
        M4_SA(M4_ARGS(S, T, W, N)); \
        if (VAR != 2 && (t) + 4 < NT) M4_DMA((t) + 4, kd, vd);               \
        M4_SB(M4_ARGS(S, T, W, N)); \
        vsm1 = vs0; vs0 = ATT_NXT(vs0, M4_NV, M4_VB); ks1 = ATT_NXT(ks1, M4_NK, M4_KB); kd = ATT_NXT(kd, M4_NK, M4_KB); vd = ATT_NXT(vd, M4_NV, M4_VB); } while (0)
    M4_DMA(0, 0, 0); M4_DMA(1, M4_KB, M4_VB); M4_DMA(2, 2 * M4_KB, 2 * M4_VB); M4_DMA(3, 3 * M4_KB, 3 * M4_VB);
    if (w03) ATT_WAIT_BARN(9); else ATT_WAIT_BARN(6);
    { SA0 = f32x16{}; SA1 = f32x16{};
#pragma unroll
      for (int d0 = 0; d0 < 6; ++d0) { const lds_cptr kp_ = (lds_cptr)shm + kb[d0]; const int kh_ = d0 < 4 ? 32 * 128 : 32 * 64;
          SA0 = __builtin_amdgcn_mfma_f32_32x32x16_bf16(*(const LAS bf16x8*)kp_, qr[d0], SA0, 0, 0, 0); SA1 = __builtin_amdgcn_mfma_f32_32x32x16_bf16(*(const LAS bf16x8*)(kp_ + kh_), qr[d0], SA1, 0, 0, 0); } }
    { const lds_cptr vp_ = (lds_cptr)shm + vofs; f0l = vtr(vp_); f0h = vtr(vp_ + 512); f1l = vtr(vp_ + 1024); f1h = vtr(vp_ + 1024 + 512); f2l = vtr(vp_ + 2048); f2h = vtr(vp_ + 2048 + 512); f3l = vtr(vp_ + 3072); f3h = vtr(vp_ + 3072 + 512); }
    int ks1 = M4_KB, vsm1 = 0, vs0 = 0, kd = 0, vd = 4 * M4_VB;
    for (int t = 0; t < NT; t += 2) {
        M4_STEP(t, SB, SA, wB, wA);
        M4_STEP(t + 1, SA, SB, wA, wB);
    }
    ATT_LBAR();
    pv<2>(o, (lds_cptr)shm + vsm1 + vofs, ATT_BC(wB0), ATT_BC(wB1), ATT_BC(wB2), ATT_BC(wB3));
    ATT_LBAR();
#undef M4_DMA
#undef M4_BAR
#undef M4_STEP
#undef M4_ARGS
#undef M4_SA
#undef M4_SB
    int lane_e = lane; asm volatile("" : "+v"(lane_e)); const int r32e = lane_e & 31, hie = lane_e >> 5;
    { auto rr = __builtin_amdgcn_permlane32_swap(__float_as_uint(l_reg), __float_as_uint(l_reg), false, false); l_reg = __uint_as_float(rr[0]) + __uint_as_float(rr[1]); }
    if (hie == 0) wsf[32 + r32e] = l_reg;
    asm volatile("s_waitcnt lgkmcnt(0)" ::: "memory");
    float rli[16];
#pragma unroll
    for (int r = 0; r < 16; ++r) rli[r] = __builtin_amdgcn_rcpf((wsf + 32 + 4 * hie)[(r & 3) + 8 * (r >> 2)]);
    bf16* Ow = OCAT + (rowbase + q0 + wid * 32) * 1024 + h * 64;
    { LAS bf16* stg = (LAS bf16*)(shm + M4_OST) + wid * 2048;
#pragma unroll
      for (int r = 0; r < 16; ++r) { const int orow = crow(r, hie);
#pragma unroll
          for (int d0 = 0; d0 < 2; ++d0) stg[orow * 64 + d0 * 32 + r32e] = (bf16)(cvtpk_s(o[d0][r] * rli[r], 0.f) & 0xffffu); }
      asm volatile("s_waitcnt lgkmcnt(0)" ::: "memory");
#pragma unroll
      for (int i = 0; i < 4; ++i) { const int row = i * 8 + (lane_e >> 3), ch = lane_e & 7; const v4u v = *(const LAS v4u*)(stg + row * 64 + ch * 8); __builtin_nontemporal_store(v, (v4u*)(Ow + (long)row * 1024 + ch * 8)); } }
    ATT_LBAR();
}

constexpr int D4_KB = 16 * 1024, D4_VB = 16 * 1024, D4_NK = 3, D4_NV = 5, D4_VOFF = D4_NK * D4_KB, D4_X = 0, D4_OST = 65536;
__device__ __forceinline__ void diff_unit4(int b, int h, int qb, int t_lo, int NT, const bf16* QD, const bf16* KD, const bf16* VD, bf16* OCAT, float lam, float sref, const float* gsub, LAS char* shm) {
    const int tid = threadIdx.x, lane = tid & 63, r32 = lane & 31, hi = lane >> 5; const int wid = __builtin_amdgcn_readfirstlane(tid >> 6);
    const int w4 = wid & 3, mp = wid >> 2;
    const long rowbase = (long)b * SEQ; const int q0 = qb * 128;
    const unsigned lds0 = (unsigned)(uintptr_t)shm;
    LAS float* wsf = (LAS float*)(shm + ATT_WS_OFF) + wid * 64;
    bf16x8 qr[4];
    { const bf16* Qw = QD + (rowbase + q0 + w4 * 32 + r32) * 512 + h * 128 + mp * 64 + hi * 8;
#pragma unroll
      for (int d0 = 0; d0 < 4; ++d0) qr[d0] = *(const bf16x8*)(Qw + d0 * 16); }
    const char* kbase = (const char*)(KD + rowbase * 512 + h * 128); const char* vbase = (const char*)(VD + rowbase * 512 + h * 128);
    const int kr4 = 4 * wid + (lane >> 4);
    const unsigned koffs = (unsigned)(kr4 * 1024 + (((lane & 15) ^ (kr4 & 15)) << 4));
    const unsigned voffs = (unsigned)((16 * (wid & 3) + (lane >> 2)) * 512 + (wid >> 2) * 32 + (lane & 3) * 8) * 2u;
#define D4_DMA(t, kd_, vd_) do { const char* kt_ = uptr(kbase + (size_t)(t) * (64 * 512 * 2)); const char* vt_ = uptr(vbase + (size_t)(t) * (64 * 512 * 2)); \
        const unsigned dk_ = (unsigned)__builtin_amdgcn_readfirstlane(lds0 + (kd_) + wid * 1024), dv_ = (unsigned)__builtin_amdgcn_readfirstlane(lds0 + D4_VOFF + (vd_) + wid * 1024); \
        glds16s_x2(kt_, koffs, dk_, kt_ + 32 * 1024, koffs, dk_ + 8192u); \
        glds16s_x2(vt_, voffs, dv_, vt_ + 128, voffs, dv_ + 8192u); } while (0)
    const int vofs = D4_VOFF + ((lane >> 4) & 1) * 32 + (lane & 3) * 8 + (4 * hi + ((lane & 15) >> 2)) * 64;
    int kb[4];
#pragma unroll
    for (int d0 = 0; d0 < 4; ++d0) kb[d0] = r32 * 256 + (((8 * mp + 2 * d0 + hi) ^ (r32 & 15)) << 4);
    const float sl2 = __builtin_amdgcn_exp2f(-2.f * (float)(h + 1)) * LOG2E;
    const int qpos = q0 + w4 * 32 + r32;
    const int t_d = (q0 + w4 * 32) >> 6;
    float l_reg = 0.f; f32x16 o[4]; o[0] = f32x16{}; o[1] = f32x16{}; o[2] = f32x16{}; o[3] = f32x16{};
    f32x16 SA0, SA1, SB0, SB1; v4u wA0 = {0u, 0u, 0u, 0u}, wA1 = wA0, wA2 = wA0, wA3 = wA0, wB0 = wA0, wB1 = wA0, wB2 = wA0, wB3 = wA0;
    s16x4 f0l, f0h, f1l, f1h, f2l, f2h; bf16x8 k0, k1, k2;
#define D4_DIAG(T, S0, S1) do { if ((T) == t_d) { int x0_ = (T) * 64 + 4 * hi - qpos; asm volatile("" : "+v"(x0_)); \
        _Pragma("unroll") for (int r = 0; r < 16; ++r) { const int x = x0_ + ((r & 3) + 8 * (r >> 2)); S0[r] -= 2.f * sl2 * fmaxf((float)x, 0.f); S1[r] -= 2.f * sl2 * fmaxf((float)(x + 32), 0.f); } } } while (0)
#define D4_BAR(t) do { if ((t) + 2 < NT) ATT_WAIT_BARN(4); else ATT_WAIT_BAR0(); } while (0)
#define D4_ARGS(S, T, W, N) o, S##0, S##1, T##0, T##1, ATT_BC(W##0), ATT_BC(W##1), ATT_BC(W##2), ATT_BC(W##3), N##0, N##1, N##2, N##3, qr, \
                    (lds_cptr)shm + vsm1 + vofs, (lds_cptr)shm + ks1, kb, (lds_cptr)shm + vs0 + vofs, f0l, f0h, f1l, f1h, f2l, f2h, k0, k1, k2, l_reg, sg_, cb_
#define D4_STEP(t, S, T, W, N) do { D4_BAR(t); \
        { const int T1_ = t_lo + (t) + 1; float sg_ = T1_ <= t_d ? sl2 : -sl2; asm volatile("" : "+v"(sg_)); const float cb_ = fmaf(sg_, (float)(T1_ * 64 + 4 * hi - qpos), -sref); \
          diff_step_a(D4_ARGS(S, T, W, N)); \
          if ((t) + 3 < NT) D4_DMA(t_lo + (t) + 3, kd, vd); \
          diff_step_b(D4_ARGS(S, T, W, N)); \
          D4_DIAG(T1_, S##0, S##1); } \
        vsm1 = vs0; vs0 = ATT_NXT(vs0, D4_NV, D4_VB); ks1 = ATT_NXT(ks1, D4_NK, D4_KB); kd = ATT_NXT(kd, D4_NK, D4_KB); vd = ATT_NXT(vd, D4_NV, D4_VB); } while (0)
    D4_DMA(t_lo, 0, 0); D4_DMA(t_lo + 1, D4_KB, D4_VB); D4_DMA(t_lo + 2, 2 * D4_KB, 2 * D4_VB);
    ATT_WAIT_BARN(8);
    { f32x16 c0_, c1_; const float sg_ = t_lo <= t_d ? sl2 : -sl2; const float cb_ = fmaf(sg_, (float)(t_lo * 64 + 4 * hi - qpos), -sref);
#pragma unroll
      for (int r = 0; r < 16; ++r) { c0_[r] = fmaf(sg_, (float)((r & 3) + 8 * (r >> 2)), cb_); c1_[r] = c0_[r] + 32.f * sg_; }
      SA0 = c0_; SA1 = c1_;
#pragma unroll
      for (int d0 = 0; d0 < 4; ++d0) { const lds_cptr kp_ = (lds_cptr)shm + kb[d0];
          SA0 = __builtin_amdgcn_mfma_f32_32x32x16_bf16(*(const LAS bf16x8*)kp_, qr[d0], SA0, 0, 0, 0); SA1 = __builtin_amdgcn_mfma_f32_32x32x16_bf16(*(const LAS bf16x8*)(kp_ + 32 * 256), qr[d0], SA1, 0, 0, 0); }
      D4_DIAG(t_lo, SA0, SA1); }
    { const lds_cptr vp_ = (lds_cptr)shm + vofs; f0l = vtr(vp_); f0h = vtr(vp_ + 512); f1l = vtr(vp_ + 1024); f1h = vtr(vp_ + 1024 + 512); }
    int ks1 = D4_KB, vsm1 = 0, vs0 = 0, kd = 0, vd = 3 * D4_VB;
    for (int t = 0; t < NT; t += 2) {
        D4_STEP(t, SB, SA, wB, wA);
        D4_STEP(t + 1, SA, SB, wA, wB);
    }
    ATT_LBAR();
    pv<4>(o, (lds_cptr)shm + vsm1 + vofs, ATT_BC(wB0), ATT_BC(wB1), ATT_BC(wB2), ATT_BC(wB3));
#undef D4_DMA
#undef D4_DIAG
#undef D4_BAR
#undef D4_STEP
#undef D4_ARGS
    int lane_e = lane; asm volatile("" : "+v"(lane_e)); const int r32e = lane_e & 31, hie = lane_e >> 5;
    { auto rr = __builtin_amdgcn_permlane32_swap(__float_as_uint(l_reg), __float_as_uint(l_reg), false, false); l_reg = __uint_as_float(rr[0]) + __uint_as_float(rr[1]); }
    if (hie == 0) wsf[32 + r32e] = l_reg;
    asm volatile("s_waitcnt lgkmcnt(0)" ::: "memory");
#pragma unroll
    for (int r = 0; r < 16; ++r) { const float rl_ = __builtin_amdgcn_rcpf((wsf + 32 + 4 * hie)[(r & 3) + 8 * (r >> 2)]) * (mp == 1 ? lam : 1.f);
#pragma unroll
        for (int d0 = 0; d0 < 4; ++d0) o[d0][r] *= rl_; }
    ATT_LBAR();
    LAS float* X = (LAS float*)(shm + D4_X);
    if (mp == 1) {
#pragma unroll
        for (int r = 0; r < 16; ++r) { LAS float* xr = X + (w4 * 32 + 4 * hie) * 128 + r32e;
#pragma unroll
            for (int d0 = 0; d0 < 4; ++d0) xr[((r & 3) + 8 * (r >> 2)) * 128 + d0 * 32] = o[d0][r]; }
    }
    ATT_LBAR();
    if (mp == 0) {
        float gs[4];
#pragma unroll
        for (int d0 = 0; d0 < 4; ++d0) gs[d0] = gsub[d0 * 32 + r32e] * 0.8f;
        LAS bf16* stg = (LAS bf16*)(shm + D4_OST) + w4 * 4096 + 4 * hie * 128 + r32e;
        const LAS float* xr = X + (w4 * 32 + 4 * hie) * 128 + r32e;
#pragma unroll
        for (int r = 0; r < 16; ++r) { const int c0r = (r & 3) + 8 * (r >> 2); float v[4]; float ss = 0.f;
#pragma unroll
            for (int d0 = 0; d0 < 4; ++d0) { v[d0] = o[d0][r] - xr[c0r * 128 + d0 * 32]; ss += v[d0] * v[d0]; }
            ss += __int_as_float(__builtin_amdgcn_ds_swizzle(__float_as_int(ss), 0x041F)); ss += __int_as_float(__builtin_amdgcn_ds_swizzle(__float_as_int(ss), 0x081F));
            ss += __int_as_float(__builtin_amdgcn_ds_swizzle(__float_as_int(ss), 0x101F)); ss += __int_as_float(__builtin_amdgcn_ds_swizzle(__float_as_int(ss), 0x201F));
            ss += __int_as_float(__builtin_amdgcn_ds_swizzle(__float_as_int(ss), 0x401F));
            const float rr = __builtin_amdgcn_rsqf(ss * (1.f / 128.f) + EPS);
#pragma unroll
            for (int d0 = 0; d0 < 4; ++d0) stg[c0r * 128 + d0 * 32] = (bf16)(cvtpk_s(v[d0] * rr * gs[d0], 0.f) & 0xffffu); }
        asm volatile("s_waitcnt lgkmcnt(0)" ::: "memory");
        bf16* Ow = OCAT + (rowbase + q0 + w4 * 32) * 1024 + 512 + h * 128;
        const LAS bf16* stg0 = (const LAS bf16*)(shm + D4_OST) + w4 * 4096;
#pragma unroll
        for (int i = 0; i < 8; ++i) { const int row = i * 4 + (lane_e >> 4), ch = lane_e & 15; const v4u v = *(const LAS v4u*)(stg0 + row * 128 + ch * 8); __builtin_nontemporal_store(v, (v4u*)(Ow + (long)row * 1024 + ch * 8)); }
    }
    ATT_LBAR();
}
#undef ATT_NXT
#undef ATT_BC
}
}
namespace mk {
namespace pg8 {
__device__ __forceinline__ v4u pack8(const f32x4 a, const f32x4 b, float s) { v4u w; w.x = cvt_pk_bf16(a[0] * s, a[1] * s); w.y = cvt_pk_bf16(a[2] * s, a[3] * s); w.z = cvt_pk_bf16(b[0] * s, b[1] * s); w.w = cvt_pk_bf16(b[2] * s, b[3] * s); return w; }
__device__ __forceinline__ float sq4(const f32x4 a) { return (a[0] * a[0] + a[1] * a[1]) + (a[2] * a[2] + a[3] * a[3]); }
__device__ __forceinline__ float fq_sum(float s) { return xor_sum_16_32(s); }
__device__ __forceinline__ void rope32(f32x4& x0, f32x4& x1, const float* g32, const float2* tabrow, int fq, float osc) {
    const float ms = fq_sum(sq4(x0) + sq4(x1)) * (1.f / 32.f);
    const float r = __builtin_amdgcn_rsqf(ms + EPS);
    const f32x4 g0 = *(const f32x4*)(g32 + 4 * fq), g1 = *(const f32x4*)(g32 + 16 + 4 * fq);
    const f32x4 t0 = *(const f32x4*)(tabrow + 4 * fq), t1 = *(const f32x4*)(tabrow + 4 * fq + 2);
    const float cs[4] = {t0[0], t0[2], t1[0], t1[2]}, sn[4] = {t0[1], t0[3], t1[1], t1[3]};
#pragma unroll
    for (int i = 0; i < 4; ++i) { const float a = x0[i] * r * g0[i], b = x1[i] * r * g1[i]; x0[i] = (a * cs[i] - b * sn[i]) * osc; x1[i] = (b * cs[i] + a * sn[i]) * osc; }
}
__device__ __forceinline__ void rope32v(f32x4& x0, f32x4& x1, const f32x4 g0, const f32x4 g1, const f32x4 t0, const f32x4 t1, float osc) {
    const float ms = fq_sum(sq4(x0) + sq4(x1)) * (1.f / 32.f);
    const float r = __builtin_amdgcn_rsqf(ms + EPS);
    const float cs[4] = {t0[0], t0[2], t1[0], t1[2]}, sn[4] = {t0[1], t0[3], t1[1], t1[3]};
#pragma unroll
    for (int i = 0; i < 4; ++i) { const float a = x0[i] * r * g0[i], b = x1[i] * r * g1[i]; x0[i] = (a * cs[i] - b * sn[i]) * osc; x1[i] = (b * cs[i] + a * sn[i]) * osc; }
}
__device__ __forceinline__ void store_rope(bf16* dst, const f32x4 x0, const f32x4 x1, int fq) {
    v2u a; a.x = cvt_pk_bf16(x0[0], x0[1]); a.y = cvt_pk_bf16(x0[2], x0[3]); *(v2u*)(dst + 4 * fq) = a;
    v2u b; b.x = cvt_pk_bf16(x1[0], x1[1]); b.y = cvt_pk_bf16(x1[2], x1[3]); *(v2u*)(dst + 16 + 4 * fq) = b;
}

struct EpiWin {
    static constexpr bool PERM = true, AFTER_DRAIN = false, PRE = false;
    unsigned char* ws;
    __device__ __forceinline__ void operator()(const Acc& acc, const Unit& u, int wr, int wc, int fr, int fq) const {
        asm volatile("" : "+v"(fr), "+v"(fq));
        const float* ssq = (const float*)(ws + WS_S1); bf16* LATP = (bf16*)(ws + WS_LATP); float* QSS = (float*)(ws + WS_QSS); float* KSS = (float*)(ws + WS_KSS); bf16* KROT = (bf16*)(ws + WS_KROT);
        bf16* QD = (bf16*)(ws + WS_QD); bf16* KD = (bf16*)(ws + WS_KD); bf16* VD = (bf16*)(ws + WS_VD); const float2* tab = (const float2*)(ws + WS_TAB);
        const float* gdq = kin(I_GDQ); const float* gdk = kin(I_GDK); const float* gkr = kin(I_GMLAK) + 64;
        const int row0 = u.pm * BM + wr * 64 + fr, pn = u.pn;
        f32x4 g00 = {1.f, 1.f, 1.f, 1.f}, g01 = g00, g10 = g00, g11 = g00;
        if (pn >= 2 && pn < 6) { const float* g = (pn < 4 ? gdq : gdk) + 8 * fq; g00 = *(const f32x4*)g; g01 = *(const f32x4*)(g + 4); g10 = *(const f32x4*)(g + 32); g11 = *(const f32x4*)(g + 36); }
        const bool ropew = pn == 1 && wc == 0;
        if (ropew) { g00 = *(const f32x4*)(gkr + 4 * fq); g01 = *(const f32x4*)(gkr + 16 + 4 * fq); }
        f32x4 tn0 = {0.f, 0.f, 0.f, 0.f}, tn1 = tn0;
        if (ropew) { const float2* tr = tab + (size_t)(row0 % SEQ) * 16; tn0 = *(const f32x4*)(tr + 4 * fq); tn1 = *(const f32x4*)(tr + 4 * fq + 2); }
#pragma unroll
        for (int ai = 0; ai < 2; ++ai) { float r1s[4];
#pragma unroll
            for (int m = 0; m < 4; ++m) r1s[m] = rstd4(ssq, row0 + ai * HALF + m * 16, 1.f / DM);
#pragma unroll
            for (int m = 0; m < 4; ++m) { const int row = row0 + ai * HALF + m * 16; const float r1 = r1s[m];
                const f32x4 a00 = acc[ai][0][m][0] * r1, a01 = acc[ai][0][m][1] * r1, a10 = acc[ai][1][m][0] * r1, a11 = acc[ai][1][m][1] * r1;
                if (pn == 0) {
                    const float s = fq_sum((sq4(a00) + sq4(a01)) + (sq4(a10) + sq4(a11)));
                    if (fq == 0) QSS[(size_t)row * 4 + wc] = s;
                    bf16* d = LATP + (size_t)row * 768 + wc * 32 + 8 * fq;
                    *(v4u*)d = pack8(a00, a01, 1.f); *(v4u*)(d + HALF) = pack8(a10, a11, 1.f);
                } else if (pn == 1) {
                    const float s = fq_sum(sq4(a00) + sq4(a01));
                    if (fq == 0) KSS[(size_t)row * 4 + wc] = s;
                    bf16* d = LATP + (size_t)row * 768 + 256 + wc * 32 + 8 * fq;
                    *(v4u*)d = pack8(a00, a01, 1.f); *(v4u*)(d + HALF) = (v4u){0u, 0u, 0u, 0u};
                    if (ropew) { f32x4 x0 = a10, x1 = a11; const f32x4 t0 = tn0, t1 = tn1;
                        if (ai * 4 + m < 7) { const int rown = row0 + ((ai * 4 + m + 1) >> 2) * HALF + ((ai * 4 + m + 1) & 3) * 16; const float2* tr = tab + (size_t)(rown % SEQ) * 16; tn0 = *(const f32x4*)(tr + 4 * fq); tn1 = *(const f32x4*)(tr + 4 * fq + 2); asm volatile("" ::: "memory"); }
                        rope32v(x0, x1, g00, g01, t0, t1, 1.f); store_rope(KROT + (size_t)row * 32, x0, x1, fq); }
                } else if (pn < 6) {
                    const bool isq = pn < 4; const int ch = 4 * ((pn - 2) & 1) + wc;
                    const float ms = fq_sum((sq4(a00) + sq4(a01)) + (sq4(a10) + sq4(a11))) * (1.f / 64.f);
                    const float r = __builtin_amdgcn_rsqf(ms + EPS) * (isq ? QSC_DIFF : 1.f);
                    bf16* d = (isq ? QD : KD) + (size_t)row * 512 + 64 * ch + 8 * fq;
                    *(v4u*)d = pack8(a00 * g00, a01 * g01, r); *(v4u*)(d + 32) = pack8(a10 * g10, a11 * g11, r);
                } else {
                    bf16* d = VD + (size_t)row * 512 + 256 * (pn - 6) + wc * 32 + 8 * fq;
                    *(v4u*)d = pack8(a00, a01, 1.f); *(v4u*)(d + HALF) = pack8(a10, a11, 1.f);
                }
            } }
    }
};

struct EpiUp {
    static constexpr bool PERM = true, AFTER_DRAIN = false, PRE = false;
    unsigned char* ws;
    __device__ __forceinline__ void operator()(const Acc& acc, const Unit& u, int wr, int wc, int fr, int fq) const {
        asm volatile("" : "+v"(fr), "+v"(fq));
        const float* QSS = (const float*)(ws + WS_QSS); const float* KSS = (const float*)(ws + WS_KSS); bf16* QM = (bf16*)(ws + WS_QM); bf16* KVM = (bf16*)(ws + WS_KVM); const float2* tab = (const float2*)(ws + WS_TAB);
        const float* gq = kin(I_GMLAQ); const float* gk = kin(I_GMLAK);
        const int row0 = u.pm * BM + wr * 64 + fr, pn = u.pn;
        f32x4 g00 = {1.f, 1.f, 1.f, 1.f}, g01 = g00, g10 = g00, g11 = g00;
        if (pn < 2 || (pn >= 3 && (wc & 1) == 0)) { const float* g = (pn < 2 ? gq : gk) + 8 * fq; g00 = *(const f32x4*)g; g01 = *(const f32x4*)(g + 4); g10 = *(const f32x4*)(g + 32); g11 = *(const f32x4*)(g + 36); }
        if (pn == 2) { g00 = *(const f32x4*)(gq + 64 + 4 * fq); g01 = *(const f32x4*)(gq + 64 + 16 + 4 * fq); }
        f32x4 tn0 = {0.f, 0.f, 0.f, 0.f}, tn1 = tn0;
        if (pn == 2) { const float2* tr = tab + (size_t)(row0 % SEQ) * 16; tn0 = *(const f32x4*)(tr + 4 * fq); tn1 = *(const f32x4*)(tr + 4 * fq + 2); }
#pragma unroll
        for (int ai = 0; ai < 2; ++ai) { float r2s[4];
#pragma unroll
            for (int m = 0; m < 4; ++m) { const int row = row0 + ai * HALF + m * 16; r2s[m] = pn < 3 ? rstd4(QSS, row, 1.f / 256.f) : rstd4(KSS, row, 1.f / 128.f); }
#pragma unroll
            for (int m = 0; m < 4; ++m) { const int row = row0 + ai * HALF + m * 16;
                const float r2 = r2s[m];
                const f32x4 a00 = acc[ai][0][m][0] * r2, a01 = acc[ai][0][m][1] * r2, a10 = acc[ai][1][m][0] * r2, a11 = acc[ai][1][m][1] * r2;
                if (pn < 2) {
                    const int h = 4 * pn + wc;
                    const float ms = fq_sum((sq4(a00) + sq4(a01)) + (sq4(a10) + sq4(a11))) * (1.f / 64.f);
                    const float r = __builtin_amdgcn_rsqf(ms + EPS) * QSC_MLA;
                    bf16* d = QM + (size_t)row * 768 + 96 * h + 8 * fq;
                    *(v4u*)d = pack8(a00 * g00, a01 * g01, r); *(v4u*)(d + 32) = pack8(a10 * g10, a11 * g11, r);
                } else if (pn == 2) {
                    const f32x4 t0 = tn0, t1 = tn1;
                    if (ai * 4 + m < 7) { const int rown = row0 + ((ai * 4 + m + 1) >> 2) * HALF + ((ai * 4 + m + 1) & 3) * 16; const float2* tr = tab + (size_t)(rown % SEQ) * 16; tn0 = *(const f32x4*)(tr + 4 * fq); tn1 = *(const f32x4*)(tr + 4 * fq + 2); asm volatile("" ::: "memory"); }
                    { f32x4 x0 = a00, x1 = a01; rope32v(x0, x1, g00, g01, t0, t1, QSC_MLA); store_rope(QM + (size_t)row * 768 + 96 * (2 * wc) + 64, x0, x1, fq); }
                    { f32x4 x0 = a10, x1 = a11; rope32v(x0, x1, g00, g01, t0, t1, QSC_MLA); store_rope(QM + (size_t)row * 768 + 96 * (2 * wc + 1) + 64, x0, x1, fq); }
                } else {
                    const int cid = 4 * (pn - 3) + wc, head = cid >> 1, kind = cid & 1;
                    bf16* d = KVM + (size_t)row * 1024 + 128 * head + 64 * kind + 8 * fq;
                    if (kind == 0) {
                        const float ms = fq_sum((sq4(a00) + sq4(a01)) + (sq4(a10) + sq4(a11))) * (1.f / 64.f);
                        const float r = __builtin_amdgcn_rsqf(ms + EPS);
                        *(v4u*)d = pack8(a00 * g00, a01 * g01, r); *(v4u*)(d + 32) = pack8(a10 * g10, a11 * g11, r);
                    } else { *(v4u*)d = pack8(a00, a01, 1.f); *(v4u*)(d + 32) = pack8(a10, a11, 1.f); }
                }
            }
        }
    }
};
struct EpiPP {
    static constexpr bool PERM = true, AFTER_DRAIN = false, PRE = false;
    bf16* PP; float* SPP;
    __device__ __forceinline__ void operator()(const Acc& acc, const Unit& u, int wr, int wc, int fr, int fq) const {
        asm volatile("" : "+v"(fr), "+v"(fq));
        const int row0 = u.pm * BM + wr * 64 + fr, pn = u.pn;
#pragma unroll
        for (int ai = 0; ai < 2; ++ai)
#pragma unroll
            for (int m = 0; m < 4; ++m) { const int row = row0 + ai * HALF + m * 16;
                const f32x4 a00 = acc[ai][0][m][0], a01 = acc[ai][0][m][1], a10 = acc[ai][1][m][0], a11 = acc[ai][1][m][1];
                const float s = fq_sum((sq4(a00) + sq4(a01)) + (sq4(a10) + sq4(a11)));
                if (fq == 0) SPP[(size_t)row * 16 + pn * 4 + wc] = s;
                bf16* d = PP + (size_t)row * DM + 256 * pn + wc * 32 + 8 * fq;
                *(v4u*)d = pack8(a00, a01, 1.f); *(v4u*)(d + HALF) = pack8(a10, a11, 1.f); }
    }
};
}

__device__ __forceinline__ void pp_gemm(Frame& F, int G2, int c2) {
    pg8::Gemm g2{(const bf16*)F.ws, (const bf16*)(F.ws + WS_WUP) + (size_t)1792 * 256, M, DM, 256, 256, 1 << 30, 0, 1 << 30, 0, 1}; pg8::StaticOrder S2; S2.init(M, DM, G2, c2);
    pg8::EpiPP E2{(bf16*)(F.ws + WS_PP), (float*)(F.ws + WS_SPP)};
    pg8::gemm_phase<pg8::EpiPP, true>(F.lds + RING_OFF, g2, S2, E2);
}

struct Args;
template <class BarT>
__device__ __forceinline__ void mix_phases(Frame& F, const BarT& bar, int lo, int hi) {
#define IN(k) (lo <= (k) && (k) < hi)
#define BOTH(k) (IN(k) && IN((k) + 1))
    unsigned char* ws = F.ws;
    bf16* HB = (bf16*)(ws + WS_HB); bf16* LATP = (bf16*)(ws + WS_LATP); bf16* KROT = (bf16*)(ws + WS_KROT); bf16* QD = (bf16*)(ws + WS_QD); bf16* KD = (bf16*)(ws + WS_KD); bf16* VD = (bf16*)(ws + WS_VD);
    bf16* QM = (bf16*)(ws + WS_QM); bf16* KVM = (bf16*)(ws + WS_KVM); bf16* OCAT = (bf16*)(ws + WS_OCAT); bf16* PP = (bf16*)(ws + WS_PP);
    float* S1 = (float*)(ws + WS_S1); float* S2 = (float*)(ws + WS_S2); float* QSS = (float*)(ws + WS_QSS); float* KSS = (float*)(ws + WS_KSS); float* SPP = (float*)(ws + WS_SPP);
    const float2* tab = (const float2*)(ws + WS_TAB);
    const int NOPN = 1 << 30;
    if (IN(3)) {
        pg8::Gemm g{HB, (const bf16*)(ws + WS_WIN), M, 2048, DM, DM, NOPN, 0, NOPN, 0}; pg8::StaticOrder S; S.init(M, 2048, F.G, (int)blockIdx.x);
        pg8::EpiWin E{ws};
        pg8::gemm_phase<pg8::EpiWin, true>(F.lds + RING_OFF, g, S, E);
        if (BOTH(3)) PANEL_BAR_L1CLEAN();
    }
    if (IN(4)) {
        pg8::Gemm g{LATP, (const bf16*)(ws + WS_WUP), M, 1792, 256, 768, 3, 256, 7, 512, 0, 3  }; pg8::StaticOrder S; S.init(M, 1792, F.G, (int)blockIdx.x);
        pg8::EpiUp E{ws};
        pg8::gemm_phase<pg8::EpiUp, true>(F.lds + RING_OFF, g, S, E);
        if (BOTH(4)) xcd_barrier(bar);
    }
#ifdef MK_PROBE_VAR
    if (IN(5) && karg_pad()) { for (int i = 0; i < 2; ++i) { const int bh = 2 * (F.vcu >> 5) + i, qb = F.vcu & 31; att::mla_unit4<MK_PROBE_VAR>(bh >> 3, bh & 7, qb, QM, KVM, KROT, PP, (LAS char*)(F.lds + RING_OFF)); } }
#endif
    if (IN(5)) {
        float gq = fmaxf(fabsf(kin(I_GMLAQ)[F.lane]), F.lane < 32 ? fabsf(kin(I_GMLAQ)[64 + F.lane]) : 0.f), gk = fmaxf(fabsf(kin(I_GMLAK)[F.lane]), F.lane < 32 ? fabsf(kin(I_GMLAK)[64 + F.lane]) : 0.f);
#pragma unroll
        for (int o_ = 1; o_ < 64; o_ <<= 1) { gq = fmaxf(gq, __shfl_xor(gq, o_)); gk = fmaxf(gk, __shfl_xor(gk, o_)); }
        const bool fast = __builtin_amdgcn_readfirstlane((int)(9.7979590f * gq * gk * LOG2E * 1.02f + 1.f <= 40.f)) != 0;
#ifdef MK_PROBE_VAR
        if (!karg_pad())
#endif
        for (int i = 0; i < 2; ++i) { const int bh = 2 * (F.vcu >> 5) + i, qb = F.vcu & 31;
            if (fast) att::mla_unit4<0>(bh >> 3, bh & 7, qb, QM, KVM, KROT, OCAT, (LAS char*)(F.lds + RING_OFF));
            else att::mla_unit(bh >> 3, bh & 7, qb, QM, KVM, KROT, OCAT, (LAS char*)(F.lds + RING_OFF)); }
    }
    if (IN(6)) {
        const float s1 = wave_sum(kin(I_LQ1)[F.lane] * kin(I_LK1)[F.lane]), s2 = wave_sum(kin(I_LQ2)[F.lane] * kin(I_LK2)[F.lane]);
        const float lam = __expf(s1) - __expf(s2) + 0.2f;
        float gq = fabsf(kin(I_GDQ)[F.lane]), gk = fabsf(kin(I_GDK)[F.lane]);
#pragma unroll
        for (int o_ = 1; o_ < 64; o_ <<= 1) { gq = fmaxf(gq, __shfl_xor(gq, o_)); gk = fmaxf(gk, __shfl_xor(gk, o_)); }
        const float B2 = 8.f * gq * gk * LOG2E * 1.02f + 1.f;
        const bool fastd = __builtin_amdgcn_readfirstlane((int)(B2 <= 40.f)) != 0;
        const int xj = F.vcu >> 5, bb = xj >> 2, pair = (xj >> 1) & 1, qb = 32 * (xj & 1) + (F.vcu & 31);
        for (int i = 0; i < 2; ++i) {
            const int h = pair == 0 ? (i == 0 ? 3 : 0) : (i == 0 ? 2 : 1);
            const float sl2 = exp2f(-2.f * (float)(h + 1)) * LOG2E;
            const float wdf = ceilf((fastd ? 127.f : B2 + 127.f) / sl2);
            const int Wd = __builtin_amdgcn_readfirstlane(wdf > 16384.f ? 16384 : (int)wdf);
            const int q0 = qb * 128;
            int t_lo = q0 - 63 - Wd; t_lo = t_lo < 0 ? 0 : (t_lo >> 6) + 1;
            int t_hi = (q0 + 127 + Wd + 63) / 64 - 1; t_hi = t_hi > SEQ / 64 - 1 ? SEQ / 64 - 1 : t_hi;
            if (t_hi - t_lo < 3) { if (t_lo >= 4) t_lo = t_hi - 3; else t_hi = t_lo + 3; }
            if (((t_hi - t_lo + 1) & 1) != 0) { if (t_lo > 0) --t_lo; else ++t_hi; }
            if (fastd) att::diff_unit4(bb, h, qb, t_lo, t_hi - t_lo + 1, QD, KD, VD, OCAT, lam, B2, kin(I_GSUB), (LAS char*)(F.lds + RING_OFF));
            else att::diff_unit(bb, h, qb, t_lo, t_hi - t_lo + 1, QD, KD, VD, OCAT, lam, kin(I_GSUB), (LAS char*)(F.lds + RING_OFF));
        }
        if (F.G == 256 && pair == 0) { const int wrank = (xj >> 2) * 64 + (xj & 1) * 32 + (F.vcu & 31), rank = wrank * NWAVES + F.wave; p0_convert(F, 2, 4, rank, 128 * NWAVES); p0_convert(F, 6, 8, rank, 128 * NWAVES); __syncthreads(); pp_gemm(F, 128, wrank); }
        if (BOTH(6)) xcd_barrier(bar);
    }
    if (IN(7)) {
        pg8::Gemm g{OCAT, (const bf16*)(ws + WS_WOUT), M, DM, DM, DM, NOPN, 0, NOPN, 0}; pg8::StaticOrder S; S.init(M, DM, F.G, (int)blockIdx.x);
        pg8::EpiResid<true> E{HB, HB, S2, 1.0f, 0};
        pg8::gemm_phase<pg8::EpiResid<true>, false>(F.lds + RING_OFF, g, S, E);
        if (BOTH(7)) PANEL_BAR_L1CLEAN();
    }
#undef IN
#undef BOTH
}
}
namespace mk {
template <class BarT>
__device__ __forceinline__ void tail_phases(Frame& F, const BarT& bar, int lo, int hi) {
#define IN(k) (lo <= (k) && (k) < hi)
#define BOTH(k) (IN(k) && IN((k) + 1))
    unsigned char* ws = F.ws;
    bf16* HB = (bf16*)(ws + WS_HB); bf16* ACT = (bf16*)(ws + WS_ACT); bf16* PP = (bf16*)(ws + WS_PP);
    float* S2 = (float*)(ws + WS_S2); float* S3 = (float*)(ws + WS_S3); float* SPP = (float*)(ws + WS_SPP);
    const int NOPN = 1 << 30;
    if (IN(8)) {
        pg8::Gemm g{HB, (const bf16*)(ws + WS_WGU2), M, 2 * DFF, DM, DM, NOPN, 0, NOPN, 0}; pg8::StaticOrder S; S.init(M, 2 * DFF, F.G, (int)blockIdx.x);
        pg8::EpiSwiglu E{ACT, S2};
        pg8::gemm_phase<pg8::EpiSwiglu, true>(F.lds + RING_OFF, g, S, E);
        if (BOTH(8)) PANEL_BAR_L1CLEAN();
    }
    if (IN(9)) {
        pg8::Gemm g{ACT, (const bf16*)(ws + WS_WD2), M, DM, DFF, DFF, NOPN, 0, NOPN, 0}; pg8::StaticOrder S; S.init(M, DM, F.G, (int)blockIdx.x);
        pg8::EpiResid<true> E{HB, HB, S3, 0.5f, 0};
        pg8::gemm_phase<pg8::EpiResid<true>, false>(F.lds + RING_OFF, g, S, E);
        if (BOTH(9)) PANEL_BAR();
    }
    if (IN(10)) {
        pg8::Gemm g{HB, (const bf16*)(ws + WS_WPG), M, DM, DM, DM, NOPN, 0, NOPN, 0}; pg8::StaticOrder S; S.init(M, DM, F.G, (int)blockIdx.x);
        pg8::EpiPle E{HB, F.out, S3, SPP, PP, kin(I_BPG), kin(I_GPLEOUT)};
        pg8::gemm_phase<pg8::EpiPle, false>(F.lds + RING_OFF, g, S, E);
    }
#undef IN
#undef BOTH
}
}
namespace mk {
constexpr int NPHASE = 11;
struct Args { const float* in[31]; float* out; unsigned char* ws; int ph_lo, ph_hi, li, pad; };
static_assert(offsetof(Args, pad) == 69 * 4, "karg_pad");

__global__ void __launch_bounds__(NWAVES * 64, 2) mega_fwd(Args args) {
    extern __shared__ __attribute__((aligned(16))) unsigned char lds[];
    Frame F;
    F.lds = (LAS unsigned char*)lds;
    F.MISC = (volatile LAS unsigned*)(F.lds + MISC_OFF);
    F.tid = threadIdx.x; F.lane = F.tid & 63; F.wave = __builtin_amdgcn_readfirstlane(F.tid >> 6);
    F.G = gridDim.x; { const int bx = blockIdx.x; F.vcu = (F.G % 8 == 0) ? (bx % 8) * (F.G / 8) + bx / 8 : bx; }
    unsigned char* ws = args.ws; F.ws = ws; F.out = args.out;
    F.ctl = (gu32*)(ws + WS_CTL);
    for (int u = F.tid; u < (LDS_BYTES - LDSCTL_OFF) / 4; u += NWAVES * 64) ((LAS unsigned*)(F.lds + LDSCTL_OFF))[u] = 0u;
    __syncthreads();
    XcdBarrier bar = xcd_barrier_post((unsigned*)(F.ctl + CW_BAR) + args.li * XCD_BAR_STRIDE, F.MISC + 8);
#define GRID_BAR() xcd_barrier(bar)
    (void)grp_barrier_post(bar.bar, bar.bar, bar.x, F.MISC + 12);
    const int lo = args.ph_lo, hi = args.ph_hi;
#define IN(k) (lo <= (k) && (k) < hi)
#define BOTH(k) (IN(k) && IN((k) + 1))
    bf16* HB = (bf16*)(ws + WS_HB); bf16* ACT = (bf16*)(ws + WS_ACT);
    float* S0 = (float*)(ws + WS_S0); float* S1 = (float*)(ws + WS_S1); float* S2 = (float*)(ws + WS_S2); float* S3 = (float*)(ws + WS_S3);
    const int NOPN = 1 << 30;

#ifdef MK_CALIB
    calib<MK_CALIB>(F, (float*)(ws + WS_PP));
#endif
    if (IN(0)) { p0_prologue(F); if (BOTH(0)) GRID_BAR(); }
    if (IN(1)) {
        pg8::Gemm g{HB, (const bf16*)(ws + WS_WGU1), M, 2 * DFF, DM, DM, NOPN, 0, NOPN, 0}; pg8::StaticOrder S; S.init(M, 2 * DFF, F.G, (int)blockIdx.x);
        pg8::EpiSwiglu E{ACT, S0};
        pg8::gemm_phase<pg8::EpiSwiglu, true>(F.lds + RING_OFF, g, S, E);
        if (F.G != 256) pp_gemm(F, F.G, (int)blockIdx.x);
        else if (blockIdx.x >= 128) { const int rank = ((int)blockIdx.x - 128) * NWAVES + F.wave; p0_convert<true>(F, 4, 6, rank, 128 * NWAVES); }
        if (BOTH(1)) PANEL_BAR_L1CLEAN();
    }
    if (IN(2)) {
        pg8::Gemm g{ACT, (const bf16*)(ws + WS_WD1), M, DM, DFF, DFF, NOPN, 0, NOPN, 0}; pg8::StaticOrder S; S.init(M, DM, F.G, (int)blockIdx.x);
        pg8::EpiResid<true> E{HB, HB, S1, 0.5f, 0};
        pg8::gemm_phase<pg8::EpiResid<true>, false>(F.lds + RING_OFF, g, S, E);
        if (BOTH(2)) PANEL_BAR_ALL();
    }
#ifdef MK_HAVE_MIX
    mix_phases(F, bar, lo, hi);
#endif
#ifdef MK_HAVE_TAIL
    tail_phases(F, bar, lo, hi);
#endif
#undef IN
#undef BOTH
}

static int mk_grid = 0;
static bool launch(void* const* d_in, float* out, unsigned char* ws, hipStream_t stream, int lo, int hi, int li, int var = 0) {
    if (mk_grid == 0) {
        int dev = 0, cus = 0, per_cu = 0;
        if (hipGetDevice(&dev) != hipSuccess || hipDeviceGetAttribute(&cus, hipDeviceAttributeMultiprocessorCount, dev) != hipSuccess) { fprintf(stderr, "kernel_launch: device query failed\n"); mk_grid = -1; return false; }
        if (hipFuncSetAttribute((const void*)mega_fwd, hipFuncAttributeMaxDynamicSharedMemorySize, LDS_BYTES) != hipSuccess) { fprintf(stderr, "kernel_launch: hipFuncSetAttribute failed\n"); mk_grid = -1; return false; }
        if (hipOccupancyMaxActiveBlocksPerMultiprocessor(&per_cu, (const void*)mega_fwd, NWAVES * 64, LDS_BYTES) != hipSuccess || per_cu < 1) { fprintf(stderr, "kernel_launch: occupancy query reports %d blocks per CU\n", per_cu); (void)hipGetLastError(); mk_grid = -1; return false; }
        if (cus != 256) { fprintf(stderr, "kernel_launch: built for 256 CUs, found %d\n", cus); mk_grid = -1; return false; }
        mk_grid = cus;
    }
    if (mk_grid < 0) return false;
    Args a; memset(&a, 0, sizeof(a));
    for (int i = 0; i < 31; ++i) a.in[i] = (const float*)d_in[i];
    a.out = out; a.ws = ws; a.ph_lo = lo; a.ph_hi = hi; a.li = li; a.pad = var;
    hipLaunchKernelGGL(mega_fwd, dim3(mk_grid), dim3(NWAVES * 64), LDS_BYTES, stream, a);
    const hipError_t le = hipPeekAtLastError();
    if (le != hipSuccess) { fprintf(stderr, "kernel_launch: launch failed: %s\n", hipGetErrorName(le)); return false; }
    return true;
}
}
extern "C" void kernel_launch(void* const* d_in, const int* in_sizes, int n_in, void* d_out, int out_size, void* d_ws, size_t ws_size, hipStream_t stream) {
    if (n_in != 31 || out_size != mk::M * mk::DM || ws_size < (size_t)256 * mk::MiB) { fprintf(stderr, "kernel_launch: unexpected shapes n_in %d out %d ws %zu\n", n_in, out_size, ws_size); return; }
    if (hipMemsetAsync((char*)d_ws + mk::WS_CTL, 0, mk::CTL_ZERO_BYTES, stream) != hipSuccess) return;
    (void)mk::launch(d_in, (float*)d_out, (unsigned char*)d_ws, stream, 0, mk::NPHASE, 0);
}
```
